# Optimizing an MI355X kernel written in HIP

```python
import jax
import jax.numpy as jnp
from jax import lax
import numpy as np

D_MODEL = 1024
BATCH = 4
SEQ = 8192
DEPTH = 2

CHUNK = 64
EPS = 1e-6
CONV_CH = D_MODEL // 2
CONV_WIDTH = 31
GLA_HEADS = 4
GLA_DK = D_MODEL // 16
GLA_DV = D_MODEL // 8
GLA_GATE_RANK = 16
GLA_GATE_TAU = 16.0
FOX_HEADS = 16
FOX_HD = D_MODEL // FOX_HEADS
Q_BLOCK = 128
PEER_HEADS = 8
PEER_NKEYS = 128
PEER_N = PEER_NKEYS * PEER_NKEYS
PEER_QDIM = 256
PEER_TOPK = 16
PEER_TOKEN_BLOCK = 128

EVEN_IN = 2 * CONV_CH + 2 * GLA_HEADS * GLA_DK + 2 * GLA_HEADS * GLA_DV + GLA_GATE_RANK
ODD_IN = 3 * FOX_HEADS * FOX_HD + FOX_HEADS

kernel_name = 'hybrid_conv_gla_fox_peer_trunk'


def rms_norm(x, g):
    xf = x.astype(jnp.float32)
    y = xf * lax.rsqrt(jnp.mean(xf * xf, axis=-1, keepdims=True) + EPS)
    return (y * g.astype(jnp.float32)).astype(x.dtype)


def layer_norm(x, g, b):
    xf = x.astype(jnp.float32)
    mu = jnp.mean(xf, axis=-1, keepdims=True)
    xc = xf - mu
    y = xc * lax.rsqrt(jnp.mean(xc * xc, axis=-1, keepdims=True) + EPS)
    return (y * g.astype(jnp.float32) + b.astype(jnp.float32)).astype(x.dtype)


def conformer_conv(val, gate, conv_w, conv_b, ln_g, ln_b):
    u = val * jax.nn.sigmoid(gate)
    w = conv_w.astype(u.dtype)[:, None, :]
    y = lax.conv_general_dilated(u, w, window_strides=(1,), padding=[(CONV_WIDTH - 1, 0)],
                                 dimension_numbers=('NWC', 'WIO', 'NWC'),
                                 feature_group_count=u.shape[-1])
    y = y + conv_b.astype(y.dtype)
    return jax.nn.silu(layer_norm(y, ln_g, ln_b))


def gla_chunked(q, k, v, log_a):
    B, S, H, dk = q.shape
    dv = v.shape[-1]
    n = S // CHUNK

    def to_chunks(t):
        return t.reshape(B, n, CHUNK, H, t.shape[-1]).transpose(1, 0, 3, 2, 4)

    qc, kc, vc, gc = to_chunks(q * (dk ** -0.5)), to_chunks(k), to_chunks(v), to_chunks(log_a)
    causal = jnp.tril(jnp.ones((CHUNK, CHUNK), dtype=bool))

    def step(state, inp):
        qi, ki, vi, gi = inp
        b = jnp.cumsum(gi, axis=2)
        b_last = b[:, :, -1:, :]
        o_inter = jnp.einsum('bhtk,bhkv->bhtv', qi * jnp.exp(b), state)
        diff = b[:, :, :, None, :] - b[:, :, None, :, :]
        decay = jnp.exp(jnp.where(causal[:, :, None], diff, -jnp.inf))
        attn = jnp.einsum('bhtk,bhsk,bhtsk->bhts', qi, ki, decay)
        o = o_inter + jnp.einsum('bhts,bhsv->bhtv', attn, vi)
        k_dec = ki * jnp.exp(b_last - b)
        new_state = state * jnp.exp(b_last[:, :, 0, :, None]) + jnp.einsum('bhsk,bhsv->bhkv', k_dec, vi)
        return new_state, o

    s0 = jnp.zeros((B, H, dk, dv), jnp.float32)
    _, o = lax.scan(step, s0, (qc, kc, vc, gc))
    return o.transpose(1, 0, 3, 2, 4).reshape(B, S, H, dv)


def even_mix(h, w_in, conv_w, conv_b, ln_g, ln_b, gate_w2, gate_b, gla_norm_g, w_out):
    B, S, _ = h.shape
    hk = GLA_HEADS * GLA_DK
    hv = GLA_HEADS * GLA_DV
    p = h @ w_in
    cuts = [int(c) for c in np.cumsum([CONV_CH, CONV_CH, hk, hk, hv, hv])]
    a_val, a_gate, q, k, v, r, glr = jnp.split(p, cuts, axis=-1)
    y_a = conformer_conv(a_val, a_gate, conv_w, conv_b, ln_g, ln_b)
    f32 = jnp.float32
    log_a = jax.nn.log_sigmoid((glr @ gate_w2 + gate_b).astype(f32)) / GLA_GATE_TAU
    o = gla_chunked(q.reshape(B, S, GLA_HEADS, GLA_DK).astype(f32),
                    k.reshape(B, S, GLA_HEADS, GLA_DK).astype(f32),
                    v.reshape(B, S, GLA_HEADS, GLA_DV).astype(f32),
                    log_a.reshape(B, S, GLA_HEADS, GLA_DK))
    o = rms_norm(o, gla_norm_g).reshape(B, S, hv).astype(h.dtype)
    y_b = o * jax.nn.silu(r)
    return jnp.concatenate([y_a, y_b], axis=-1) @ w_out


def fox_mix(h, w_in, fgate_b, q_g, k_g, w_out):
    B, S, _ = h.shape
    hd = FOX_HEADS * FOX_HD
    p = h @ w_in
    q, k, v, fz = jnp.split(p, [hd, 2 * hd, 3 * hd], axis=-1)
    q = rms_norm(q.reshape(B, S, FOX_HEADS, FOX_HD), q_g).transpose(0, 2, 1, 3)
    k = rms_norm(k.reshape(B, S, FOX_HEADS, FOX_HD), k_g).transpose(0, 2, 1, 3)
    v = v.reshape(B, S, FOX_HEADS, FOX_HD).transpose(0, 2, 1, 3)
    f32 = jnp.float32
    log_f = jax.nn.log_sigmoid(fz.astype(f32) + fgate_b.astype(f32))
    c = jnp.cumsum(log_f, axis=1).transpose(0, 2, 1)
    scale = FOX_HD ** -0.5
    pos = jnp.arange(S)
    outs = []
    for i in range(S // Q_BLOCK):
        lo, hi = i * Q_BLOCK, (i + 1) * Q_BLOCK
        logits = jnp.einsum('bhqd,bhkd->bhqk', q[:, :, lo:hi], k[:, :, :hi]).astype(f32) * scale
        logits = logits + c[:, :, lo:hi, None] - c[:, :, None, :hi]
        mask = pos[lo:hi, None] >= pos[None, :hi]
        probs = jax.nn.softmax(jnp.where(mask, logits, -jnp.inf), axis=-1)
        outs.append(jnp.einsum('bhqk,bhkd->bhqd', probs.astype(v.dtype), v[:, :, :hi]))
    o = jnp.concatenate(outs, axis=2).transpose(0, 2, 1, 3).reshape(B, S, hd)
    return o @ w_out


def peer_ffn(h, wq, keys, u, v):
    B, S, D = h.shape
    f32 = jnp.float32
    half = PEER_QDIM // 2
    q = (h @ wq).reshape(B, S, PEER_HEADS, 2, half).astype(f32)
    s1 = jnp.einsum('bshd,hnd->bshn', q[..., 0, :], keys[:, 0].astype(f32))
    s2 = jnp.einsum('bshd,hnd->bshn', q[..., 1, :], keys[:, 1].astype(f32))
    v1, i1 = lax.top_k(s1, PEER_TOPK)
    v2, i2 = lax.top_k(s2, PEER_TOPK)
    cand = (v1[..., :, None] + v2[..., None, :]).reshape(B, S, PEER_HEADS, PEER_TOPK * PEER_TOPK)
    sc, j = lax.top_k(cand, PEER_TOPK)
    e1 = jnp.take_along_axis(i1, j // PEER_TOPK, axis=-1)
    e2 = jnp.take_along_axis(i2, j % PEER_TOPK, axis=-1)
    experts = e1 * PEER_NKEYS + e2
    gates = jax.nn.softmax(sc, axis=-1)
    nb = (B * S) // PEER_TOKEN_BLOCK
    ne = PEER_HEADS * PEER_TOPK
    hb = h.reshape(nb, PEER_TOKEN_BLOCK, D)
    eb = experts.reshape(nb, PEER_TOKEN_BLOCK, ne)
    gb = gates.reshape(nb, PEER_TOKEN_BLOCK, ne).astype(h.dtype)

    def block(args):
        ht, et, gt = args
        act = jax.nn.gelu(jnp.einsum('td,ted->te', ht, u[et]), approximate=False)
        return jnp.einsum('te,ted->td', gt * act, v[et])

    out = lax.map(block, (hb, eb, gb))
    return out.reshape(B, S, D)


def setup_inputs(seed: int = 0) -> dict:
    key = jax.random.key(seed)
    ks = iter(jax.random.split(key, 32))
    n_even = (DEPTH + 1) // 2
    n_odd = DEPTH // 2
    f32 = jnp.float32
    D = D_MODEL

    def nrm(shape, scale):
        return jax.random.normal(next(ks), shape, f32) * scale

    def gain(shape):
        return 1.0 + 0.05 * jax.random.normal(next(ks), shape, f32)

    return {
        'x': nrm((BATCH, SEQ, D), 1.0),
        'ev_norm_mix': gain((n_even, D)),
        'ev_w_in': nrm((n_even, D, EVEN_IN), D ** -0.5),
        'ev_conv_w': nrm((n_even, CONV_WIDTH, CONV_CH), CONV_WIDTH ** -0.5),
        'ev_conv_b': nrm((n_even, CONV_CH), 0.02),
        'ev_conv_ln_g': gain((n_even, CONV_CH)),
        'ev_conv_ln_b': nrm((n_even, CONV_CH), 0.02),
        'ev_gate_w2': nrm((n_even, GLA_GATE_RANK, GLA_HEADS * GLA_DK), GLA_GATE_RANK ** -0.5),
        'ev_gate_b': nrm((n_even, GLA_HEADS * GLA_DK), 0.1),
        'ev_gla_norm_g': gain((n_even, GLA_DV)),
        'ev_w_out': nrm((n_even, CONV_CH + GLA_HEADS * GLA_DV, D), (CONV_CH + GLA_HEADS * GLA_DV) ** -0.5),
        'od_norm_mix': gain((n_odd, D)),
        'od_w_in': nrm((n_odd, D, ODD_IN), D ** -0.5),
        'od_fgate_b': jax.random.uniform(next(ks), (n_odd, FOX_HEADS), f32, minval=1.0, maxval=4.0),
        'od_q_norm_g': gain((n_odd, FOX_HD)),
        'od_k_norm_g': gain((n_odd, FOX_HD)),
        'od_w_out': nrm((n_odd, FOX_HEADS * FOX_HD, D), (FOX_HEADS * FOX_HD) ** -0.5),
        'ffn_norm': gain((DEPTH, D)),
        'peer_wq': nrm((DEPTH, D, PEER_HEADS * PEER_QDIM), D ** -0.5),
        'peer_keys': nrm((DEPTH, PEER_HEADS, 2, PEER_NKEYS, PEER_QDIM // 2), (PEER_QDIM // 2) ** -0.5),
        'peer_u': nrm((DEPTH, PEER_N, D), D ** -0.5),
        'peer_v': nrm((DEPTH, PEER_N, D), (PEER_HEADS * PEER_TOPK) ** -0.5),
    }


def reference(x, ev_norm_mix, ev_w_in, ev_conv_w, ev_conv_b, ev_conv_ln_g, ev_conv_ln_b,
              ev_gate_w2, ev_gate_b, ev_gla_norm_g, ev_w_out,
              od_norm_mix, od_w_in, od_fgate_b, od_q_norm_g, od_k_norm_g, od_w_out,
              ffn_norm, peer_wq, peer_keys, peer_u, peer_v):
    for layer in range(DEPTH):
        j = layer // 2
        if layer % 2 == 0:
            h = rms_norm(x, ev_norm_mix[j])
            x = x + even_mix(h, ev_w_in[j], ev_conv_w[j], ev_conv_b[j], ev_conv_ln_g[j], ev_conv_ln_b[j],
                             ev_gate_w2[j], ev_gate_b[j], ev_gla_norm_g[j], ev_w_out[j])
        else:
            h = rms_norm(x, od_norm_mix[j])
            x = x + fox_mix(h, od_w_in[j], od_fgate_b[j], od_q_norm_g[j], od_k_norm_g[j], od_w_out[j])
        h = rms_norm(x, ffn_norm[layer])
        x = x + peer_ffn(h, peer_wq[layer], peer_keys[layer], peer_u[layer], peer_v[layer])
    return x
```

```cpp
#include <hip/hip_runtime.h>
#include <hip/hip_cooperative_groups.h>
#include <hip/hip_bf16.h>
#include <cstdio>
#include <cstdint>
#include <cmath>
namespace cg = cooperative_groups;
namespace pg8 {
#define PG8_LAS __attribute__((address_space(3)))
typedef unsigned short bf16_t;
typedef short bf16x8 __attribute__((ext_vector_type(8)));
typedef float f32x4 __attribute__((ext_vector_type(4)));
typedef unsigned u32x4 __attribute__((ext_vector_type(4)));
constexpr int BM = 256, BK = 64, HALF = 128, HTB = HALF * BK * 2  , STAGE_BYTES = 8 * HTB, NXCD = 8, WGM = 8;

__host__ __device__ __forceinline__ int lds_byte(int r, int c) { const int st = (r >> 4) * 2 + (c >> 5), rr = r & 15, cc = c & 31, ob = rr * 64 + cc * 2; return st * 1024 + (ob ^ (((ob >> 9) & 1) << 5)); }
__host__ __device__ __forceinline__ void stage_rc(int b, int& R, int& C) { const int st = b / 1024, sb = b % 1024, swz = sb ^ (((sb >> 9) & 1) << 5); R = (st >> 1) * 16 + swz / 64; C = (st & 1) * 32 + (swz % 64) / 2; }
__host__ __device__ __forceinline__ int perm32(int rho) { const int n = rho >> 4, i = rho & 15; return 8 * (i >> 2) + 4 * n + (i & 3); }

struct Unit { int pm, pn; };
struct Gemm { const bf16_t* A; const bf16_t* Bt; int M, N, K; };

struct StaticOrder {
    int nM, nN, nwg, G, c;
    __host__ __device__ void init(int M, int N, int G_, int c_) { nM = M / BM; nN = N / BM; nwg = nM * nN; G = G_; c = c_; }
    __host__ __device__ bool next(int i, Unit& u) const {
        const long L = (long)i * G + c; if (L >= nwg) return false;
        int wgid = (int)L; { const int q = nwg / NXCD, r = nwg % NXCD, xcd = wgid % NXCD, off = wgid / NXCD; wgid = (xcd < r ? xcd * (q + 1) : r * (q + 1) + (xcd - r) * q) + off; }
        const int nig = WGM * nN, gid = wgid / nig, fm = gid * WGM, gsz = (nM - fm) < WGM ? (nM - fm) : WGM;
        u.pm = fm + ((wgid % nig) % gsz); u.pn = (wgid % nig) / gsz; return true;
    }
    __device__ __forceinline__ void a_ready(const Unit&) const {}
    __device__ __forceinline__ void done(const Unit&) const {}
};
__device__ __forceinline__ unsigned cvt_pk_bf16(float lo, float hi) { unsigned r; asm volatile("v_cvt_pk_bf16_f32 %0, %1, %2" : "=v"(r) : "v"(lo), "v"(hi)); return r; }
constexpr int MROWS = 32768;
template <int SSN> __device__ __forceinline__ float row_rstd(const float* ss, int row) {
    float s;
    if (SSN == 1) s = ss[row];
    else { const f32x4* p = (const f32x4*)(ss + (size_t)row * 16); const f32x4 a = p[0], b = p[1], c = p[2], d = p[3];
        s = (((a[0] + a[1]) + (a[2] + a[3])) + ((b[0] + b[1]) + (b[2] + b[3]))) + (((c[0] + c[1]) + (c[2] + c[3])) + ((d[0] + d[1]) + (d[2] + d[3]))); }
    return __builtin_amdgcn_rsqf(s * (1.0f / 1024.0f) + 1e-6f);
}
template <int SSN> struct EpiScale {
    static constexpr bool PERM = true, AFTER_DRAIN = false;
    bf16_t* O; int ldc; int nvalid; const float* ss;
    __device__ __forceinline__ void operator()(const f32x4 (&acc)[2][2][4][2], const Unit& u, int wr, int wc, int fr, int fq) const {
        const int row0 = u.pm * BM + wr * 64 + fr; const int col0 = u.pn * BM + wc * 32 + 8 * fq;
#pragma unroll
        for (int ai = 0; ai < 2; ++ai)
#pragma unroll
            for (int m = 0; m < 4; ++m) { const int row = row0 + ai * HALF + m * 16; const float rs = row_rstd<SSN>(ss, row); bf16_t* rowp = O + (size_t)row * ldc + col0;
#pragma unroll
                for (int bj = 0; bj < 2; ++bj) { if (col0 + bj * HALF < nvalid) { const f32x4 v0 = acc[ai][bj][m][0] * rs, v1 = acc[ai][bj][m][1] * rs;
                    u32x4 w; w.x = cvt_pk_bf16(v0[0], v0[1]); w.y = cvt_pk_bf16(v0[2], v0[3]); w.z = cvt_pk_bf16(v1[0], v1[1]); w.w = cvt_pk_bf16(v1[2], v1[3]);
                    *(u32x4*)(rowp + bj * HALF) = w; } } }
    }
};
struct EpiResid {
    static constexpr bool PERM = true, AFTER_DRAIN = false;
    const float* xin; float* xout; bf16_t* xb; float* ssp;
    __device__ __forceinline__ void operator()(const f32x4 (&acc)[2][2][4][2], const Unit& u, int wr, int wc, int fr, int fq) const {
        const int row0 = u.pm * BM + wr * 64 + fr; const int col0 = u.pn * BM + wc * 32 + 8 * fq;
#pragma unroll
        for (int ai = 0; ai < 2; ++ai)
#pragma unroll
            for (int m = 0; m < 4; ++m) { const int row = row0 + ai * HALF + m * 16; const size_t off = (size_t)row * 1024 + col0; float s = 0.f;
#pragma unroll
                for (int bj = 0; bj < 2; ++bj) { const f32x4 a0 = *(const f32x4*)(xin + off + bj * HALF), a1 = *(const f32x4*)(xin + off + bj * HALF + 4);
                    const f32x4 v0 = a0 + acc[ai][bj][m][0], v1 = a1 + acc[ai][bj][m][1];
                    *(f32x4*)(xout + off + bj * HALF) = v0; *(f32x4*)(xout + off + bj * HALF + 4) = v1;
                    s += (v0[0] * v0[0] + v0[1] * v0[1]) + (v0[2] * v0[2] + v0[3] * v0[3]) + (v1[0] * v1[0] + v1[1] * v1[1]) + (v1[2] * v1[2] + v1[3] * v1[3]);
                    u32x4 w; w.x = cvt_pk_bf16(v0[0], v0[1]); w.y = cvt_pk_bf16(v0[2], v0[3]); w.z = cvt_pk_bf16(v1[0], v1[1]); w.w = cvt_pk_bf16(v1[2], v1[3]);
                    *(u32x4*)(xb + off + bj * HALF) = w; }
                s += __shfl_xor(s, 16); s += __shfl_xor(s, 32);
                if (fq == 0) ssp[(size_t)row * 16 + u.pn * 4 + wc] = s; }
    }
};
struct EpiQkv {
    static constexpr bool PERM = true, AFTER_DRAIN = false;
    bf16_t* QKV; const float* ss; float* lft; const float* fb;
    __device__ __forceinline__ void operator()(const f32x4 (&acc)[2][2][4][2], const Unit& u, int wr, int wc, int fr, int fq) const {
        const int row0 = u.pm * BM + wr * 64 + fr;
        if (u.pn < 12) {
            bf16_t* base = QKV + (size_t)(u.pn >> 2) * ((size_t)MROWS * 1024); const int col0 = (u.pn & 3) * BM + wc * 32 + 8 * fq;
#pragma unroll
            for (int ai = 0; ai < 2; ++ai)
#pragma unroll
                for (int m = 0; m < 4; ++m) { const int row = row0 + ai * HALF + m * 16; const float rs = row_rstd<16>(ss, row); bf16_t* rowp = base + (size_t)row * 1024 + col0;
#pragma unroll
                    for (int bj = 0; bj < 2; ++bj) { const f32x4 v0 = acc[ai][bj][m][0] * rs, v1 = acc[ai][bj][m][1] * rs;
                        u32x4 w; w.x = cvt_pk_bf16(v0[0], v0[1]); w.y = cvt_pk_bf16(v0[2], v0[3]); w.z = cvt_pk_bf16(v1[0], v1[1]); w.w = cvt_pk_bf16(v1[2], v1[3]);
                        *(u32x4*)(rowp + bj * HALF) = w; } }
        } else if (wc == 0 && fq < 2) {
            const f32x4 f0 = *(const f32x4*)(fb + 8 * fq), f1 = *(const f32x4*)(fb + 8 * fq + 4);
#pragma unroll
            for (int ai = 0; ai < 2; ++ai)
#pragma unroll
                for (int m = 0; m < 4; ++m) { const int row = row0 + ai * HALF + m * 16; const float rs = row_rstd<16>(ss, row);
                    float* dst = lft + (size_t)row * 16 + 8 * fq;
                    *(f32x4*)dst = acc[ai][0][m][0] * rs + f0; *(f32x4*)(dst + 4) = acc[ai][0][m][1] * rs + f1; }
        }
    }
};
template <class Epi, class Sched, bool ALIGN_EPI = false, bool SP2 = false>
__device__ __forceinline__ void gemm_phase(PG8_LAS unsigned char* lds, const Gemm g, const Sched& S, const Epi& E) {
    int tid = threadIdx.x; asm volatile("" : "+v"(tid)); const int wid = __builtin_amdgcn_readfirstlane(tid >> 6), lane = tid & 63, wr = wid >> 2, wc = wid & 3, fr = lane & 15, fq = lane >> 4;
    const int K = g.K, nt = K / BK;
    unsigned voffA[2], voffB[2];
#pragma unroll
    for (int i = 0; i < 2; ++i) { int R, C; stage_rc(tid * 16 + i * 8192, R, C); const int Rb = Epi::PERM ? ((R & ~31) + perm32(R & 31)) : R;
        voffA[i] = (unsigned)(R * K + C) * 2u; voffB[i] = (unsigned)(Rb * K + C) * 2u; }
    const size_t kstep = (size_t)(BK * 2);
    const size_t hstep = (size_t)HALF * K * 2;
    const size_t tstep = 2 * hstep;
    const unsigned ldsw = (unsigned)wid * 1024u;
    const int aoff = lds_byte(wr * 64 + fr, fq * 8), boff = lds_byte(wc * 32 + fr, fq * 8);
#define PG8_SA(b, h) (((b) * 2 + (h)) * HTB)
#define PG8_SB(b, h) ((4 + (b) * 2 + (h)) * HTB)
#define PG8_STAGE(bufoff, gbase, voff) do { _Pragma("unroll") for (int _i = 0; _i < 2; ++_i) \
        __builtin_amdgcn_global_load_lds((const unsigned*)((const char*)(gbase) + (voff)[_i]), (PG8_LAS unsigned*)(lds + (bufoff) + ldsw + _i * 8192), 16, 0, 0); } while (0)
#define PG8_LDA(dst, b, h) do { _Pragma("unroll") for (int m = 0; m < 4; ++m) _Pragma("unroll") for (int k = 0; k < 2; ++k) dst[m][k] = *(const PG8_LAS bf16x8*)(lds + PG8_SA(b, h) + aoff + m * 2048 + k * 1024); } while (0)
#define PG8_LDB(dst, b, h) do { _Pragma("unroll") for (int n = 0; n < 2; ++n) _Pragma("unroll") for (int k = 0; k < 2; ++k) dst[n][k] = *(const PG8_LAS bf16x8*)(lds + PG8_SB(b, h) + boff + n * 2048 + k * 1024); } while (0)
#define PG8_MMA(ai, bj, At, Bt) do { __builtin_amdgcn_s_setprio(1); _Pragma("unroll") for (int m = 0; m < 4; ++m) _Pragma("unroll") for (int n = 0; n < 2; ++n) _Pragma("unroll") for (int k = 0; k < 2; ++k) \
        acc[ai][bj][m][n] = __builtin_amdgcn_mfma_f32_16x16x32_bf16(Bt[n][k], At[m][k], acc[ai][bj][m][n], 0, 0, 0); __builtin_amdgcn_s_setprio(0); } while (0)
#define PG8_WAIT_V(n) asm volatile("s_waitcnt vmcnt(" #n ")" ::: "memory")
#define PG8_WAIT_L(n) asm volatile("s_waitcnt lgkmcnt(" #n ")" ::: "memory")
#define PG8_BAR __builtin_amdgcn_s_barrier()
#define PG8_SCHED __builtin_amdgcn_sched_barrier(0)
    Unit cur, nxt; int ui = 0;
    if (!S.next(0, cur)) return;
    f32x4 acc[2][2][4][2];
#pragma unroll
    for (int a = 0; a < 2; ++a)
#pragma unroll
        for (int b = 0; b < 2; ++b)
#pragma unroll
            for (int m = 0; m < 4; ++m)
#pragma unroll
                for (int n = 0; n < 2; ++n) acc[a][b][m][n] = (f32x4){0.f, 0.f, 0.f, 0.f};
    bf16x8 At[4][2], B0[2][2], B1[2][2];
    const char* cA = (const char*)g.A + (size_t)cur.pm * tstep; const char* cB = (const char*)g.Bt + (size_t)cur.pn * tstep;
    S.a_ready(cur);
    if constexpr (SP2) {
        PG8_STAGE(PG8_SB(0, 0), cB, voffB); PG8_STAGE(PG8_SB(0, 1), cB + hstep, voffB); PG8_STAGE(PG8_SA(0, 0), cA, voffA); PG8_STAGE(PG8_SA(0, 1), cA + hstep, voffA);
        if (wr == 1) PG8_BAR;
        PG8_WAIT_V(2); PG8_BAR;
        PG8_STAGE(PG8_SB(1, 0), cB + kstep, voffB); PG8_STAGE(PG8_SA(1, 0), cA + kstep, voffA); PG8_STAGE(PG8_SB(1, 1), cB + hstep + kstep, voffB);
        PG8_WAIT_V(6); PG8_BAR;
    } else {
        PG8_STAGE(PG8_SB(0, 0), cB, voffB); PG8_STAGE(PG8_SA(0, 0), cA, voffA); PG8_STAGE(PG8_SB(0, 1), cB + hstep, voffB); PG8_STAGE(PG8_SA(0, 1), cA + hstep, voffA);
        if (wr == 1) PG8_BAR;
        PG8_WAIT_V(4); PG8_BAR;
        PG8_STAGE(PG8_SB(1, 0), cB + kstep, voffB); PG8_STAGE(PG8_SA(1, 0), cA + kstep, voffA); PG8_STAGE(PG8_SB(1, 1), cB + hstep + kstep, voffB);
        PG8_WAIT_V(6); PG8_BAR;
    }
    for (;;) {
        const bool has_next = S.next(ui + 1, nxt);
        const char* nA = has_next ? (const char*)g.A + (size_t)nxt.pm * tstep : cA; const char* nB = has_next ? (const char*)g.Bt + (size_t)nxt.pn * tstep : cB;
        for (int t = 0; t < nt; t += 2) {
            const bool last = (t == nt - 2);
            const char* a1 = cA + (size_t)(t + 1) * kstep;
            const char* a2 = last ? nA : cA + (size_t)(t + 2) * kstep; const char* b2 = last ? nB : cB + (size_t)(t + 2) * kstep;
            const char* a3 = a2 + kstep; const char* b3 = b2 + kstep;
            if (last && has_next) S.a_ready(nxt);
            if constexpr (SP2) {
            PG8_LDB(B0, 0, 0); PG8_LDB(B1, 0, 1); PG8_SCHED; PG8_LDA(At, 0, 0); PG8_STAGE(PG8_SA(1, 1), a1 + hstep, voffA);
            PG8_WAIT_V(8); PG8_WAIT_L(0); PG8_BAR; PG8_MMA(0, 0, At, B0); PG8_MMA(0, 1, At, B1); PG8_BAR; PG8_SCHED;
            PG8_LDA(At, 0, 1); PG8_STAGE(PG8_SB(0, 0), b2, voffB); PG8_STAGE(PG8_SB(0, 1), b2 + hstep, voffB); PG8_STAGE(PG8_SA(0, 0), a2, voffA);
            PG8_WAIT_V(8); PG8_WAIT_L(0); PG8_BAR; PG8_MMA(1, 0, At, B0); PG8_MMA(1, 1, At, B1); PG8_BAR; PG8_SCHED;
            PG8_LDB(B0, 1, 0); PG8_LDB(B1, 1, 1); PG8_SCHED; PG8_LDA(At, 1, 0); PG8_STAGE(PG8_SA(0, 1), a2 + hstep, voffA);
            PG8_WAIT_V(8); PG8_WAIT_L(0); PG8_BAR; PG8_MMA(0, 0, At, B0); PG8_MMA(0, 1, At, B1); PG8_BAR; PG8_SCHED;
            PG8_LDA(At, 1, 1); PG8_STAGE(PG8_SB(1, 0), b3, voffB); PG8_STAGE(PG8_SB(1, 1), b3 + hstep, voffB); PG8_STAGE(PG8_SA(1, 0), a3, voffA);
            PG8_WAIT_V(8); PG8_WAIT_L(0); PG8_BAR; PG8_MMA(1, 0, At, B0); PG8_MMA(1, 1, At, B1); PG8_BAR; PG8_SCHED;
            } else {
            PG8_LDB(B0, 0, 0); PG8_SCHED; PG8_LDA(At, 0, 0); PG8_STAGE(PG8_SA(1, 1), a1 + hstep, voffA);
            PG8_WAIT_L(8); PG8_BAR; PG8_WAIT_L(0); PG8_MMA(0, 0, At, B0); PG8_BAR; PG8_SCHED;
            PG8_LDB(B1, 0, 1); PG8_STAGE(PG8_SB(0, 0), b2, voffB);
            PG8_BAR; PG8_WAIT_L(0); PG8_MMA(0, 1, At, B1); PG8_BAR;
            PG8_LDA(At, 0, 1); PG8_STAGE(PG8_SA(0, 0), a2, voffA);
            PG8_BAR; PG8_WAIT_L(0); PG8_MMA(1, 0, At, B0); PG8_BAR; PG8_SCHED;
            PG8_STAGE(PG8_SB(0, 1), b2 + hstep, voffB);
            PG8_WAIT_V(6); PG8_BAR; PG8_MMA(1, 1, At, B1); PG8_BAR;
            PG8_LDB(B0, 1, 0); PG8_SCHED; PG8_LDA(At, 1, 0); PG8_STAGE(PG8_SA(0, 1), a2 + hstep, voffA);
            PG8_WAIT_L(8); PG8_BAR; PG8_WAIT_L(0); PG8_MMA(0, 0, At, B0); PG8_BAR; PG8_SCHED;
            PG8_LDB(B1, 1, 1); PG8_STAGE(PG8_SB(1, 0), b3, voffB);
            PG8_BAR; PG8_WAIT_L(0); PG8_MMA(0, 1, At, B1); PG8_BAR;
            PG8_LDA(At, 1, 1); PG8_STAGE(PG8_SA(1, 0), a3, voffA);
            PG8_BAR; PG8_WAIT_L(0); PG8_MMA(1, 0, At, B0); PG8_BAR; PG8_SCHED;
            PG8_STAGE(PG8_SB(1, 1), b3 + hstep, voffB);
            PG8_WAIT_V(6); PG8_BAR; PG8_MMA(1, 1, At, B1); PG8_BAR;
            }
        }
        if constexpr (ALIGN_EPI) { if (wr == 0) PG8_BAR; }
        if constexpr (!Epi::AFTER_DRAIN) { E(acc, cur, wr, wc, fr, fq); S.done(cur); }
        if (!has_next) break;
#pragma unroll
        for (int a = 0; a < 2; ++a)
#pragma unroll
            for (int b = 0; b < 2; ++b)
#pragma unroll
                for (int m = 0; m < 4; ++m)
#pragma unroll
                    for (int n = 0; n < 2; ++n) acc[a][b][m][n] = (f32x4){0.f, 0.f, 0.f, 0.f};
        cur = nxt; cA = nA; cB = nB; ++ui;
        if constexpr (ALIGN_EPI) { if (wr == 1) PG8_BAR; }
    }
    PG8_WAIT_V(0);
    if constexpr (!ALIGN_EPI) { if (wr == 0) PG8_BAR; }
    PG8_BAR;
    if constexpr (Epi::AFTER_DRAIN) { E.fused(acc, cur, wr, wc, fr, fq, lds, wid, lane); S.done(cur); }
#undef PG8_SA
#undef PG8_SB
#undef PG8_STAGE
#undef PG8_LDA
#undef PG8_LDB
#undef PG8_MMA
#undef PG8_WAIT_V
#undef PG8_WAIT_L
#undef PG8_BAR
#undef PG8_SCHED
}
}
#include <hip/hip_bf16.h>
#include <cmath>
namespace attn_body {
using bf16=__hip_bfloat16;
using bf16x8=__attribute__((ext_vector_type(8)))short;
using s16x4=__attribute__((ext_vector_type(4)))short;
using f32x16=__attribute__((ext_vector_type(16)))float;
using u32x4=__attribute__((ext_vector_type(4)))unsigned;
constexpr int BATCH=4,NHEAD=16,SEQ=8192,D=64,DM=NHEAD*D;
constexpr int NW=8,QBLK=32,QB=QBLK*NW,KVBLK=64,NQB=SEQ/QB;
constexpr int ATTN_PITCH=DM, ATTN_UNIT_ROWS=QB;
__device__ __forceinline__ int crow(int r,int hi){return (r&3)+8*(r>>2)+4*hi;}
#define SBAR() __builtin_amdgcn_sched_barrier(0)
__device__ __forceinline__ void cmask(f32x16&p0,f32x16&p1,int jb,int qrel,int hi){
  const float NEG=-INFINITY; int kb=64*jb+4*hi;
  #pragma unroll
  for(int r=0;r<16;++r){int kv=kb+(r&3)+8*(r>>2); if(kv>qrel)p0[r]=NEG; if(kv+32>qrel)p1[r]=NEG;}
}

constexpr int NSLOT=3, SLOTB=8192;
constexpr int LDS_K=0, LDS_V=NSLOT*SLOTB, LDS_WS=2*NSLOT*SLOTB, LDS_OST=LDS_WS+NW*64*4, LDS_BYTES=LDS_OST+NW*4096;
constexpr float C2=0.125f*1.4426950408889634f;
__device__ __forceinline__ void glds16(const void*gsrc,unsigned lds_dst){unsigned keep;
  asm volatile("s_mov_b32 %0, m0\n\ts_mov_b32 m0, %2\n\ts_nop 0\n\tglobal_load_lds_dwordx4 %1, off\n\ts_mov_b32 m0, %0":"=&s"(keep):"v"(gsrc),"s"(lds_dst):"memory");}
__device__ __forceinline__ float max3f(float a,float b,float c){float r;asm("v_max3_f32 %0, %1, %2, %3":"=v"(r):"v"(a),"v"(b),"v"(c));return r;}
__device__ __forceinline__ float max2f(float a,float b){float r;asm("v_max_f32_e32 %0, %1, %2":"=v"(r):"v"(a),"v"(b));return r;}
__device__ __forceinline__ float fadd_s(float a,float b){float r;asm("v_add_f32_e32 %0, %1, %2":"=v"(r):"v"(a),"v"(b));return r;}
__device__ __forceinline__ float fsub_s(float a,float b){float r;asm("v_sub_f32_e32 %0, %1, %2":"=v"(r):"v"(a),"v"(b));return r;}
typedef float f32x2_t __attribute__((ext_vector_type(2))); typedef __bf16 bf16x2_t __attribute__((ext_vector_type(2)));
__device__ __forceinline__ unsigned cvtpk_s(float lo,float hi){f32x2_t v={lo,hi};bf16x2_t b=__builtin_convertvector(v,bf16x2_t);return __builtin_bit_cast(unsigned,b);}
#define WAIT_BAR(N) asm volatile("s_waitcnt vmcnt(" #N ") lgkmcnt(0)\n\ts_barrier":::"memory")

__device__ __forceinline__ void qkt(f32x16&p0,f32x16&p1,const char*Kslot,const bf16x8*qr,const f32x16&negm,int r32,int hi){
  const char*kb=Kslot+hi*1024+r32*16;
  #pragma unroll
  for(int d0=0;d0<4;++d0){
    const bf16x8 b0=*reinterpret_cast<const bf16x8*>(kb+d0*2048);
    const bf16x8 b1=*reinterpret_cast<const bf16x8*>(kb+d0*2048+512);
    if(d0==0){p0=__builtin_amdgcn_mfma_f32_32x32x16_bf16(b0,qr[0],negm,0,0,0);p1=__builtin_amdgcn_mfma_f32_32x32x16_bf16(b1,qr[0],negm,0,0,0);}
    else{p0=__builtin_amdgcn_mfma_f32_32x32x16_bf16(b0,qr[d0],p0,0,0,0);p1=__builtin_amdgcn_mfma_f32_32x32x16_bf16(b1,qr[d0],p1,0,0,0);}}
}
typedef __attribute__((address_space(3))) const char* lds_cptr;
typedef short v4i16_t __attribute__((ext_vector_type(4)));
__device__ __forceinline__ void kload8(bf16x8*kf,lds_cptr kp){
  kf[0]=*(const __attribute__((address_space(3))) bf16x8*)(kp);      kf[1]=*(const __attribute__((address_space(3))) bf16x8*)(kp+512);
  kf[2]=*(const __attribute__((address_space(3))) bf16x8*)(kp+2048); kf[3]=*(const __attribute__((address_space(3))) bf16x8*)(kp+2560);
  kf[4]=*(const __attribute__((address_space(3))) bf16x8*)(kp+4096); kf[5]=*(const __attribute__((address_space(3))) bf16x8*)(kp+4608);
  kf[6]=*(const __attribute__((address_space(3))) bf16x8*)(kp+6144); kf[7]=*(const __attribute__((address_space(3))) bf16x8*)(kp+6656);
}
__device__ __forceinline__ void kload2(bf16x8*kf,lds_cptr kp,int j){ kf[2*j]=*(const __attribute__((address_space(3))) bf16x8*)(kp+j*2048); kf[2*j+1]=*(const __attribute__((address_space(3))) bf16x8*)(kp+j*2048+512); }
__device__ __forceinline__ s16x4 vtr(lds_cptr p){ return __builtin_bit_cast(s16x4,__builtin_amdgcn_ds_read_tr16_b64_v4i16((__attribute__((address_space(3))) v4i16_t*)p)); }
__device__ __forceinline__ float rowmax(const f32x16&p0,const f32x16&p1){
  float a=max3f(p0[0],p0[1],p1[0]),b=max3f(p0[2],p0[3],p1[1]);a=max3f(a,p1[2],p1[3]);
  #pragma unroll
  for(int r=4;r<16;r+=4){a=max3f(a,p0[r],p0[r+1]);b=max3f(b,p0[r+2],p0[r+3]);a=max3f(a,p1[r],p1[r+1]);b=max3f(b,p1[r+2],p1[r+3]);}
  const float m=max2f(a,b);
  auto rr=__builtin_amdgcn_permlane32_swap(__float_as_uint(m),__float_as_uint(m),false,false);
  return max2f(__uint_as_float(rr[0]),__uint_as_float(rr[1]));
}
__device__ __forceinline__ void pv(f32x16*o,int vb,bf16x8 pa0,bf16x8 pa1,bf16x8 pa2,bf16x8 pa3){
  #pragma unroll
  for(int d0=0;d0<2;++d0){s16x4 lo[4],hi[4];
    #pragma unroll
    for(int ks=0;ks<4;++ks){
      asm volatile("ds_read_b64_tr_b16 %0,%1 offset:%c2":"=&v"(lo[ks]):"v"(vb),"i"(d0*4096+ks*1024):"memory");
      asm volatile("ds_read_b64_tr_b16 %0,%1 offset:%c2":"=&v"(hi[ks]):"v"(vb),"i"(d0*4096+ks*1024+512):"memory");}
    asm volatile("s_waitcnt lgkmcnt(0)":::"memory");SBAR();
    #define PK(k) (bf16x8){lo[k][0],lo[k][1],lo[k][2],lo[k][3],hi[k][0],hi[k][1],hi[k][2],hi[k][3]}
    o[d0]=__builtin_amdgcn_mfma_f32_32x32x16_bf16(pa0,PK(0),o[d0],0,0,0);
    o[d0]=__builtin_amdgcn_mfma_f32_32x32x16_bf16(pa1,PK(1),o[d0],0,0,0);
    o[d0]=__builtin_amdgcn_mfma_f32_32x32x16_bf16(pa2,PK(2),o[d0],0,0,0);
    o[d0]=__builtin_amdgcn_mfma_f32_32x32x16_bf16(pa3,PK(3),o[d0],0,0,0);
    #undef PK
  }
}

typedef float f32x4_t __attribute__((ext_vector_type(4)));
typedef __attribute__((address_space(3))) const float* lds_fptr;
typedef __attribute__((address_space(3))) const f32x4_t* lds_f4ptr;
#define BIAS(P0,P1,t) do{ const lds_f4ptr bp_=(lds_f4ptr)(bl+(t)*64+4*hi); \
  _Pragma("unroll") for(int g_=0;g_<4;++g_){ { const f32x4_t v0_=bp_[2*g_]; \
    P0[4*g_]+=v0_[0];P0[4*g_+1]+=v0_[1];P0[4*g_+2]+=v0_[2];P0[4*g_+3]+=v0_[3]; } SBAR(); \
    { const f32x4_t v1_=bp_[8+2*g_]; \
    P1[4*g_]+=v1_[0];P1[4*g_+1]+=v1_[1];P1[4*g_+2]+=v1_[2];P1[4*g_+3]+=v1_[3]; } SBAR(); } }while(0)
#define PREFILL(P0,P1,t) do{ const lds_f4ptr bp_=(lds_f4ptr)(bl+(t)*64+4*hi); \
  _Pragma("unroll") for(int g_=0;g_<4;++g_){ { const f32x4_t v0_=bp_[2*g_]; \
    P0[4*g_]=v0_[0]-mhat;P0[4*g_+1]=v0_[1]-mhat;P0[4*g_+2]=v0_[2]-mhat;P0[4*g_+3]=v0_[3]-mhat; } SBAR(); \
    { const f32x4_t v1_=bp_[8+2*g_]; \
    P1[4*g_]=v1_[0]-mhat;P1[4*g_+1]=v1_[1]-mhat;P1[4*g_+2]=v1_[2]-mhat;P1[4*g_+3]=v1_[3]-mhat; } SBAR(); } }while(0)
#ifndef ATTN_STORE16
#define ATTN_STORE16(p,v) (*(u32x4*)(p)=(v))
#endif
template<int THRL> __device__ __forceinline__ void attn_unit(int b,int h,int qb,const bf16*Q,const bf16*__restrict__ K,const bf16*__restrict__ V,bf16*O,char*shm,lds_fptr bl,int t0){
  int tid=threadIdx.x; asm volatile("":"+v"(tid)); const int lane=tid&63,r32=lane&31,hi=lane>>5; const int wid=__builtin_amdgcn_readfirstlane(tid>>6);
  const long rowbase=(long)b*SEQ; const int q0=qb*QB;
  const bf16*Qw=Q+(rowbase+q0+wid*QBLK)*DM+h*D;
  const bf16*Kh=K+(rowbase+(long)t0*KVBLK)*DM+h*D,*Vh=V+(rowbase+(long)t0*KVBLK)*DM+h*D;
  const unsigned lds0=(unsigned)(uintptr_t)shm;
  float*wsf=(float*)(shm+LDS_WS)+wid*64;
  const bf16*ksrc=Kh+(long)lane*DM+wid*8;
  const bf16*vsrc=Vh+(long)(16*(wid&3)+(lane>>2))*DM+(wid>>2)*32+(lane&3)*8;
  const unsigned kdst=lds0+LDS_K+wid*1024, vdst=lds0+LDS_V+wid*1024;
  #define DMA_K(t,slot) glds16(ksrc+(long)(t)*KVBLK*DM,(unsigned)__builtin_amdgcn_readfirstlane(kdst+(slot)))
  #define DMA_V(t,slot) glds16(vsrc+(long)(t)*KVBLK*DM,(unsigned)__builtin_amdgcn_readfirstlane(vdst+(slot)))
  const int vb0=(int)(lds0+LDS_V)+((lane>>4)&1)*32+(lane&3)*8+(4*hi+((lane&15)>>2))*64;
  const char*Kbase=shm+LDS_K; bf16x8 kf[8];
  const lds_cptr shm3=(lds_cptr)shm; const lds_cptr kp0=shm3+LDS_K+hi*1024+r32*16; const lds_cptr vp0=shm3+LDS_V+((lane>>4)&1)*32+(lane&3)*8+(4*hi+((lane&15)>>2))*64;
  const int NT=(q0+QB)/KVBLK-t0;
  DMA_K(0,0);DMA_V(0,0);DMA_K(1,SLOTB);
  bf16x8 qr[4];
  #pragma unroll
  for(int d0=0;d0<4;++d0)qr[d0]=*reinterpret_cast<const bf16x8*>(&Qw[(long)r32*DM+d0*16+hi*8]);
  float mhat=0.f,l_reg=0.f;f32x16 o[2];o[0]=f32x16{};o[1]=f32x16{};f32x16 negm=f32x16{};asm volatile("":"+v"(negm));
  const int qrel=wid*QBLK+r32;
  #define CMASK(P0,P1,t) do{int jb_=(t)-(NT-4); if(jb_>=0)cmask(P0,P1,jb_,qrel,hi);}while(0)
  bool resc=false;
  #define START(P0,P1) do{ const float rm=rowmax(P0,P1); resc=false; \
    { const float dl=rm; mhat=fadd_s(mhat,dl); \
      _Pragma("unroll") for(int r=0;r<16;++r){P0[r]=fsub_s(P0[r],dl);P1[r]=fsub_s(P1[r],dl);} \
      } \
    _Pragma("unroll") for(int r=0;r<16;++r)P0[r]=__builtin_amdgcn_exp2f(P0[r]); }while(0)
  #define RESC() do{ if(resc){ asm volatile("s_waitcnt lgkmcnt(0)":::"memory"); \
      _Pragma("unroll") for(int d_=0;d_<2;++d_) _Pragma("unroll") for(int r=0;r<16;++r)o[d_][r]*=wsf[crow(r,hi)]; } }while(0)
  f32x16 pA0,pA1,pB0,pB1;
  int sl_prev=0,sl_cur=0,sl_next=SLOTB;
  #define ROT() do{sl_prev=sl_cur;sl_cur=sl_next;sl_next=(sl_next==(NSLOT-1)*SLOTB)?0:sl_next+SLOTB;}while(0)
  DMA_K(2,2*SLOTB);
  WAIT_BAR(3);
  qkt(pA0,pA1,Kbase,qr,negm,r32,hi);asm volatile("s_nop 15\n\ts_nop 7":"+v"(pA0),"+v"(pA1));BIAS(pA0,pA1,0);CMASK(pA0,pA1,0);
  START(pA0,pA1);
  PREFILL(pB0,pB1,1);
  _Pragma("unroll") for(int r=0;r<16;++r)pA1[r]=__builtin_amdgcn_exp2f(pA1[r]);
  WAIT_BAR(0);
  DMA_K(3,0);DMA_V(1,SLOTB);
  ROT();
  kload8(kf,kp0+sl_cur);
  WAIT_BAR(2);
  s16x4 vlo[8],vhi[8]; u32x4 pw0,pw1,pw2,pw3;
  #define PKW(P,B) cvtpk_s(P[B],P[B+1])
  #define PAF(k) __builtin_bit_cast(bf16x8,pw##k)
  #define VFR(i) (bf16x8){vlo[i][0],vlo[i][1],vlo[i][2],vlo[i][3],vhi[i][0],vhi[i][1],vhi[i][2],vhi[i][3]}
  #define PIN(x) asm volatile("":"+v"(x))
  #define MX3(a,b,c) __builtin_fmaxf(__builtin_fmaxf((a),(b)),(c))
  #define GAPA(MF,A0,A1,A2,A3,W0,W1,PW) do{ MF; sacc+=A0; sacc+=A1; sacc+=A2; sacc+=A3; PIN(sacc); W0; W1; PIN(PW); SBAR(); }while(0)
  #define EX(v) __builtin_amdgcn_exp2f(v)
  #define GAPB(MF,X,B,PRE) do{ MF; PRE; X[B]=EX(X[B]); X[B+1]=EX(X[B+1]); X[B+2]=EX(X[B+2]); X[B+3]=EX(X[B+3]); PIN(X); SBAR(); }while(0)
  #define PREF(P,g,nf4) do{ P[4*(g)]=vq_[0]-mhat; P[4*(g)+1]=vq_[1]-mhat; P[4*(g)+2]=vq_[2]-mhat; P[4*(g)+3]=vq_[3]-mhat; vq_=bpn_[nf4]; }while(0)
  #define VRD(i) do{ vlo[i]=vtr(vp_+(((i)>>2)*4096+((i)&3)*1024)); vhi[i]=vtr(vp_+(((i)>>2)*4096+((i)&3)*1024+512)); }while(0)
  #define KRD(G,j) do{ if(G){ kload2(kf,kp0+sl_next,j); SBAR(); } }while(0)
  #define STEP(C0,C1,P0,P1,t,GK,GV,GL) do{ SBAR(); \
    const lds_cptr vp_=vp0+sl_prev; \
    VRD(0); SBAR(); float sacc=(P0[0]+P0[1]); \
    GAPA(C0=__builtin_amdgcn_mfma_f32_32x32x16_bf16(kf[0],qr[0],C0,0,0,0), P0[2],P0[3],P0[4],P0[5],     pw0[0]=PKW(P0,0), pw0[1]=PKW(P0,2), pw0); \
    VRD(4); SBAR(); GAPA(C1=__builtin_amdgcn_mfma_f32_32x32x16_bf16(kf[1],qr[0],C1,0,0,0), P0[6],P0[7],P0[8],P0[9],     pw0[2]=PKW(P0,4), pw0[3]=PKW(P0,6), pw0); \
    VRD(1); SBAR(); GAPA(C0=__builtin_amdgcn_mfma_f32_32x32x16_bf16(kf[2],qr[1],C0,0,0,0),   P0[10],P0[11],P0[12],P0[13], pw1[0]=PKW(P0,8), pw1[1]=PKW(P0,10), pw1); \
    VRD(5); SBAR(); GAPA(C1=__builtin_amdgcn_mfma_f32_32x32x16_bf16(kf[3],qr[1],C1,0,0,0),   P0[14],P0[15],P1[0],P1[1],   pw1[2]=PKW(P0,12),pw1[3]=PKW(P0,14), pw1); \
    VRD(2); SBAR(); GAPA(C0=__builtin_amdgcn_mfma_f32_32x32x16_bf16(kf[4],qr[2],C0,0,0,0),   P1[2],P1[3],P1[4],P1[5],     pw2[0]=PKW(P1,0), pw2[1]=PKW(P1,2), pw2); \
    VRD(6); SBAR(); GAPA(C1=__builtin_amdgcn_mfma_f32_32x32x16_bf16(kf[5],qr[2],C1,0,0,0),   P1[6],P1[7],P1[8],P1[9],     pw2[2]=PKW(P1,4), pw2[3]=PKW(P1,6), pw2); \
    VRD(3); SBAR(); GAPA(C0=__builtin_amdgcn_mfma_f32_32x32x16_bf16(kf[6],qr[3],C0,0,0,0),   P1[10],P1[11],P1[12],P1[13], pw3[0]=PKW(P1,8), pw3[1]=PKW(P1,10), pw3); \
    VRD(7); SBAR(); GAPA(C1=__builtin_amdgcn_mfma_f32_32x32x16_bf16(kf[7],qr[3],C1,0,0,0),   P1[14],P1[15],0.f,0.f,       pw3[2]=PKW(P1,12),pw3[3]=PKW(P1,14), pw3); \
    l_reg+=sacc; \
    if(GK){DMA_K((t)+3,sl_cur);} if(GV){DMA_V((t)+1,sl_next);} \
    CMASK(C0,C1,t); \
    { float a=MX3(C0[0],C0[1],C1[0]),b=MX3(C0[2],C0[3],C1[1]); a=MX3(a,C1[2],C1[3]); \
      _Pragma("unroll") for(int r=4;r<16;r+=4){a=MX3(a,C0[r],C0[r+1]);b=MX3(b,C0[r+2],C0[r+3]);a=MX3(a,C1[r],C1[r+1]);b=MX3(b,C1[r+2],C1[r+3]);} \
      float rm=__builtin_fmaxf(a,b); { auto rr=__builtin_amdgcn_permlane32_swap(__float_as_uint(rm),__float_as_uint(rm),false,false); rm=__builtin_fmaxf(__uint_as_float(rr[0]),__uint_as_float(rr[1])); } \
      resc=false; \
      if(__builtin_expect(__any(rm>(float)THRL),0)){ const float dl=__builtin_fmaxf(rm,0.f); mhat+=dl; \
        _Pragma("unroll") for(int r=0;r<16;++r){C0[r]-=dl;C1[r]-=dl;} \
        const float f=__builtin_amdgcn_exp2f(-dl); l_reg*=f; if(hi==0)wsf[r32]=f; resc=true; } } \
    const lds_f4ptr bpn_=(lds_f4ptr)(bl+((t)+1)*64+4*hi); f32x4_t vq_=bpn_[0]; \
    SBAR(); \
    GAPB(o[0]=__builtin_amdgcn_mfma_f32_32x32x16_bf16(PAF(0),VFR(0),o[0],0,0,0), C0,0, PREF(P0,0,2)); \
    GAPB(o[1]=__builtin_amdgcn_mfma_f32_32x32x16_bf16(PAF(0),VFR(4),o[1],0,0,0), C0,4, PREF(P0,1,4)); \
    KRD(GL,0); GAPB(o[0]=__builtin_amdgcn_mfma_f32_32x32x16_bf16(PAF(1),VFR(1),o[0],0,0,0), C0,8, PREF(P0,2,6)); \
    KRD(GL,1); GAPB(o[1]=__builtin_amdgcn_mfma_f32_32x32x16_bf16(PAF(1),VFR(5),o[1],0,0,0), C0,12, PREF(P0,3,8)); \
    KRD(GL,2); GAPB(o[0]=__builtin_amdgcn_mfma_f32_32x32x16_bf16(PAF(2),VFR(2),o[0],0,0,0), C1,0, PREF(P1,0,10)); \
    KRD(GL,3); GAPB(o[1]=__builtin_amdgcn_mfma_f32_32x32x16_bf16(PAF(2),VFR(6),o[1],0,0,0), C1,4, PREF(P1,1,12)); \
    GAPB(o[0]=__builtin_amdgcn_mfma_f32_32x32x16_bf16(PAF(3),VFR(3),o[0],0,0,0), C1,8, PREF(P1,2,14)); \
    GAPB(o[1]=__builtin_amdgcn_mfma_f32_32x32x16_bf16(PAF(3),VFR(7),o[1],0,0,0), C1,12, PREF(P1,3,14)); \
    }while(0)
  int t=1;
  #undef CMASK
  #define CMASK(P0,P1,t) do{}while(0)
  for(;t+5<NT;t+=2){
    STEP(pB0,pB1,pA0,pA1,t,true,true,true);     WAIT_BAR(2); RESC(); ROT();
    STEP(pA0,pA1,pB0,pB1,t+1,true,true,true);   WAIT_BAR(2); RESC(); ROT();
  }
  #undef CMASK
  #define CMASK(P0,P1,t) do{int jb_=(t)-(NT-4); if(jb_>=0)cmask(P0,P1,jb_,qrel,hi);}while(0)
  #define ENDW(tt) do{ if((tt)+3<NT){WAIT_BAR(2);} else if((tt)+2<NT){WAIT_BAR(1);} else {WAIT_BAR(0);} }while(0)
  for(;t+1<NT;t+=2){
    STEP(pB0,pB1,pA0,pA1,t,(t+3<NT),(t+1<NT),(t+1<NT));       ENDW(t);   RESC(); ROT();
    STEP(pA0,pA1,pB0,pB1,t+1,(t+4<NT),(t+2<NT),(t+2<NT));     ENDW(t+1); RESC(); ROT();
  }
  STEP(pB0,pB1,pA0,pA1,NT-1,false,false,false); RESC();
  { float sacc=pB0[0]+pB0[1]; _Pragma("unroll") for(int r=2;r<16;++r)sacc+=pB0[r]; _Pragma("unroll") for(int r=0;r<16;++r)sacc+=pB1[r]; l_reg+=sacc;
    pw0=(u32x4){PKW(pB0,0),PKW(pB0,2),PKW(pB0,4),PKW(pB0,6)};pw1=(u32x4){PKW(pB0,8),PKW(pB0,10),PKW(pB0,12),PKW(pB0,14)};pw2=(u32x4){PKW(pB1,0),PKW(pB1,2),PKW(pB1,4),PKW(pB1,6)};pw3=(u32x4){PKW(pB1,8),PKW(pB1,10),PKW(pB1,12),PKW(pB1,14)};
    SBAR(); pv(o,vb0+sl_cur,PAF(0),PAF(1),PAF(2),PAF(3)); }
  #undef PKW
  #undef PAF
  #undef VFR
  #undef PIN
  #undef MX3
  #undef GAPA
  #undef GAPB
  #undef PREF
  #undef EX
  #undef VRD
  #undef KRD
  #undef STEP
  #undef ENDW
  {auto rr=__builtin_amdgcn_permlane32_swap(__float_as_uint(l_reg),__float_as_uint(l_reg),false,false);l_reg=__uint_as_float(rr[0])+__uint_as_float(rr[1]);}
  if(hi==0)wsf[32+r32]=l_reg;asm volatile("s_waitcnt lgkmcnt(0)":::"memory");
  float rli[16];
  #pragma unroll
  for(int r=0;r<16;++r)rli[r]=__builtin_amdgcn_rcpf(wsf[32+crow(r,hi)]);
  bf16*Ow=O+(rowbase+q0+wid*QBLK)*DM+h*D;
  { bf16*stg=(bf16*)(shm+LDS_OST)+wid*2048;
    #pragma unroll
    for(int r=0;r<16;++r){const int orow=crow(r,hi);
      #pragma unroll
      for(int d0=0;d0<2;++d0)stg[orow*64+d0*32+r32]=__float2bfloat16(o[d0][r]*rli[r]);}
    asm volatile("s_waitcnt lgkmcnt(0)":::"memory");
    #pragma unroll
    for(int i=0;i<4;++i){const int row=i*8+(lane>>3),ch=lane&7; const u32x4 v=*(const u32x4*)(stg+row*64+ch*8); ATTN_STORE16(Ow+(long)row*DM+ch*8,v);} }
  asm volatile("s_waitcnt lgkmcnt(0)\n\ts_barrier":::"memory");
  #undef DMA_K
  #undef DMA_V
  #undef CMASK
  #undef START
  #undef RESC
  #undef ROT
}
constexpr int ATTN_LDS_BYTES=LDS_BYTES;
struct AttnTensors { const bf16* Q; const bf16* K; const bf16* V; bf16* O; };
struct AttnUnit { int bh; int qb; };
struct StaticOrder {
  int vcu, G;
  __device__ __forceinline__ explicit StaticOrder(int grid,int block):vcu((grid%8==0)?(block%8)*(grid/8)+block/8:block),G(grid){}
  __device__ __forceinline__ bool next(int i,AttnUnit&u)const{
    if(G==256){ if(i>=8)return false; const int s=vcu&3; u.bh=vcu>>2; const int base=8*(i>>1); u.qb=(i&1)?base+7-s:base+s; return true; }
    const int L=i*G+vcu; if(L>=BATCH*NHEAD*NQB)return false; u.bh=L/NQB; u.qb=NQB-1-(L%NQB); return true; }
  __device__ __forceinline__ void a_ready(const AttnUnit&)const{}
  __device__ __forceinline__ void done(const AttnUnit&)const{}
};
constexpr float PRUNE_LOG2=40.0f;
template<int THRL=8> __device__ __forceinline__ void attn_phase_dyn(char*lds,const AttnTensors&T,const float*CB,const float*qg,const float*kg,unsigned*ctr){
  int tid=threadIdx.x; asm volatile("":"+v"(tid)); const int lane=tid&63;
  __attribute__((address_space(3))) int* sh=(__attribute__((address_space(3))) int*)(lds+LDS_BYTES+32768);
  float gq=fabsf(qg[lane]),gk=fabsf(kg[lane]);
  #pragma unroll
  for(int o=1;o<64;o<<=1){gq=fmaxf(gq,__shfl_xor(gq,o));gk=fmaxf(gk,__shfl_xor(gk,o));}
  const float thresh=2.0f*(8.25f*gq*gk*1.4426950408889634f)+PRUNE_LOG2;
  for(;;){
    __syncthreads();
    if(tid<64){ int ui=0; if(tid==0)ui=(int)atomicAdd(ctr,1u); ui=__shfl(ui,0);
      int t0=0;
      if(ui<BATCH*NHEAD*NQB){ const int qb=NQB-1-ui/(BATCH*NHEAD),bh=ui%(BATCH*NHEAD),q0=qb*QB,NT=(q0+QB)/KVBLK; const float*row=CB+(long)bh*SEQ; const float cq=row[q0];
        int cnt=0;
        #pragma unroll
        for(int j=0;j<2;++j){ const int t=lane+64*j; const bool p=(t<NT)&&(cq-row[t*64+63]>thresh); cnt+=__popcll(__ballot(p)); }
        t0=cnt&~1; if(t0>NT-4)t0=NT-4; }
      if(tid==0){sh[0]=ui;sh[1]=t0;} }
    __syncthreads();
    const int ui=sh[0],t0=sh[1];
    if(ui>=BATCH*NHEAD*NQB)break;
    const int qb=NQB-1-ui/(BATCH*NHEAD),bh=ui%(BATCH*NHEAD);
    { float*bl=(float*)(lds+LDS_BYTES); const f32x4_t*src=(const f32x4_t*)(CB+(long)bh*SEQ); const int lo=t0*16,hi4=(qb+1)*64;
      for(int j=lo+tid;j<hi4;j+=NW*64)((f32x4_t*)bl)[j]=src[j]; }
    __syncthreads();
    attn_unit<THRL>(bh/NHEAD,bh%NHEAD,qb,T.Q,T.K,T.V,T.O,lds,(lds_fptr)(lds+LDS_BYTES)+t0*64,t0);
  }
}
#undef BIAS
#undef PREFILL
#undef SBAR
#undef WAIT_BAR
}
#define LAS __attribute__((address_space(3)))
typedef unsigned short bfu;
typedef unsigned v4u __attribute__((ext_vector_type(4)));
typedef unsigned v2u __attribute__((ext_vector_type(2)));
typedef float f32x4 __attribute__((ext_vector_type(4)));
typedef float f32x2 __attribute__((ext_vector_type(2)));
typedef float f32x16 __attribute__((ext_vector_type(16)));
typedef short bf16x8 __attribute__((ext_vector_type(8)));
typedef __bf16 bf16x2_t __attribute__((ext_vector_type(2)));
constexpr int M = 32768, D = 1024, SEQ = 8192, NWV = 8, NTH = 512;
constexpr int EVEN_IN = 2576, EVEN_PAD = 2816, ODD_PAD = 3328, ODD_IN = 3088;
constexpr size_t MiB = 1u << 20;
constexpr size_t WS_SS = 0, WS_SSP = 1 * MiB, WS_LFT = 3 * MiB, WS_CB = 5 * MiB, WS_DEC = 7 * MiB, WS_USC = 7 * MiB + 512 * 1024, WS_BAR = 7 * MiB + 768 * 1024, WS_KEYS = 8 * MiB, WS_WINE = 9 * MiB, WS_WOUTE = 15 * MiB,
                 WS_WINO = 17 * MiB, WS_WOUTO = 24 * MiB, WS_WQ = 26 * MiB, WS_UV = 34 * MiB, WS_XB = 162 * MiB, WS_R1 = 226 * MiB, WS_R2 = 418 * MiB,
                 WS_EXP = 482 * MiB, WS_GATE = 490 * MiB, WS_END = 506 * MiB;
constexpr int LDS_BYTES = 147456;
constexpr float EPSF = 1e-6f;

__device__ __forceinline__ int tid_fresh() { int t = threadIdx.x; asm volatile("" : "+v"(t)); return t; }
__device__ __forceinline__ int bid_fresh() { int b = __builtin_amdgcn_workgroup_id_x(); asm volatile("" : "+s"(b)); return b; }
#define LDS_WAIT() asm volatile("s_waitcnt lgkmcnt(0)" ::: "memory")
__device__ __forceinline__ void lds_barrier() { asm volatile("s_waitcnt lgkmcnt(0)\n\ts_barrier" ::: "memory"); }
__device__ __forceinline__ float bf2f(unsigned u16) { return __uint_as_float(u16 << 16); }
__device__ __forceinline__ float bflo(unsigned w) { return __uint_as_float(w << 16); }
__device__ __forceinline__ float bfhi(unsigned w) { return __uint_as_float(w & 0xffff0000u); }
__device__ __forceinline__ unsigned pk2(float lo, float hi) { f32x2 v = {lo, hi}; bf16x2_t b = __builtin_convertvector(v, bf16x2_t); return __builtin_bit_cast(unsigned, b); }
__device__ __forceinline__ unsigned short f2bf(float f) { return (unsigned short)(pk2(f, 0.f) & 0xffffu); }
__device__ __forceinline__ float wave_sum(float v) {
#pragma unroll
    for (int o = 1; o < 64; o <<= 1) v += __shfl_xor(v, o);
    return v;
}
__device__ __forceinline__ float sigmoidf_(float x) { return __builtin_amdgcn_rcpf(1.0f + __builtin_amdgcn_exp2f(-1.4426950408889634f * x)); }
__device__ __forceinline__ float logsigf_(float z) { return fminf(z, 0.f) - 0.69314718056f * __builtin_amdgcn_logf(1.0f + __builtin_amdgcn_exp2f(-1.4426950408889634f * fabsf(z))); }
__device__ __forceinline__ int crow(int r, int hi) { return (r & 3) + 8 * (r >> 2) + 4 * hi; }

__device__ __forceinline__ void transpose_item(const float* W, const float* gain, int K, int N, bfu* WT, LAS float* scr, int item, int nblk, int lane) {
    const int kb = item / nblk, nb = item % nblk, k0 = 64 * kb, n0 = 32 * nb; const int n = n0 + (lane & 31); const bool ok = n < N;
#pragma unroll 8
    for (int i = 0; i < 32; ++i) { const int kk = 2 * i + (lane >> 5); float v = 0.f; if (ok) { v = W[(size_t)(k0 + kk) * N + n]; if (gain) v *= gain[k0 + kk]; } scr[kk * 33 + (lane & 31)] = v; }
    LDS_WAIT();
    const int c = lane & 7;
#pragma unroll
    for (int j = 0; j < 4; ++j) { const int nn = (lane >> 3) + 8 * j; const LAS float* s = scr + (8 * c) * 33 + nn;
        v4u o; o.x = pk2(s[0 * 33], s[1 * 33]); o.y = pk2(s[2 * 33], s[3 * 33]); o.z = pk2(s[4 * 33], s[5 * 33]); o.w = pk2(s[6 * 33], s[7 * 33]);
        *(v4u*)(WT + (size_t)(n0 + nn) * K + k0 + 8 * c) = o; }
    LDS_WAIT();
}
__device__ __forceinline__ void cvt8(const float* src, bfu* dst) {
    const f32x4 a = *(const f32x4*)src, b = *(const f32x4*)(src + 4);
    v4u o; o.x = pk2(a[0], a[1]); o.y = pk2(a[2], a[3]); o.z = pk2(b[0], b[1]); o.w = pk2(b[2], b[3]); *(v4u*)dst = o;
}
__device__ __forceinline__ void p0_prologue(const float* const* in, unsigned char* ws, LAS unsigned char* lds, int G) {
    const int tid = tid_fresh(), lane = tid & 63, wave = tid >> 6; const int gw = bid_fresh() * NWV + wave, NGW = G * NWV;
    LAS float* scr = (LAS float*)(lds + wave * 16384);
    for (int st = 0; st < 3; ++st) { const int kind = (wave & 1) ? st : (st + 1) % 3;
    if (kind == 0) {
    const int I0 = 16 * (EVEN_PAD / 32), I1 = 16 * 32, I2 = 16 * (ODD_PAD / 32), I3 = 16 * 32, I4 = 16 * 64, I5 = 16 * 64;
    const int NIT = I0 + I1 + I2 + I3 + I4 + I5;
    for (int it = gw; it < NIT; it += NGW) {
        int r = it;
        if (r < I0) { transpose_item(in[2], in[1], 1024, EVEN_IN, (bfu*)(ws + WS_WINE), scr, r, EVEN_PAD / 32, lane); continue; } r -= I0;
        if (r < I1) { transpose_item(in[10], nullptr, 1024, 1024, (bfu*)(ws + WS_WOUTE), scr, r, 32, lane); continue; } r -= I1;
        if (r < I2) { transpose_item(in[12], in[11], 1024, ODD_IN, (bfu*)(ws + WS_WINO), scr, r, ODD_PAD / 32, lane); continue; } r -= I2;
        if (r < I3) { transpose_item(in[16], nullptr, 1024, 1024, (bfu*)(ws + WS_WOUTO), scr, r, 32, lane); continue; } r -= I3;
        if (r < I4) { transpose_item(in[18], in[17], 1024, 2048, (bfu*)(ws + WS_WQ), scr, r, 64, lane); continue; } r -= I4;
        transpose_item(in[18] + (size_t)1024 * 2048, in[17] + 1024, 1024, 2048, (bfu*)(ws + WS_WQ + 4 * MiB), scr, r, 64, lane);
    }
    } else if (kind == 1) {
    const int gt = bid_fresh() * NTH + tid, NGT = G * NTH;
    for (int r = gw; r < 65536; r += NGW) { const int chunk = r >> 14, row = r & 16383;
        const float* src = ((chunk & 1) ? in[21] : in[20]) + (size_t)(chunk >> 1) * 16777216 + (size_t)row * 1024 + 16 * lane;
        f32x4 a[4]; float mx = 0.f;
#pragma unroll
        for (int q = 0; q < 4; ++q) { a[q] = *(const f32x4*)(src + 4 * q); mx = fmaxf(mx, fmaxf(fmaxf(fabsf(a[q][0]), fabsf(a[q][1])), fmaxf(fabsf(a[q][2]), fabsf(a[q][3])))); }
#pragma unroll
        for (int o = 1; o < 64; o <<= 1) mx = fmaxf(mx, __shfl_xor(mx, o));
        const float scale = (mx > 0.f) ? mx * (1.0f / 127.0f) : 1.0f, inv = 1.0f / scale; const int off = 0;
        v4u o;
#pragma unroll
        for (int q = 0; q < 4; ++q) { unsigned w = 0;
#pragma unroll
            for (int k = 0; k < 4; ++k) { const int qi = (int)__builtin_rintf(a[q][k] * inv) + off; w |= ((unsigned)qi & 0xffu) << (8 * k); }
            o[q] = w; }
        if (chunk & 1) *(v4u*)(ws + WS_UV + (size_t)chunk * 16777216 + ((size_t)(lane >> 3) * 16384 + row) * 128 + 16 * (lane & 7)) = o;
        else *(v4u*)(ws + WS_UV + (size_t)chunk * 16777216 + (size_t)row * 1024 + 16 * lane) = o;
        if (lane == 0) ((float*)(ws + WS_USC))[r] = scale; }
    for (int g = gt; g < 65536; g += NGT) cvt8(in[19] + (size_t)g * 8, (bfu*)(ws + WS_KEYS) + (size_t)g * 8);
    } else {
    for (int m = gw; m < M; m += NGW) { const f32x4* xr = (const f32x4*)(in[0] + (size_t)m * D) + lane; v2u* o8 = (v2u*)((bfu*)(ws + WS_XB) + (size_t)m * D) + lane; float s = 0.f;
#pragma unroll
        for (int j = 0; j < 4; ++j) { const f32x4 v = xr[64 * j]; s += (v[0] * v[0] + v[1] * v[1]) + (v[2] * v[2] + v[3] * v[3]); v2u o; o.x = pk2(v[0], v[1]); o.y = pk2(v[2], v[3]); o8[64 * j] = o; }
        s = wave_sum(s); if (lane == 0) ((float*)(ws + WS_SS))[m] = s;     } }
}
}
__device__ __forceinline__ float row_rstd16(const float* ss, int row) { return pg8::row_rstd<16>(ss, row); }
__device__ __forceinline__ void conv_unit(const bfu* P, const float* cw, const float* cb, const float* lng, const float* lnb, bfu* Y, LAS unsigned char* lds, int unit) {
    const int tid = tid_fresh(), lane = tid & 63, wave = tid >> 6, c = tid; const int row0 = unit * 32, tseq0 = row0 & (SEQ - 1);
    LAS float* U = (LAS float*)lds;
    float u[62];
#pragma unroll
    for (int i = 0; i < 62; ++i) { const int trel = i - 30; float v = 0.f;
        if (tseq0 + trel >= 0) { const bfu* pr = P + (size_t)(row0 + trel) * EVEN_IN; const float val = bf2f(pr[c]), gate = bf2f(pr[512 + c]); v = val * sigmoidf_(gate); }
        u[i] = v; }
    float w[31];
#pragma unroll
    for (int j = 0; j < 31; ++j) w[j] = cw[j * 512 + c];
    const float bias = cb[c];
#pragma unroll
    for (int i = 0; i < 32; ++i) { float a = bias;
#pragma unroll
        for (int j = 0; j < 31; ++j) a += w[j] * u[i + j];
        U[i * 512 + c] = a; }
    lds_barrier();
    const f32x4 g0 = *(const f32x4*)(lng + 8 * lane), g1 = *(const f32x4*)(lng + 8 * lane + 4), b0 = *(const f32x4*)(lnb + 8 * lane), b1 = *(const f32x4*)(lnb + 8 * lane + 4);
#pragma unroll
    for (int q = 0; q < 4; ++q) { const int i = wave * 4 + q; const f32x4 v0 = *(const LAS f32x4*)(U + i * 512 + 8 * lane), v1 = *(const LAS f32x4*)(U + i * 512 + 8 * lane + 4);
        const float mean = wave_sum((v0[0] + v0[1]) + (v0[2] + v0[3]) + (v1[0] + v1[1]) + (v1[2] + v1[3])) * (1.f / 512.f);
        const f32x4 d0 = v0 - mean, d1 = v1 - mean;
        const float var = wave_sum((d0[0] * d0[0] + d0[1] * d0[1]) + (d0[2] * d0[2] + d0[3] * d0[3]) + (d1[0] * d1[0] + d1[1] * d1[1]) + (d1[2] * d1[2] + d1[3] * d1[3])) * (1.f / 512.f);
        const float rstd = __builtin_amdgcn_rsqf(var + EPSF);
        f32x4 o0 = d0 * rstd * g0 + b0, o1 = d1 * rstd * g1 + b1;
#pragma unroll
        for (int k = 0; k < 4; ++k) { o0[k] = o0[k] * sigmoidf_(o0[k]); o1[k] = o1[k] * sigmoidf_(o1[k]); }
        v4u o; o.x = pk2(o0[0], o0[1]); o.y = pk2(o0[2], o0[3]); o.z = pk2(o1[0], o1[1]); o.w = pk2(o1[2], o1[3]);
        *(v4u*)(Y + (size_t)(row0 + i) * D + 8 * lane) = o; }
    lds_barrier();
}

constexpr int GL_GLR = 0, GL_TOT = 4096, GL_B = 6144, GL_KT = 22528, GL_VT = 31744, GL_Q = 50176, GL_K = 59392, GL_ST = 68608, GL_AT = 87040, GL_O = 96256;
constexpr int GLD = 72;
__device__ __forceinline__ void gla_decay(const bfu* P, const float* gw2, const float* gb, LAS unsigned char* lds, int row0, int h, float (&bl)[8], float& blast) {
    const int tid = tid_fresh(), lane = tid & 63, wave = tid >> 6;
    LAS float* GLR = (LAS float*)(lds + GL_GLR); LAS float* TOT = (LAS float*)(lds + GL_TOT);
    { const int idx = tid * 2, t = idx >> 4, j = idx & 15; const unsigned w = *(const unsigned*)(P + (size_t)(row0 + t) * EVEN_IN + 2560 + j); GLR[idx] = bflo(w); GLR[idx + 1] = bfhi(w); }
    float w2[16];
#pragma unroll
    for (int j = 0; j < 16; ++j) w2[j] = gw2[j * 256 + h * 64 + lane];
    const float gbv = gb[h * 64 + lane];
    lds_barrier();
    float run = 0.f;
#pragma unroll
    for (int i = 0; i < 8; ++i) { const int t = wave * 8 + i; float z = gbv;
#pragma unroll
        for (int j4 = 0; j4 < 4; ++j4) { const f32x4 g = *(const LAS f32x4*)(GLR + t * 16 + 4 * j4); z += g[0] * w2[4 * j4] + g[1] * w2[4 * j4 + 1] + g[2] * w2[4 * j4 + 2] + g[3] * w2[4 * j4 + 3]; }
        run += logsigf_(z) * (1.0f / 16.0f); bl[i] = run; }
    TOT[wave * 64 + lane] = run;
    lds_barrier();
    float off = 0.f, tot = 0.f;
#pragma unroll
    for (int s = 0; s < 8; ++s) { const float v = TOT[s * 64 + lane]; if (s < wave) off += v; tot += v; }
#pragma unroll
    for (int i = 0; i < 8; ++i) bl[i] += off;
    blast = tot;
}
struct VtRaw { unsigned short e[2][8]; };
__device__ __forceinline__ void gla_load_vt(VtRaw& r, const bfu* P, int row0, int h, int tid) {
#pragma unroll
    for (int q = 0; q < 2; ++q) { const int p = tid + q * 512, vv = p & 127, sg = p >> 7; const bfu* src = P + (size_t)(row0 + 8 * sg) * EVEN_IN + 1536 + h * 128 + vv;
#pragma unroll
        for (int i = 0; i < 8; ++i) r.e[q][i] = src[(size_t)i * EVEN_IN]; }
}
__device__ __forceinline__ void gla_store_vt(const VtRaw& r, LAS unsigned char* lds, int tid) {
#pragma unroll
    for (int q = 0; q < 2; ++q) { const int p = tid + q * 512, vv = p & 127, sg = p >> 7; const unsigned short* e = r.e[q];
        v4u o; o.x = e[0] | ((unsigned)e[1] << 16); o.y = e[2] | ((unsigned)e[3] << 16); o.z = e[4] | ((unsigned)e[5] << 16); o.w = e[6] | ((unsigned)e[7] << 16);
        *(LAS v4u*)(lds + GL_VT + (vv * GLD + 8 * sg) * 2) = o; }
}
__device__ __forceinline__ bf16x8 lds_frag(LAS unsigned char* lds, int base, int row, int kofs) { return *(const LAS bf16x8*)(lds + base + (row * GLD + kofs) * 2); }

__device__ __forceinline__ void gla_g1_unit(const bfu* P, const float* gw2, const float* gb, float* ST, float* DEC, LAS unsigned char* lds, int ug) {
    const int tid = tid_fresh(), lane = tid & 63, wave = tid >> 6, r32 = lane & 31, hi = lane >> 5;
    const int bh = ug >> 7, n = ug & 127, b = bh >> 2, h = bh & 3, row0 = b * SEQ + 64 * n;
    VtRaw vraw; gla_load_vt(vraw, P, row0, h, tid); unsigned short kraw[8];
#pragma unroll
    for (int i = 0; i < 8; ++i) kraw[i] = P[(size_t)(row0 + wave * 8 + i) * EVEN_IN + 1280 + h * 64 + lane];
    float bl[8], blast; gla_decay(P, gw2, gb, lds, row0, h, bl, blast);
    { unsigned short e[8];
#pragma unroll
      for (int i = 0; i < 8; ++i) { const float kv = bf2f(kraw[i]); e[i] = f2bf(kv * __expf(blast - bl[i])); }
      v4u o; o.x = e[0] | ((unsigned)e[1] << 16); o.y = e[2] | ((unsigned)e[3] << 16); o.z = e[4] | ((unsigned)e[5] << 16); o.w = e[6] | ((unsigned)e[7] << 16);
      *(LAS v4u*)(lds + GL_KT + (lane * GLD + 8 * wave) * 2) = o;
      if (wave == 0) DEC[(size_t)ug * 64 + lane] = __expf(blast); }
    gla_store_vt(vraw, lds, tid);
    lds_barrier();
    const int vb = wave >> 1, kb = wave & 1; f32x16 acc = {};
#pragma unroll
    for (int ks = 0; ks < 4; ++ks) acc = __builtin_amdgcn_mfma_f32_32x32x16_bf16(lds_frag(lds, GL_VT, vb * 32 + r32, 16 * ks + 8 * hi), lds_frag(lds, GL_KT, kb * 32 + r32, 16 * ks + 8 * hi), acc, 0, 0, 0);
    float* dst = ST + (size_t)ug * 8192 + kb * 32 + r32;
#pragma unroll
    for (int r = 0; r < 16; ++r) dst[(vb * 32 + crow(r, hi)) * 64] = acc[r];
    lds_barrier();
}
__device__ __forceinline__ void gla_g2(float* ST, const float* DEC, int G) {
    for (int gid = bid_fresh() * NTH + tid_fresh(); gid < 16 * 8192; gid += G * NTH) { const int bh = gid >> 13, e = gid & 8191, kk = e & 63;
        float* p = ST + (size_t)bh * 128 * 8192 + e; const float* d = DEC + (size_t)bh * 128 * 64 + kk; float s = 0.f;
        for (int n0 = 0; n0 < 128; n0 += 8) { float loc[8], dc[8];
#pragma unroll
            for (int i = 0; i < 8; ++i) { loc[i] = p[(size_t)(n0 + i) * 8192]; dc[i] = d[(n0 + i) * 64]; }
#pragma unroll
            for (int i = 0; i < 8; ++i) { p[(size_t)(n0 + i) * 8192] = s; s = s * dc[i] + loc[i]; } } }
}
__device__ __forceinline__ void gla_g3_unit(const bfu* P, const float* gw2, const float* gb, const float* ng, const float* ST, bfu* Y, LAS unsigned char* lds, int ug) {
    const int tid = tid_fresh(), lane = tid & 63, wave = tid >> 6, r32 = lane & 31, hi = lane >> 5;
    const int bh = ug >> 7, n = ug & 127, b = bh >> 2, h = bh & 3, row0 = b * SEQ + 64 * n;
    VtRaw vraw; gla_load_vt(vraw, P, row0, h, tid); unsigned short qraw[8], kraw[8]; unsigned rraw[8]; f32x4 sraw[2][2];
#pragma unroll
    for (int i = 0; i < 8; ++i) { const int t = wave * 8 + i; const bfu* pr = P + (size_t)(row0 + t) * EVEN_IN + h * 64 + lane; qraw[i] = pr[1024]; kraw[i] = pr[1280];
        rraw[i] = *(const unsigned*)(P + (size_t)(row0 + t) * EVEN_IN + 2048 + h * 128 + 2 * lane); }
#pragma unroll
    for (int q = 0; q < 2; ++q) { const int gq = tid + q * 512, vv = gq >> 3, k8 = (gq & 7) * 8; const float* src = ST + (size_t)ug * 8192 + vv * 64 + k8; sraw[q][0] = *(const f32x4*)src; sraw[q][1] = *(const f32x4*)(src + 4); }
    float bl[8], blast; gla_decay(P, gw2, gb, lds, row0, h, bl, blast);
#pragma unroll
    for (int i = 0; i < 8; ++i) { const int t = wave * 8 + i;
        const float qv = bf2f(qraw[i]) * 0.125f * __expf(bl[i]), kv = bf2f(kraw[i]) * __expf(-bl[i]);
        *(LAS unsigned short*)(lds + GL_Q + (t * GLD + lane) * 2) = f2bf(qv); *(LAS unsigned short*)(lds + GL_K + (t * GLD + lane) * 2) = f2bf(kv); }
    gla_store_vt(vraw, lds, tid);
#pragma unroll
    for (int q = 0; q < 2; ++q) { const int g = tid + q * 512, vv = g >> 3, k8 = (g & 7) * 8;
        const f32x4 a = sraw[q][0], c = sraw[q][1]; v4u o; o.x = pk2(a[0], a[1]); o.y = pk2(a[2], a[3]); o.z = pk2(c[0], c[1]); o.w = pk2(c[2], c[3]);
        *(LAS v4u*)(lds + GL_ST + (vv * GLD + k8) * 2) = o; }
    lds_barrier();
    if (wave < 4) { const int tb = wave >> 1, sb = wave & 1; f32x16 acc = {};
        if (sb <= tb) {
#pragma unroll
            for (int ks = 0; ks < 4; ++ks) acc = __builtin_amdgcn_mfma_f32_32x32x16_bf16(lds_frag(lds, GL_Q, tb * 32 + r32, 16 * ks + 8 * hi), lds_frag(lds, GL_K, sb * 32 + r32, 16 * ks + 8 * hi), acc, 0, 0, 0);
        }
        const int s = sb * 32 + r32;
#pragma unroll
        for (int r = 0; r < 16; ++r) { const int t = tb * 32 + crow(r, hi); const float v = (s <= t) ? acc[r] : 0.f; *(LAS unsigned short*)(lds + GL_AT + (t * GLD + s) * 2) = f2bf(v); } }
    lds_barrier();
    { const int tb = wave >> 2, vb = wave & 3; f32x16 acc = {};
#pragma unroll
      for (int ks = 0; ks < 4; ++ks) acc = __builtin_amdgcn_mfma_f32_32x32x16_bf16(lds_frag(lds, GL_Q, tb * 32 + r32, 16 * ks + 8 * hi), lds_frag(lds, GL_ST, vb * 32 + r32, 16 * ks + 8 * hi), acc, 0, 0, 0);
#pragma unroll
      for (int ks = 0; ks < 4; ++ks) acc = __builtin_amdgcn_mfma_f32_32x32x16_bf16(lds_frag(lds, GL_AT, tb * 32 + r32, 16 * ks + 8 * hi), lds_frag(lds, GL_VT, vb * 32 + r32, 16 * ks + 8 * hi), acc, 0, 0, 0);
      LAS float* O = (LAS float*)(lds + GL_O);
#pragma unroll
      for (int r = 0; r < 16; ++r) O[(tb * 32 + crow(r, hi)) * 132 + vb * 32 + r32] = acc[r]; }
    lds_barrier();
    { const LAS float* O = (const LAS float*)(lds + GL_O); const f32x2 g = *(const f32x2*)(ng + 2 * lane);
#pragma unroll
      for (int i = 0; i < 8; ++i) { const int t = wave * 8 + i; const f32x2 o = *(const LAS f32x2*)(O + t * 132 + 2 * lane);
          const float rstd = __builtin_amdgcn_rsqf(wave_sum(o[0] * o[0] + o[1] * o[1]) * (1.f / 128.f) + EPSF);
          const unsigned rw = rraw[i]; const float r0 = bflo(rw), r1 = bfhi(rw);
          const float y0 = o[0] * rstd * g[0] * (r0 * sigmoidf_(r0)), y1 = o[1] * rstd * g[1] * (r1 * sigmoidf_(r1));
          *(unsigned*)(Y + (size_t)(row0 + t) * D + 512 + h * 128 + 2 * lane) = pk2(y0, y1); } }
    lds_barrier();
}

__device__ __forceinline__ float pair_max(float m) { auto rr = __builtin_amdgcn_permlane32_swap(__float_as_uint(m), __float_as_uint(m), false, false); return fmaxf(__uint_as_float(rr[0]), __uint_as_float(rr[1])); }
constexpr int TK_PITCH = 272;
__device__ __forceinline__ void top16_of_scores(const bfu* qp, const LAS unsigned char* kl, int hi, float (&top)[16]) {
    f32x16 acc[4] = {};
    bf16x8 bq[8];
#pragma unroll
    for (int ks = 0; ks < 8; ++ks) bq[ks] = *(const bf16x8*)(qp + 16 * ks);
#pragma unroll
    for (int ks = 0; ks < 8; ++ks) { bf16x8 ak[4];
#pragma unroll
        for (int kb = 0; kb < 4; ++kb) ak[kb] = *(const LAS bf16x8*)(kl + kb * 32 * TK_PITCH + 32 * ks);
#pragma unroll
        for (int kb = 0; kb < 4; ++kb) acc[kb] = __builtin_amdgcn_mfma_f32_32x32x16_bf16(ak[kb], bq[ks], acc[kb], 0, 0, 0);
        if (ks & 1) asm volatile("" ::: "memory"); }
    float val[64];
#pragma unroll
    for (int kb = 0; kb < 4; ++kb)
#pragma unroll
        for (int r = 0; r < 16; ++r) { const unsigned idx = 32 * kb + crow(r, hi); val[kb * 16 + r] = __uint_as_float((__float_as_uint(acc[kb][r]) & ~127u) | idx); }
#define CE_D(a,b) do{ const float hi_=fmaxf(a,b), lo_=fminf(a,b); a=hi_; b=lo_; }while(0)
    {
        CE_D(val[0],val[1]);
        CE_D(val[3],val[2]);
        CE_D(val[4],val[5]);
        CE_D(val[7],val[6]);
        CE_D(val[8],val[9]);
        CE_D(val[11],val[10]);
        CE_D(val[12],val[13]);
        CE_D(val[15],val[14]);
        CE_D(val[0],val[2]);
        CE_D(val[1],val[3]);
        CE_D(val[6],val[4]);
        CE_D(val[7],val[5]);
        CE_D(val[8],val[10]);
        CE_D(val[9],val[11]);
        CE_D(val[14],val[12]);
        CE_D(val[15],val[13]);
        CE_D(val[0],val[1]);
        CE_D(val[2],val[3]);
        CE_D(val[5],val[4]);
        CE_D(val[7],val[6]);
        CE_D(val[8],val[9]);
        CE_D(val[10],val[11]);
        CE_D(val[13],val[12]);
        CE_D(val[15],val[14]);
        CE_D(val[0],val[4]);
        CE_D(val[1],val[5]);
        CE_D(val[2],val[6]);
        CE_D(val[3],val[7]);
        CE_D(val[12],val[8]);
        CE_D(val[13],val[9]);
        CE_D(val[14],val[10]);
        CE_D(val[15],val[11]);
        CE_D(val[0],val[2]);
        CE_D(val[1],val[3]);
        CE_D(val[4],val[6]);
        CE_D(val[5],val[7]);
        CE_D(val[10],val[8]);
        CE_D(val[11],val[9]);
        CE_D(val[14],val[12]);
        CE_D(val[15],val[13]);
        CE_D(val[0],val[1]);
        CE_D(val[2],val[3]);
        CE_D(val[4],val[5]);
        CE_D(val[6],val[7]);
        CE_D(val[9],val[8]);
        CE_D(val[11],val[10]);
        CE_D(val[13],val[12]);
        CE_D(val[15],val[14]);
        CE_D(val[0],val[8]);
        CE_D(val[1],val[9]);
        CE_D(val[2],val[10]);
        CE_D(val[3],val[11]);
        CE_D(val[4],val[12]);
        CE_D(val[5],val[13]);
        CE_D(val[6],val[14]);
        CE_D(val[7],val[15]);
        CE_D(val[0],val[4]);
        CE_D(val[1],val[5]);
        CE_D(val[2],val[6]);
        CE_D(val[3],val[7]);
        CE_D(val[8],val[12]);
        CE_D(val[9],val[13]);
        CE_D(val[10],val[14]);
        CE_D(val[11],val[15]);
        CE_D(val[0],val[2]);
        CE_D(val[1],val[3]);
        CE_D(val[4],val[6]);
        CE_D(val[5],val[7]);
        CE_D(val[8],val[10]);
        CE_D(val[9],val[11]);
        CE_D(val[12],val[14]);
        CE_D(val[13],val[15]);
        CE_D(val[0],val[1]);
        CE_D(val[2],val[3]);
        CE_D(val[4],val[5]);
        CE_D(val[6],val[7]);
        CE_D(val[8],val[9]);
        CE_D(val[10],val[11]);
        CE_D(val[12],val[13]);
        CE_D(val[14],val[15]);
        CE_D(val[16],val[17]);
        CE_D(val[19],val[18]);
        CE_D(val[20],val[21]);
        CE_D(val[23],val[22]);
        CE_D(val[24],val[25]);
        CE_D(val[27],val[26]);
        CE_D(val[28],val[29]);
        CE_D(val[31],val[30]);
        CE_D(val[16],val[18]);
        CE_D(val[17],val[19]);
        CE_D(val[22],val[20]);
        CE_D(val[23],val[21]);
        CE_D(val[24],val[26]);
        CE_D(val[25],val[27]);
        CE_D(val[30],val[28]);
        CE_D(val[31],val[29]);
        CE_D(val[16],val[17]);
        CE_D(val[18],val[19]);
        CE_D(val[21],val[20]);
        CE_D(val[23],val[22]);
        CE_D(val[24],val[25]);
        CE_D(val[26],val[27]);
        CE_D(val[29],val[28]);
        CE_D(val[31],val[30]);
        CE_D(val[16],val[20]);
        CE_D(val[17],val[21]);
        CE_D(val[18],val[22]);
        CE_D(val[19],val[23]);
        CE_D(val[28],val[24]);
        CE_D(val[29],val[25]);
        CE_D(val[30],val[26]);
        CE_D(val[31],val[27]);
        CE_D(val[16],val[18]);
        CE_D(val[17],val[19]);
        CE_D(val[20],val[22]);
        CE_D(val[21],val[23]);
        CE_D(val[26],val[24]);
        CE_D(val[27],val[25]);
        CE_D(val[30],val[28]);
        CE_D(val[31],val[29]);
        CE_D(val[16],val[17]);
        CE_D(val[18],val[19]);
        CE_D(val[20],val[21]);
        CE_D(val[22],val[23]);
        CE_D(val[25],val[24]);
        CE_D(val[27],val[26]);
        CE_D(val[29],val[28]);
        CE_D(val[31],val[30]);
        CE_D(val[16],val[24]);
        CE_D(val[17],val[25]);
        CE_D(val[18],val[26]);
        CE_D(val[19],val[27]);
        CE_D(val[20],val[28]);
        CE_D(val[21],val[29]);
        CE_D(val[22],val[30]);
        CE_D(val[23],val[31]);
        CE_D(val[16],val[20]);
        CE_D(val[17],val[21]);
        CE_D(val[18],val[22]);
        CE_D(val[19],val[23]);
        CE_D(val[24],val[28]);
        CE_D(val[25],val[29]);
        CE_D(val[26],val[30]);
        CE_D(val[27],val[31]);
        CE_D(val[16],val[18]);
        CE_D(val[17],val[19]);
        CE_D(val[20],val[22]);
        CE_D(val[21],val[23]);
        CE_D(val[24],val[26]);
        CE_D(val[25],val[27]);
        CE_D(val[28],val[30]);
        CE_D(val[29],val[31]);
        CE_D(val[16],val[17]);
        CE_D(val[18],val[19]);
        CE_D(val[20],val[21]);
        CE_D(val[22],val[23]);
        CE_D(val[24],val[25]);
        CE_D(val[26],val[27]);
        CE_D(val[28],val[29]);
        CE_D(val[30],val[31]);
        CE_D(val[32],val[33]);
        CE_D(val[35],val[34]);
        CE_D(val[36],val[37]);
        CE_D(val[39],val[38]);
        CE_D(val[40],val[41]);
        CE_D(val[43],val[42]);
        CE_D(val[44],val[45]);
        CE_D(val[47],val[46]);
        CE_D(val[32],val[34]);
        CE_D(val[33],val[35]);
        CE_D(val[38],val[36]);
        CE_D(val[39],val[37]);
        CE_D(val[40],val[42]);
        CE_D(val[41],val[43]);
        CE_D(val[46],val[44]);
        CE_D(val[47],val[45]);
        CE_D(val[32],val[33]);
        CE_D(val[34],val[35]);
        CE_D(val[37],val[36]);
        CE_D(val[39],val[38]);
        CE_D(val[40],val[41]);
        CE_D(val[42],val[43]);
        CE_D(val[45],val[44]);
        CE_D(val[47],val[46]);
        CE_D(val[32],val[36]);
        CE_D(val[33],val[37]);
        CE_D(val[34],val[38]);
        CE_D(val[35],val[39]);
        CE_D(val[44],val[40]);
        CE_D(val[45],val[41]);
        CE_D(val[46],val[42]);
        CE_D(val[47],val[43]);
        CE_D(val[32],val[34]);
        CE_D(val[33],val[35]);
        CE_D(val[36],val[38]);
        CE_D(val[37],val[39]);
        CE_D(val[42],val[40]);
        CE_D(val[43],val[41]);
        CE_D(val[46],val[44]);
        CE_D(val[47],val[45]);
        CE_D(val[32],val[33]);
        CE_D(val[34],val[35]);
        CE_D(val[36],val[37]);
        CE_D(val[38],val[39]);
        CE_D(val[41],val[40]);
        CE_D(val[43],val[42]);
        CE_D(val[45],val[44]);
        CE_D(val[47],val[46]);
        CE_D(val[32],val[40]);
        CE_D(val[33],val[41]);
        CE_D(val[34],val[42]);
        CE_D(val[35],val[43]);
        CE_D(val[36],val[44]);
        CE_D(val[37],val[45]);
        CE_D(val[38],val[46]);
        CE_D(val[39],val[47]);
        CE_D(val[32],val[36]);
        CE_D(val[33],val[37]);
        CE_D(val[34],val[38]);
        CE_D(val[35],val[39]);
        CE_D(val[40],val[44]);
        CE_D(val[41],val[45]);
        CE_D(val[42],val[46]);
        CE_D(val[43],val[47]);
        CE_D(val[32],val[34]);
        CE_D(val[33],val[35]);
        CE_D(val[36],val[38]);
        CE_D(val[37],val[39]);
        CE_D(val[40],val[42]);
        CE_D(val[41],val[43]);
        CE_D(val[44],val[46]);
        CE_D(val[45],val[47]);
        CE_D(val[32],val[33]);
        CE_D(val[34],val[35]);
        CE_D(val[36],val[37]);
        CE_D(val[38],val[39]);
        CE_D(val[40],val[41]);
        CE_D(val[42],val[43]);
        CE_D(val[44],val[45]);
        CE_D(val[46],val[47]);
        CE_D(val[48],val[49]);
        CE_D(val[51],val[50]);
        CE_D(val[52],val[53]);
        CE_D(val[55],val[54]);
        CE_D(val[56],val[57]);
        CE_D(val[59],val[58]);
        CE_D(val[60],val[61]);
        CE_D(val[63],val[62]);
        CE_D(val[48],val[50]);
        CE_D(val[49],val[51]);
        CE_D(val[54],val[52]);
        CE_D(val[55],val[53]);
        CE_D(val[56],val[58]);
        CE_D(val[57],val[59]);
        CE_D(val[62],val[60]);
        CE_D(val[63],val[61]);
        CE_D(val[48],val[49]);
        CE_D(val[50],val[51]);
        CE_D(val[53],val[52]);
        CE_D(val[55],val[54]);
        CE_D(val[56],val[57]);
        CE_D(val[58],val[59]);
        CE_D(val[61],val[60]);
        CE_D(val[63],val[62]);
        CE_D(val[48],val[52]);
        CE_D(val[49],val[53]);
        CE_D(val[50],val[54]);
        CE_D(val[51],val[55]);
        CE_D(val[60],val[56]);
        CE_D(val[61],val[57]);
        CE_D(val[62],val[58]);
        CE_D(val[63],val[59]);
        CE_D(val[48],val[50]);
        CE_D(val[49],val[51]);
        CE_D(val[52],val[54]);
        CE_D(val[53],val[55]);
        CE_D(val[58],val[56]);
        CE_D(val[59],val[57]);
        CE_D(val[62],val[60]);
        CE_D(val[63],val[61]);
        CE_D(val[48],val[49]);
        CE_D(val[50],val[51]);
        CE_D(val[52],val[53]);
        CE_D(val[54],val[55]);
        CE_D(val[57],val[56]);
        CE_D(val[59],val[58]);
        CE_D(val[61],val[60]);
        CE_D(val[63],val[62]);
        CE_D(val[48],val[56]);
        CE_D(val[49],val[57]);
        CE_D(val[50],val[58]);
        CE_D(val[51],val[59]);
        CE_D(val[52],val[60]);
        CE_D(val[53],val[61]);
        CE_D(val[54],val[62]);
        CE_D(val[55],val[63]);
        CE_D(val[48],val[52]);
        CE_D(val[49],val[53]);
        CE_D(val[50],val[54]);
        CE_D(val[51],val[55]);
        CE_D(val[56],val[60]);
        CE_D(val[57],val[61]);
        CE_D(val[58],val[62]);
        CE_D(val[59],val[63]);
        CE_D(val[48],val[50]);
        CE_D(val[49],val[51]);
        CE_D(val[52],val[54]);
        CE_D(val[53],val[55]);
        CE_D(val[56],val[58]);
        CE_D(val[57],val[59]);
        CE_D(val[60],val[62]);
        CE_D(val[61],val[63]);
        CE_D(val[48],val[49]);
        CE_D(val[50],val[51]);
        CE_D(val[52],val[53]);
        CE_D(val[54],val[55]);
        CE_D(val[56],val[57]);
        CE_D(val[58],val[59]);
        CE_D(val[60],val[61]);
        CE_D(val[62],val[63]);
        val[0]=fmaxf(val[0],val[31]);
        val[1]=fmaxf(val[1],val[30]);
        val[2]=fmaxf(val[2],val[29]);
        val[3]=fmaxf(val[3],val[28]);
        val[4]=fmaxf(val[4],val[27]);
        val[5]=fmaxf(val[5],val[26]);
        val[6]=fmaxf(val[6],val[25]);
        val[7]=fmaxf(val[7],val[24]);
        val[8]=fmaxf(val[8],val[23]);
        val[9]=fmaxf(val[9],val[22]);
        val[10]=fmaxf(val[10],val[21]);
        val[11]=fmaxf(val[11],val[20]);
        val[12]=fmaxf(val[12],val[19]);
        val[13]=fmaxf(val[13],val[18]);
        val[14]=fmaxf(val[14],val[17]);
        val[15]=fmaxf(val[15],val[16]);
        CE_D(val[0],val[8]);
        CE_D(val[1],val[9]);
        CE_D(val[2],val[10]);
        CE_D(val[3],val[11]);
        CE_D(val[4],val[12]);
        CE_D(val[5],val[13]);
        CE_D(val[6],val[14]);
        CE_D(val[7],val[15]);
        CE_D(val[0],val[4]);
        CE_D(val[1],val[5]);
        CE_D(val[2],val[6]);
        CE_D(val[3],val[7]);
        CE_D(val[8],val[12]);
        CE_D(val[9],val[13]);
        CE_D(val[10],val[14]);
        CE_D(val[11],val[15]);
        CE_D(val[0],val[2]);
        CE_D(val[1],val[3]);
        CE_D(val[4],val[6]);
        CE_D(val[5],val[7]);
        CE_D(val[8],val[10]);
        CE_D(val[9],val[11]);
        CE_D(val[12],val[14]);
        CE_D(val[13],val[15]);
        CE_D(val[0],val[1]);
        CE_D(val[2],val[3]);
        CE_D(val[4],val[5]);
        CE_D(val[6],val[7]);
        CE_D(val[8],val[9]);
        CE_D(val[10],val[11]);
        CE_D(val[12],val[13]);
        CE_D(val[14],val[15]);
        val[32]=fmaxf(val[32],val[63]);
        val[33]=fmaxf(val[33],val[62]);
        val[34]=fmaxf(val[34],val[61]);
        val[35]=fmaxf(val[35],val[60]);
        val[36]=fmaxf(val[36],val[59]);
        val[37]=fmaxf(val[37],val[58]);
        val[38]=fmaxf(val[38],val[57]);
        val[39]=fmaxf(val[39],val[56]);
        val[40]=fmaxf(val[40],val[55]);
        val[41]=fmaxf(val[41],val[54]);
        val[42]=fmaxf(val[42],val[53]);
        val[43]=fmaxf(val[43],val[52]);
        val[44]=fmaxf(val[44],val[51]);
        val[45]=fmaxf(val[45],val[50]);
        val[46]=fmaxf(val[46],val[49]);
        val[47]=fmaxf(val[47],val[48]);
        CE_D(val[32],val[40]);
        CE_D(val[33],val[41]);
        CE_D(val[34],val[42]);
        CE_D(val[35],val[43]);
        CE_D(val[36],val[44]);
        CE_D(val[37],val[45]);
        CE_D(val[38],val[46]);
        CE_D(val[39],val[47]);
        CE_D(val[32],val[36]);
        CE_D(val[33],val[37]);
        CE_D(val[34],val[38]);
        CE_D(val[35],val[39]);
        CE_D(val[40],val[44]);
        CE_D(val[41],val[45]);
        CE_D(val[42],val[46]);
        CE_D(val[43],val[47]);
        CE_D(val[32],val[34]);
        CE_D(val[33],val[35]);
        CE_D(val[36],val[38]);
        CE_D(val[37],val[39]);
        CE_D(val[40],val[42]);
        CE_D(val[41],val[43]);
        CE_D(val[44],val[46]);
        CE_D(val[45],val[47]);
        CE_D(val[32],val[33]);
        CE_D(val[34],val[35]);
        CE_D(val[36],val[37]);
        CE_D(val[38],val[39]);
        CE_D(val[40],val[41]);
        CE_D(val[42],val[43]);
        CE_D(val[44],val[45]);
        CE_D(val[46],val[47]);
        val[0]=fmaxf(val[0],val[47]);
        val[1]=fmaxf(val[1],val[46]);
        val[2]=fmaxf(val[2],val[45]);
        val[3]=fmaxf(val[3],val[44]);
        val[4]=fmaxf(val[4],val[43]);
        val[5]=fmaxf(val[5],val[42]);
        val[6]=fmaxf(val[6],val[41]);
        val[7]=fmaxf(val[7],val[40]);
        val[8]=fmaxf(val[8],val[39]);
        val[9]=fmaxf(val[9],val[38]);
        val[10]=fmaxf(val[10],val[37]);
        val[11]=fmaxf(val[11],val[36]);
        val[12]=fmaxf(val[12],val[35]);
        val[13]=fmaxf(val[13],val[34]);
        val[14]=fmaxf(val[14],val[33]);
        val[15]=fmaxf(val[15],val[32]);
        CE_D(val[0],val[8]);
        CE_D(val[1],val[9]);
        CE_D(val[2],val[10]);
        CE_D(val[3],val[11]);
        CE_D(val[4],val[12]);
        CE_D(val[5],val[13]);
        CE_D(val[6],val[14]);
        CE_D(val[7],val[15]);
        CE_D(val[0],val[4]);
        CE_D(val[1],val[5]);
        CE_D(val[2],val[6]);
        CE_D(val[3],val[7]);
        CE_D(val[8],val[12]);
        CE_D(val[9],val[13]);
        CE_D(val[10],val[14]);
        CE_D(val[11],val[15]);
        CE_D(val[0],val[2]);
        CE_D(val[1],val[3]);
        CE_D(val[4],val[6]);
        CE_D(val[5],val[7]);
        CE_D(val[8],val[10]);
        CE_D(val[9],val[11]);
        CE_D(val[12],val[14]);
        CE_D(val[13],val[15]);
        CE_D(val[0],val[1]);
        CE_D(val[2],val[3]);
        CE_D(val[4],val[5]);
        CE_D(val[6],val[7]);
        CE_D(val[8],val[9]);
        CE_D(val[10],val[11]);
        CE_D(val[12],val[13]);
        CE_D(val[14],val[15]);
        { auto r_=__builtin_amdgcn_permlane32_swap(__float_as_uint(val[15]),__float_as_uint(val[15]),false,false); const float p_=__uint_as_float(hi?r_[0]:r_[1]); top[0]=fmaxf(val[0],p_); }
        { auto r_=__builtin_amdgcn_permlane32_swap(__float_as_uint(val[14]),__float_as_uint(val[14]),false,false); const float p_=__uint_as_float(hi?r_[0]:r_[1]); top[1]=fmaxf(val[1],p_); }
        { auto r_=__builtin_amdgcn_permlane32_swap(__float_as_uint(val[13]),__float_as_uint(val[13]),false,false); const float p_=__uint_as_float(hi?r_[0]:r_[1]); top[2]=fmaxf(val[2],p_); }
        { auto r_=__builtin_amdgcn_permlane32_swap(__float_as_uint(val[12]),__float_as_uint(val[12]),false,false); const float p_=__uint_as_float(hi?r_[0]:r_[1]); top[3]=fmaxf(val[3],p_); }
        { auto r_=__builtin_amdgcn_permlane32_swap(__float_as_uint(val[11]),__float_as_uint(val[11]),false,false); const float p_=__uint_as_float(hi?r_[0]:r_[1]); top[4]=fmaxf(val[4],p_); }
        { auto r_=__builtin_amdgcn_permlane32_swap(__float_as_uint(val[10]),__float_as_uint(val[10]),false,false); const float p_=__uint_as_float(hi?r_[0]:r_[1]); top[5]=fmaxf(val[5],p_); }
        { auto r_=__builtin_amdgcn_permlane32_swap(__float_as_uint(val[9]),__float_as_uint(val[9]),false,false); const float p_=__uint_as_float(hi?r_[0]:r_[1]); top[6]=fmaxf(val[6],p_); }
        { auto r_=__builtin_amdgcn_permlane32_swap(__float_as_uint(val[8]),__float_as_uint(val[8]),false,false); const float p_=__uint_as_float(hi?r_[0]:r_[1]); top[7]=fmaxf(val[7],p_); }
        { auto r_=__builtin_amdgcn_permlane32_swap(__float_as_uint(val[7]),__float_as_uint(val[7]),false,false); const float p_=__uint_as_float(hi?r_[0]:r_[1]); top[8]=fmaxf(val[8],p_); }
        { auto r_=__builtin_amdgcn_permlane32_swap(__float_as_uint(val[6]),__float_as_uint(val[6]),false,false); const float p_=__uint_as_float(hi?r_[0]:r_[1]); top[9]=fmaxf(val[9],p_); }
        { auto r_=__builtin_amdgcn_permlane32_swap(__float_as_uint(val[5]),__float_as_uint(val[5]),false,false); const float p_=__uint_as_float(hi?r_[0]:r_[1]); top[10]=fmaxf(val[10],p_); }
        { auto r_=__builtin_amdgcn_permlane32_swap(__float_as_uint(val[4]),__float_as_uint(val[4]),false,false); const float p_=__uint_as_float(hi?r_[0]:r_[1]); top[11]=fmaxf(val[11],p_); }
        { auto r_=__builtin_amdgcn_permlane32_swap(__float_as_uint(val[3]),__float_as_uint(val[3]),false,false); const float p_=__uint_as_float(hi?r_[0]:r_[1]); top[12]=fmaxf(val[12],p_); }
        { auto r_=__builtin_amdgcn_permlane32_swap(__float_as_uint(val[2]),__float_as_uint(val[2]),false,false); const float p_=__uint_as_float(hi?r_[0]:r_[1]); top[13]=fmaxf(val[13],p_); }
        { auto r_=__builtin_amdgcn_permlane32_swap(__float_as_uint(val[1]),__float_as_uint(val[1]),false,false); const float p_=__uint_as_float(hi?r_[0]:r_[1]); top[14]=fmaxf(val[14],p_); }
        { auto r_=__builtin_amdgcn_permlane32_swap(__float_as_uint(val[0]),__float_as_uint(val[0]),false,false); const float p_=__uint_as_float(hi?r_[0]:r_[1]); top[15]=fmaxf(val[15],p_); }
        CE_D(top[0],top[8]);
        CE_D(top[1],top[9]);
        CE_D(top[2],top[10]);
        CE_D(top[3],top[11]);
        CE_D(top[4],top[12]);
        CE_D(top[5],top[13]);
        CE_D(top[6],top[14]);
        CE_D(top[7],top[15]);
        CE_D(top[0],top[4]);
        CE_D(top[1],top[5]);
        CE_D(top[2],top[6]);
        CE_D(top[3],top[7]);
        CE_D(top[8],top[12]);
        CE_D(top[9],top[13]);
        CE_D(top[10],top[14]);
        CE_D(top[11],top[15]);
        CE_D(top[0],top[2]);
        CE_D(top[1],top[3]);
        CE_D(top[4],top[6]);
        CE_D(top[5],top[7]);
        CE_D(top[8],top[10]);
        CE_D(top[9],top[11]);
        CE_D(top[12],top[14]);
        CE_D(top[13],top[15]);
        CE_D(top[0],top[1]);
        CE_D(top[2],top[3]);
        CE_D(top[4],top[5]);
        CE_D(top[6],top[7]);
        CE_D(top[8],top[9]);
        CE_D(top[10],top[11]);
        CE_D(top[12],top[13]);
        CE_D(top[14],top[15]);
    }
#undef CE_D
}
template <class Sched> __device__ __forceinline__ void peer_topk(const bfu* PQ, const bfu* KEYS, unsigned short* EXP, float* GATE, LAS unsigned char* lds, const Sched& S) {
    const int tid = tid_fresh(), lane = tid & 63, wave = tid >> 6, r32 = lane & 31, hi = lane >> 5;
    const LAS unsigned char* kl0 = lds + r32 * TK_PITCH + 16 * hi;
    pg8::Unit un;
    for (int ui = 0; S.next(ui, un); ++ui) { const int h = un.pn;
        __syncthreads();
        { const bfu* src = KEYS + (size_t)h * 32768;
#pragma unroll
          for (int q = 0; q < 8; ++q) { const int c = tid + q * 512, row = c >> 4, piece = c & 15; *(LAS v4u*)(lds + row * TK_PITCH + piece * 16) = *(const v4u*)(src + (size_t)c * 8); } }
        __syncthreads();
    { const int tile = un.pm * 8 + wave; const int tok = tile * 32 + r32;

        float v1[16], v2[16];
        top16_of_scores(PQ + (size_t)tok * 2048 + h * 256 + 8 * hi, kl0, hi, v1);
        top16_of_scores(PQ + (size_t)tok * 2048 + h * 256 + 128 + 8 * hi, kl0 + 128 * TK_PITCH, hi, v2);
        float cand[25]; unsigned pay[25];
#define CAND(c, a0, b0, a1, b1) do { const float s_ = hi ? (v1[a1] + v2[b1]) : (v1[a0] + v2[b0]); const unsigned code_ = hi ? (unsigned)((a1) * 16 + (b1)) : (unsigned)((a0) * 16 + (b0)); \
        cand[c] = __uint_as_float((__float_as_uint(s_) & ~255u) | code_); \
        pay[c] = hi ? (((__float_as_uint(v1[a1]) & 127u) << 7) | (__float_as_uint(v2[b1]) & 127u)) : (((__float_as_uint(v1[a0]) & 127u) << 7) | (__float_as_uint(v2[b0]) & 127u)); } while (0)
    CAND(0, 0, 0, 0, 1);
    CAND(1, 0, 2, 0, 3);
    CAND(2, 0, 4, 0, 5);
    CAND(3, 0, 6, 0, 7);
    CAND(4, 0, 8, 0, 9);
    CAND(5, 0, 10, 0, 11);
    CAND(6, 0, 12, 0, 13);
    CAND(7, 0, 14, 0, 15);
    CAND(8, 1, 0, 1, 1);
    CAND(9, 1, 2, 1, 3);
    CAND(10, 1, 4, 1, 5);
    CAND(11, 1, 6, 1, 7);
    CAND(12, 2, 0, 2, 1);
    CAND(13, 2, 2, 2, 3);
    CAND(14, 2, 4, 3, 0);
    CAND(15, 3, 1, 3, 2);
    CAND(16, 3, 3, 4, 0);
    CAND(17, 4, 1, 4, 2);
    CAND(18, 5, 0, 5, 1);
    CAND(19, 6, 0, 6, 1);
    CAND(20, 7, 0, 7, 1);
    CAND(21, 8, 0, 9, 0);
    CAND(22, 10, 0, 11, 0);
    CAND(23, 12, 0, 13, 0);
    CAND(24, 14, 0, 15, 0);
#undef CAND
        float sc[16]; unsigned ex[16];
#pragma unroll
        for (int i = 0; i < 16; ++i) { float m = cand[0];
#pragma unroll
            for (int j = 1; j < 25; ++j) m = fmaxf(m, cand[j]);
            m = pair_max(m); unsigned pl = 0u;
#pragma unroll
            for (int j = 0; j < 25; ++j) { const bool eq = (cand[j] == m); pl = eq ? pay[j] : pl; cand[j] = eq ? -INFINITY : cand[j]; }
            { auto rr = __builtin_amdgcn_permlane32_swap(pl, pl, false, false); pl = rr[0] | rr[1]; }
            sc[i] = m; ex[i] = pl; }
        float z = 0.f; const float scmax = sc[0];
#pragma unroll
        for (int i = 0; i < 16; ++i) { sc[i] = __expf(sc[i] - scmax); z += sc[i]; }
        const float rz = 1.0f / z;
        if (hi == 0) { v4u o0, o1; o0.x = ex[0] | (ex[1] << 16); o0.y = ex[2] | (ex[3] << 16); o0.z = ex[4] | (ex[5] << 16); o0.w = ex[6] | (ex[7] << 16);
            o1.x = ex[8] | (ex[9] << 16); o1.y = ex[10] | (ex[11] << 16); o1.z = ex[12] | (ex[13] << 16); o1.w = ex[14] | (ex[15] << 16);
            v4u* d = (v4u*)(EXP + (size_t)tok * 128 + h * 16); d[0] = o0; d[1] = o1; }
        else { f32x4* d = (f32x4*)(GATE + (size_t)tok * 128 + h * 16);
#pragma unroll
            for (int q = 0; q < 4; ++q) d[q] = (f32x4){sc[4 * q] * rz, sc[4 * q + 1] * rz, sc[4 * q + 2] * rz, sc[4 * q + 3] * rz}; } } }
}
#ifndef DBG_CUMSUM_REP
#define DBG_CUMSUM_REP 1
#endif
#ifndef DBG_GATHER_REP
#define DBG_GATHER_REP 1
#endif
__device__ __forceinline__ float gelu_erf(float x) { return 0.5f * x * (1.0f + erff(x * 0.70710678118654752f)); }
__device__ __forceinline__ float row16_sum(float v) {
    v += __builtin_bit_cast(float, __builtin_amdgcn_update_dpp(0, __builtin_bit_cast(int, v), 0x128, 0xf, 0xf, false));
    v += __builtin_bit_cast(float, __builtin_amdgcn_update_dpp(0, __builtin_bit_cast(int, v), 0x124, 0xf, 0xf, false));
    v += __builtin_bit_cast(float, __builtin_amdgcn_update_dpp(0, __builtin_bit_cast(int, v), 0x122, 0xf, 0xf, false));
    v += __builtin_bit_cast(float, __builtin_amdgcn_update_dpp(0, __builtin_bit_cast(int, v), 0x121, 0xf, 0xf, false));
    return v;
}
__device__ __forceinline__ float ub0(unsigned w) { return (float)(w & 0xffu); }
__device__ __forceinline__ float ub1(unsigned w) { return (float)((w >> 8) & 0xffu); }
__device__ __forceinline__ float ub2(unsigned w) { return (float)((w >> 16) & 0xffu); }
__device__ __forceinline__ float ub3(unsigned w) { return (float)(w >> 24); }
__device__ __forceinline__ float gelu_poly(float v) {
    const float av = fabsf(v), t = __builtin_amdgcn_rcpf(av * 0.2316418882f + 1.0f);
    float q = t * 0.5307027145f + (-0.7265760135f); q = q * t + 0.7107068705f; q = q * t + (-0.142248368f); q = q * t + 0.127414796f; q = q * t;
    const float m = v * (q * __builtin_amdgcn_exp2f(v * v * (-0.72134752044f)));
    return v < 0.f ? m : v - m;
}
__device__ __forceinline__ void peer_hq(const float* XF, const float* SSP, const float* gain, unsigned* HQ, float* SH, int G) {
    const int tid = tid_fresh(), lane = tid & 63, wave = tid >> 6; const int gw = bid_fresh() * NWV + wave, NGW = G * NWV;
    const f32x4 g0 = *(const f32x4*)(gain + 16 * lane), g1 = *(const f32x4*)(gain + 16 * lane + 4), g2 = *(const f32x4*)(gain + 16 * lane + 8), g3 = *(const f32x4*)(gain + 16 * lane + 12);
    for (int tok = gw; tok < M; tok += NGW) {
        const float rstd = row_rstd16(SSP, tok); const float* xr = XF + (size_t)tok * D + 16 * lane;
        const f32x4 a[4] = {*(const f32x4*)xr * rstd * g0, *(const f32x4*)(xr + 4) * rstd * g1, *(const f32x4*)(xr + 8) * rstd * g2, *(const f32x4*)(xr + 12) * rstd * g3};
        float mx = 0.f;
#pragma unroll
        for (int q = 0; q < 4; ++q) mx = fmaxf(mx, fmaxf(fmaxf(fabsf(a[q][0]), fabsf(a[q][1])), fmaxf(fabsf(a[q][2]), fabsf(a[q][3]))));
#pragma unroll
        for (int o = 1; o < 64; o <<= 1) mx = fmaxf(mx, __shfl_xor(mx, o));
        const float sh = (mx > 0.f) ? mx * (1.0f / 127.0f) : 1.0f, inv = 1.0f / sh;
        v4u oh, ol;
#pragma unroll
        for (int k = 0; k < 4; ++k) { unsigned wh = 0, wl = 0;
#pragma unroll
            for (int b = 0; b < 4; ++b) { const float t = a[k][b] * inv; const float qh = __builtin_rintf(t); const int ql = (int)__builtin_rintf((t - qh) * 128.0f);
                wh |= ((unsigned)(int)qh & 0xffu) << (8 * b); wl |= ((unsigned)ql & 0xffu) << (8 * b); }
            oh[k] = wh; ol[k] = wl; }
        unsigned* dst = HQ + (size_t)tok * 512 + (lane & 15) * 16 + (lane >> 4) * 4;
        *(v4u*)dst = oh;
        if (lane == 0) SH[tok] = sh;
    }
}
struct URow { v4u hh[4]; float sh, ga, gb; int ea, eb; };
__device__ __forceinline__ void urow_prefetch(URow& n, const unsigned* HQ, const float* SH, const unsigned short* EXP, const float* GATE, int tok, int j, int lane) {
    const unsigned* hq = HQ + (size_t)tok * 512 + j * 16;
#pragma unroll
    for (int q = 0; q < 4; ++q) n.hh[q] = *(const v4u*)(hq + 4 * q);
    n.sh = SH[tok]; n.ea = EXP[(size_t)tok * 128 + lane]; n.eb = EXP[(size_t)tok * 128 + 64 + lane]; n.ga = GATE[(size_t)tok * 128 + lane]; n.gb = GATE[(size_t)tok * 128 + 64 + lane];
}
__device__ __forceinline__ float urow_dot(const v4u (&w)[4], const v4u (&hh)[4]) {
    int dh = 0;
#pragma unroll
    for (int c = 0; c < 4; ++c)
#pragma unroll
        for (int k = 0; k < 4; ++k) dh = __builtin_amdgcn_sdot4((int)w[c][k], (int)hh[c][k], dh, false);
    return row16_sum((float)dh);
}
__device__ __forceinline__ void peer_u_rows(const unsigned* HQ, const float* SH, const unsigned char* U8, const float* USC, const float* VSC, const unsigned short* EXP, const float* GATE_WGT, float* WOUT,
                                            LAS unsigned char* lds, int G, int x, int sub) {
    const int tid = tid_fresh(), lane = tid & 63, wave = tid >> 6, j = lane & 15, g16 = lane >> 4;
    const int w8 = sub * NWV + wave, NW8 = (G >> 3) * NWV;
    LAS int* lst = (LAS int*)(lds + wave * 2048); LAS float* dbuf = (LAS float*)(lds + wave * 2048 + 512);
    const unsigned uoff0 = 16u * (unsigned)j;
    LAS float* usl = (LAS float*)(lds + 16384); LAS float* vsl = usl + 2048;
    { const int i4 = tid * 4; *(LAS f32x4*)(usl + i4) = *(const f32x4*)(USC + x * 2048 + i4); *(LAS f32x4*)(vsl + i4) = *(const f32x4*)(VSC + x * 2048 + i4); }
    __syncthreads();
    URow cur; if (w8 < M) urow_prefetch(cur, HQ, SH, EXP, GATE_WGT, w8, j, lane);
    for (int tok = w8; tok < M; tok += NW8) {
        v4u hh[4];
#pragma unroll
        for (int q = 0; q < 4; ++q) hh[q] = cur.hh[q];
        const float sh = cur.sh, ga = cur.ga, gb = cur.gb; const int ea = cur.ea, eb = cur.eb;
        const bool ina = (ea >> 11) == x, inb = (eb >> 11) == x;
        const unsigned long long ma = __ballot(ina), mb = __ballot(inb);
        const int na = __popcll(ma), n = na + __popcll(mb);
        const int pa = __builtin_amdgcn_mbcnt_hi((unsigned)(ma >> 32), __builtin_amdgcn_mbcnt_lo((unsigned)ma, 0u)), pb = na + __builtin_amdgcn_mbcnt_hi((unsigned)(mb >> 32), __builtin_amdgcn_mbcnt_lo((unsigned)mb, 0u));
        if (ina) lst[pa] = (ea << 8) | lane;
        if (inb) lst[pb] = (eb << 8) | (64 + lane);
        float usa = 0.f, vsa = 0.f, usb = 0.f, vsb = 0.f;
        if (ina) { usa = usl[ea & 2047]; vsa = vsl[ea & 2047]; }
        if (inb) { usb = usl[eb & 2047]; vsb = vsl[eb & 2047]; }
        LDS_WAIT();
        v4u w[6][4]; int ent[6];
#pragma unroll
        for (int it = 0; it < 6; ++it) { ent[it] = -1;
            if (4 * it < n) { const int idx = 4 * it + g16; if (idx < n) { ent[it] = lst[idx]; const unsigned char* rp = U8 + (uoff0 + (unsigned)(ent[it] >> 8) * 1024u);
#pragma unroll
                for (int c = 0; c < 4; ++c) w[it][c] = *(const v4u*)(rp + 256 * c); } } }
        if (tok + NW8 < M) urow_prefetch(cur, HQ, SH, EXP, GATE_WGT, tok + NW8, j, lane);
#pragma unroll
        for (int it = 0; it < 6; ++it) if (4 * it < n) { const float d = urow_dot(w[it], hh); if (j == 0 && ent[it] >= 0) dbuf[ent[it] & 255] = d; }
        for (int it = 6; 4 * it < n; ++it) { const int idx = 4 * it + g16; int e1 = -1; v4u w1[4] = {};
            if (idx < n) { e1 = lst[idx]; const unsigned char* rp = U8 + (uoff0 + (unsigned)(e1 >> 8) * 1024u);
#pragma unroll
                for (int c = 0; c < 4; ++c) w1[c] = *(const v4u*)(rp + 256 * c); }
            const float d = urow_dot(w1, hh); if (j == 0 && e1 >= 0) dbuf[e1 & 255] = d; }
        LDS_WAIT();
        if (ina) WOUT[(size_t)tok * 128 + lane] = ga * gelu_poly(dbuf[lane] * (sh * usa)) * vsa;
        if (inb) WOUT[(size_t)tok * 128 + 64 + lane] = gb * gelu_poly(dbuf[64 + lane] * (sh * usb)) * vsb;
        LDS_WAIT();
    }
}
__device__ __forceinline__ float sum_groups8(float v) {
    v += __builtin_bit_cast(float, __builtin_amdgcn_update_dpp(0, __builtin_bit_cast(int, v), 0x128, 0xf, 0xf, false));
    { auto r = __builtin_amdgcn_permlane16_swap(__float_as_uint(v), __float_as_uint(v), false, false); v = __uint_as_float(r[0]) + __uint_as_float(r[1]); }
    { auto r = __builtin_amdgcn_permlane32_swap(__float_as_uint(v), __float_as_uint(v), false, false); v = __uint_as_float(r[0]) + __uint_as_float(r[1]); }
    return v;
}
struct VPre { float wa, wb; int ea, eb; };
__device__ __forceinline__ void v_prefetch(VPre& n, const float* WGT, const unsigned short* EXP, int tok, int lane) {
    n.wa = WGT[(size_t)tok * 128 + lane]; n.wb = WGT[(size_t)tok * 128 + 64 + lane]; n.ea = EXP[(size_t)tok * 128 + lane]; n.eb = EXP[(size_t)tok * 128 + 64 + lane];
}
__device__ __forceinline__ void peer_v_slice(const float* XF, float* XO, const float* WGT, const unsigned char* V8T, const unsigned short* EXP,
                                             bfu* XB, float* SSP, LAS unsigned char* lds, int G, int x, int sub) {
    const int tid = tid_fresh(), lane = tid & 63, wave = tid >> 6, j8 = lane & 7, g8 = lane >> 3;
    const int w8 = sub * NWV + wave, NW8 = (G >> 3) * NWV;
    const unsigned voff0 = (unsigned)x * (16384u * 128u) + 16u * (unsigned)j8;
    const int wqa = (lane >> 5) * 32 + (lane & 7) * 4 + ((lane >> 3) & 3);
    const int coff = 128 * x + 16 * j8 + ((lane >> 5) & 1) * 8 + ((lane >> 4) & 1) * 4;
    VPre cur[2];
#pragma unroll
    for (int h = 0; h < 2; ++h) if (w8 + h * NW8 < M) v_prefetch(cur[h], WGT, EXP, w8 + h * NW8, lane);
    for (int tok0 = w8; tok0 < M; tok0 += 2 * NW8) {
        float sw[2]; v4u rows[2][16]; int wq[2][4]; f32x4 xin[2]; bool live[2];
#pragma unroll
        for (int h = 0; h < 2; ++h) { live[h] = (tok0 + h * NW8 < M);
            LAS int* ebuf = (LAS int*)(lds + wave * 2048 + h * 1024); LAS char* wq8 = (LAS char*)(lds + wave * 2048 + h * 1024 + 512);
            float wmax = fmaxf(fabsf(cur[h].wa), fabsf(cur[h].wb));
#pragma unroll
            for (int o = 1; o < 64; o <<= 1) wmax = fmaxf(wmax, __shfl_xor(wmax, o));
            sw[h] = (wmax > 0.f) ? wmax * (1.0f / 127.0f) : 1.0f; const float inv = 1.0f / sw[h];
            ebuf[lane] = cur[h].ea; ebuf[64 + lane] = cur[h].eb;
            wq8[wqa] = (char)(int)__builtin_rintf(cur[h].wa * inv); wq8[64 + wqa] = (char)(int)__builtin_rintf(cur[h].wb * inv); }
        LDS_WAIT();
#pragma unroll
        for (int h = 0; h < 2; ++h) if (live[h]) { const int tok = tok0 + h * NW8;
            LAS int* ebuf = (LAS int*)(lds + wave * 2048 + h * 1024); LAS char* wq8 = (LAS char*)(lds + wave * 2048 + h * 1024 + 512);
#pragma unroll
            for (int it = 0; it < 16; ++it) rows[h][it] = *(const v4u*)(V8T + (voff0 + (unsigned)ebuf[8 * it + g8] * 128u));
#pragma unroll
            for (int q = 0; q < 4; ++q) wq[h][q] = *(const LAS int*)(wq8 + q * 32 + g8 * 4);
            xin[h] = *(const f32x4*)(XF + (size_t)tok * D + coff); }
#pragma unroll
        for (int h = 0; h < 2; ++h) if (tok0 + (2 + h) * NW8 < M) v_prefetch(cur[h], WGT, EXP, tok0 + (2 + h) * NW8, lane);
#pragma unroll
        for (int h = 0; h < 2; ++h) if (live[h]) { const int tok = tok0 + h * NW8;
            int acc[16];
#pragma unroll
            for (int i = 0; i < 16; ++i) acc[i] = 0;
#pragma unroll
            for (int q = 0; q < 4; ++q)
#pragma unroll
                for (int k = 0; k < 4; ++k) { const unsigned A = rows[h][4 * q][k], B = rows[h][4 * q + 1][k], C = rows[h][4 * q + 2][k], Dd = rows[h][4 * q + 3][k];
                    const unsigned p0 = __builtin_amdgcn_perm(A, B, 0x01050004u), p1 = __builtin_amdgcn_perm(A, B, 0x03070206u), q0 = __builtin_amdgcn_perm(C, Dd, 0x01050004u), q1 = __builtin_amdgcn_perm(C, Dd, 0x03070206u);
                    const unsigned t0 = __builtin_amdgcn_perm(p0, q0, 0x01000504u), t1 = __builtin_amdgcn_perm(p0, q0, 0x03020706u), t2 = __builtin_amdgcn_perm(p1, q1, 0x01000504u), t3 = __builtin_amdgcn_perm(p1, q1, 0x03020706u);
                    acc[4 * k] = __builtin_amdgcn_sdot4((int)t0, wq[h][q], acc[4 * k], false); acc[4 * k + 1] = __builtin_amdgcn_sdot4((int)t1, wq[h][q], acc[4 * k + 1], false);
                    acc[4 * k + 2] = __builtin_amdgcn_sdot4((int)t2, wq[h][q], acc[4 * k + 2], false); acc[4 * k + 3] = __builtin_amdgcn_sdot4((int)t3, wq[h][q], acc[4 * k + 3], false); }
            int r8[8];
#pragma unroll
            for (int i = 0; i < 8; ++i) { auto r = __builtin_amdgcn_permlane32_swap((unsigned)acc[i], (unsigned)acc[i + 8], false, false); r8[i] = (int)r[0] + (int)r[1]; }
            f32x4 c4;
#pragma unroll
            for (int i = 0; i < 4; ++i) { auto r = __builtin_amdgcn_permlane16_swap((unsigned)r8[i], (unsigned)r8[i + 4], false, false); const int v = (int)r[0] + (int)r[1];
                c4[i] = (float)(v + __builtin_amdgcn_update_dpp(0, v, 0x128, 0xf, 0xf, false)) * sw[h]; }
            float ss = 0.f;
            if ((lane & 8) == 0) { const f32x4 o = xin[h] + c4;
                ss = (o[0] * o[0] + o[1] * o[1]) + (o[2] * o[2] + o[3] * o[3]);
                *(f32x4*)(XO + (size_t)tok * D + coff) = o;
                v2u b; b.x = pk2(o[0], o[1]); b.y = pk2(o[2], o[3]); *(v2u*)(XB + (size_t)tok * D + coff) = b; }
            ss = wave_sum(ss);
            if (lane == 0) { SSP[(size_t)tok * 16 + 2 * x] = ss; SSP[(size_t)tok * 16 + 2 * x + 1] = 0.f; } }
        LDS_WAIT();
    }
}
__device__ __forceinline__ void fox_prep(bfu* QKV, const float* qg, const float* kg, const float* LFT, float* CB, int G) {
    const int tid = tid_fresh(), lane = tid & 63, wave = tid >> 6; const int gw = bid_fresh() * NWV + wave, NGW = G * NWV;
    for (int crep = 0; crep < DBG_CUMSUM_REP; ++crep)
    if (wave == 0 && (bid_fresh() & 3) == 0 && (bid_fresh() >> 2) < 64 && G >= 256) {
        const int bh = bid_fresh() >> 2, b = bh >> 4, h = bh & 15; const float* src = LFT + (size_t)b * SEQ * 16 + h; float* dst = CB + (size_t)bh * SEQ; float carry = 0.f;
#pragma unroll 4
        for (int r = 0; r < 32; ++r) { const float* sp = src + (size_t)(256 * r + 4 * lane) * 16; const float p0 = logsigf_(sp[0]), p1 = p0 + logsigf_(sp[16]), p2 = p1 + logsigf_(sp[32]), p3 = p2 + logsigf_(sp[48]);
            float inc = p3;
#pragma unroll
            for (int o = 1; o < 64; o <<= 1) { const float t = __shfl_up(inc, o); if (lane >= o) inc += t; }
            const float base = carry + (inc - p3); const float k = -1.4426950408889634f;
            *(f32x4*)(dst + 256 * r + 4 * lane) = (f32x4){k * (base + p0), k * (base + p1), k * (base + p2), k * (base + p3)};
            carry += __shfl(inc, 63); }
    } else if (G < 256 && gw < 64) {
        const int bh = gw, b = bh >> 4, h = bh & 15; const float* src = LFT + (size_t)b * SEQ * 16 + h; float* dst = CB + (size_t)bh * SEQ; float carry = 0.f;
        for (int r = 0; r < 32; ++r) { const float* sp = src + (size_t)(256 * r + 4 * lane) * 16; const float p0 = logsigf_(sp[0]), p1 = p0 + logsigf_(sp[16]), p2 = p1 + logsigf_(sp[32]), p3 = p2 + logsigf_(sp[48]);
            float inc = p3;
#pragma unroll
            for (int o = 1; o < 64; o <<= 1) { const float t = __shfl_up(inc, o); if (lane >= o) inc += t; }
            const float base = carry + (inc - p3); const float k = -1.4426950408889634f;
            *(f32x4*)(dst + 256 * r + 4 * lane) = (f32x4){k * (base + p0), k * (base + p1), k * (base + p2), k * (base + p3)};
            carry += __shfl(inc, 63); }
    }
    const float C2 = 0.125f * 1.4426950408889634f;
    int wi = gw, nwk = NGW;
    if (G == 256) { if ((gw & 31) == 0) return; wi = gw - ((gw >> 5) + 1); nwk = NGW - 64; }
    for (int it = wi; it < 2 * M; it += nwk) { const int row = it >> 1, which = it & 1; bfu* p = QKV + (size_t)which * ((size_t)M * D) + (size_t)row * D + 8 * lane; const float* gn = which ? kg : qg; const float sc = which ? 1.0f : C2;
        const f32x4 g0 = *(const f32x4*)(gn + 8 * (lane & 7)), g1 = *(const f32x4*)(gn + 8 * (lane & 7) + 4);
#pragma unroll
        for (int q = 0; q < 2; ++q) { const v4u w = *(const v4u*)(p + 512 * q);
            float v[8] = {bflo(w.x), bfhi(w.x), bflo(w.y), bfhi(w.y), bflo(w.z), bfhi(w.z), bflo(w.w), bfhi(w.w)};
            float s = 0.f;
#pragma unroll
            for (int i = 0; i < 8; ++i) s += v[i] * v[i];
            s += __shfl_xor(s, 1); s += __shfl_xor(s, 2); s += __shfl_xor(s, 4);
            const float rs = sc * __builtin_amdgcn_rsqf(s * (1.f / 64.f) + EPSF);
            v4u o; o.x = pk2(v[0] * rs * g0[0], v[1] * rs * g0[1]); o.y = pk2(v[2] * rs * g0[2], v[3] * rs * g0[3]); o.z = pk2(v[4] * rs * g1[0], v[5] * rs * g1[1]); o.w = pk2(v[6] * rs * g1[2], v[7] * rs * g1[3]);
            *(v4u*)(p + 512 * q) = o; } }
}
#define RLX_AGENT __ATOMIC_RELAXED, __HIP_MEMORY_SCOPE_AGENT
#define XB_TMO      128
#define XB_XCNT(j)  (256  + 64 * (j))
#define XB_XSUB(j)  (1280 + 64 * (j))
#define XB_XGEN(j)  (2304 + 64 * (j))
#define XB_TOP      3328
#define XB_TOPGEN   3392
#define XCD_BAR_WORDS 3456
#define XB_SPIN_CAP (1u << 18)

__device__ __forceinline__ unsigned xb_ld(unsigned* p)              { return __hip_atomic_load(p, __ATOMIC_RELAXED, __HIP_MEMORY_SCOPE_AGENT); }
__device__ __forceinline__ unsigned xb_add(unsigned* p, unsigned v) { return __hip_atomic_fetch_add(p, v, __ATOMIC_RELAXED, __HIP_MEMORY_SCOPE_AGENT); }
__device__ __forceinline__ unsigned xb_xcc_id() { return (unsigned)__builtin_amdgcn_s_getreg((3 << 11) | 20) & 0xFu; }
#define XB_SPIN(cond, bar) do { unsigned _sp = 0; while (cond) { __builtin_amdgcn_s_sleep(1); \
    if ((++_sp & 255u) == 0u) { if (xb_ld(&(bar)[XB_TMO])) break; if (_sp > XB_SPIN_CAP) { atomicAdd(&(bar)[XB_TMO], 1u); break; } } } } while (0)

struct XcdBarrier {
    unsigned* bar; unsigned x;
    volatile LAS unsigned* st;
};

__device__ __forceinline__ XcdBarrier xcd_barrier_post(unsigned* bar, volatile LAS unsigned* st) {
    XcdBarrier b; b.bar = bar; b.x = xb_xcc_id(); b.st = st;
    if (threadIdx.x == 0) (void)xb_add(&bar[XB_XCNT(b.x)], 1u);
    return b;
}
__device__ __forceinline__ void xcd_barrier_complete(unsigned* bar, unsigned x, unsigned& nloc, unsigned& nx) {
    const unsigned G = gridDim.x * gridDim.y * gridDim.z;
    unsigned sum, cnt, mine, sp = 0u;
    for (;;) {
        sum = 0u; cnt = 0u; mine = 0u;
#pragma unroll
        for (unsigned j = 0; j < 16; ++j) { const unsigned c = xb_ld(&bar[XB_XCNT(j)]); sum += c; cnt += (c > 0u) ? 1u : 0u; mine = (j == x) ? c : mine; }
        if (sum == G) break;
        __builtin_amdgcn_s_sleep(1);
        if ((++sp & 255u) == 0u) { if (xb_ld(&bar[XB_TMO])) break; if (sp > XB_SPIN_CAP) { atomicAdd(&bar[XB_TMO], 1u); break; } }
    }
    nloc = mine > 0u ? mine : 1u; nx = cnt > 0u ? cnt : 1u;
}

__device__ __forceinline__ void xcd_barrier(const XcdBarrier& b) {
    asm volatile("s_waitcnt vmcnt(0)" ::: "memory");
    __syncthreads();
    if (threadIdx.x == 0) {
        unsigned* bar = b.bar;
        __builtin_amdgcn_s_waitcnt(0);
        unsigned nloc = b.st[0], nx = b.st[1];
        if (nloc == 0u) { xcd_barrier_complete(bar, b.x, nloc, nx); b.st[0] = nloc; b.st[1] = nx; }
        const unsigned old = xb_add(&bar[XB_XSUB(b.x)], 1u);
        const unsigned gen = old / nloc;
        if (old + 1u == (gen + 1u) * nloc) {
            __builtin_amdgcn_fence(__ATOMIC_RELEASE, "agent");
            asm volatile("s_waitcnt vmcnt(0)" ::: "memory");
            const unsigned og = xb_add(&bar[XB_TOP], 1u);
            const unsigned tg = og / nx;
            if (og + 1u == (tg + 1u) * nx) xb_add(&bar[XB_TOPGEN], 1u);
            else XB_SPIN(xb_ld(&bar[XB_TOPGEN]) == tg, bar);
            __builtin_amdgcn_fence(__ATOMIC_ACQUIRE, "agent");
            xb_add(&bar[XB_XGEN(b.x)], 1u);
            asm volatile("s_waitcnt vmcnt(0)" ::: "memory");
        } else {
            XB_SPIN(xb_ld(&bar[XB_XGEN(b.x)]) == gen, bar);
            __builtin_amdgcn_fence(__ATOMIC_ACQUIRE, "agent");
            asm volatile("s_waitcnt vmcnt(0)" ::: "memory");
        }
    }
    __syncthreads();
}

struct Params { const float* in[22]; float* out; unsigned char* ws; int ph_lo, ph_hi; };
constexpr int N_PHASES = 16;
#ifndef DBG_PROBE_U
#define DBG_PROBE_U 0
#endif
#ifndef DBG_PROBE_V
#define DBG_PROBE_V 0
#endif
#ifndef DBG_PROBE_ATT
#define DBG_PROBE_ATT 0
#endif
#ifndef DBG_DUP
#define DBG_DUP 0
#endif
#ifndef SKIPMASK
#define SKIPMASK 0
#endif
#define PH_ON(n) (!((SKIPMASK >> (n)) & 1))
typedef const __attribute__((address_space(4))) Params* KP;
__device__ __forceinline__ KP kparams() { KP k = (KP)__builtin_amdgcn_kernarg_segment_ptr(); asm volatile("" : "+s"(k)); return k; }
#define WSP(T, off) ((T*)(ws + (off)))
__global__ void __launch_bounds__(NTH, 2) trunk_fwd(Params p_unused) {
    extern __shared__ __attribute__((aligned(16))) unsigned char lds_raw[];
    LAS unsigned char* lds = (LAS unsigned char*)lds_raw;
    cg::grid_group grid = cg::this_grid();
    volatile LAS unsigned* xst = (volatile LAS unsigned*)(lds + LDS_BYTES - 64);
    if (threadIdx.x < 2) xst[threadIdx.x] = 0u;
    __syncthreads();
    XcdBarrier xbar = xcd_barrier_post((unsigned*)(kparams()->ws + WS_BAR), xst);
    int ph_hi; { KP k0 = kparams(); ph_hi = k0->ph_hi; }
    for (int ph = kparams()->ph_lo; ph < ph_hi; ++ph) {
        if (ph == 7 || ph == 14) continue;
        for (int rep = 0; rep < (((DBG_DUP >> ph) & 1) ? 2 : 1); ++rep) {
        if (rep) xcd_barrier(xbar);
        KP kp = kparams(); unsigned char* ws = kp->ws; int G = gridDim.x; asm volatile("" : "+s"(G));
        switch (ph) {
        case 0: if (PH_ON(0)) { const float* inl[22];
#pragma unroll
                  for (int i = 0; i < 22; ++i) inl[i] = kp->in[i];
                  p0_prologue(inl, ws, lds, G); } break;
        case 1: if (PH_ON(1)) { pg8::Gemm g{WSP(bfu, WS_XB), WSP(const bfu, WS_WINE), M, EVEN_PAD, D}; pg8::StaticOrder S; S.init(M, EVEN_PAD, G, (int)bid_fresh());
                  pg8::EpiScale<1> E{WSP(bfu, WS_R1), EVEN_IN, EVEN_IN, WSP(float, WS_SS)}; pg8::gemm_phase<pg8::EpiScale<1>, pg8::StaticOrder, true, true>(lds, g, S, E); } break;
        case 2: if (PH_ON(2)) { for (int u = bid_fresh(); u < M / 32; u += G) conv_unit(WSP(bfu, WS_R1), kp->in[3], kp->in[4], kp->in[5], kp->in[6], WSP(bfu, WS_R2), lds, u);
                  for (int u = bid_fresh(); u < 2048; u += G) gla_g1_unit(WSP(bfu, WS_R1), kp->in[7], kp->in[8], kp->out, WSP(float, WS_DEC), lds, u); } break;
        case 3: if (PH_ON(3)) gla_g2(kp->out, WSP(float, WS_DEC), G); break;
        case 4: if (PH_ON(4)) { for (int u = bid_fresh(); u < 2048; u += G) gla_g3_unit(WSP(bfu, WS_R1), kp->in[7], kp->in[8], kp->in[9], kp->out, WSP(bfu, WS_R2), lds, u); } break;
        case 5: case 12: if (PH_ON(5)) { const bool odd = (ph == 12); pg8::Gemm g{odd ? WSP(bfu, WS_R1) : WSP(bfu, WS_R2), (const bfu*)(ws + (odd ? WS_WOUTO : WS_WOUTE)), M, D, D}; pg8::StaticOrder S; S.init(M, D, G, (int)bid_fresh());
                  pg8::EpiResid E{odd ? (const float*)kp->out : kp->in[0], kp->out, WSP(bfu, WS_XB), WSP(float, WS_SSP)}; pg8::gemm_phase<pg8::EpiResid, pg8::StaticOrder, true, true>(lds, g, S, E); } break;
        case 6: case 13: if (PH_ON(6)) { const int l = (ph == 13); pg8::Gemm g{WSP(bfu, WS_XB), (const bfu*)(ws + WS_WQ + (size_t)l * 4 * MiB), M, 2048, D}; pg8::StaticOrder S; S.init(M, 2048, G, (int)bid_fresh());
                  pg8::EpiScale<16> E{WSP(bfu, WS_R1), 2048, 2048, WSP(float, WS_SSP)}; pg8::gemm_phase<pg8::EpiScale<16>, pg8::StaticOrder, true, true>(lds, g, S, E);
                  peer_hq(kp->out, WSP(float, WS_SSP), kp->in[17] + l * 1024, WSP(unsigned, WS_R2), WSP(float, WS_SS), G);
                  __syncthreads();
                  peer_topk(WSP(bfu, WS_R1), WSP(const bfu, WS_KEYS) + (size_t)l * 262144, WSP(unsigned short, WS_EXP), WSP(float, WS_GATE), lds, S); } break;
        case 7: case 14: break;
        case 8: case 15: if (PH_ON(8)) { const int l = (ph == 15); const unsigned char* U8 = ws + WS_UV + (size_t)l * 2 * 16777216; const float* USC = WSP(const float, WS_USC) + l * 2 * 16384;
#if DBG_PROBE_U
                  peer_u_rows(WSP(unsigned, WS_R2), WSP(float, WS_SS), U8, USC, USC + 16384, WSP(unsigned short, WS_EXP), WSP(float, WS_GATE), WSP(float, WS_R1), lds, G, bid_fresh() & 7, bid_fresh() >> 3);
                  xcd_barrier(xbar);
#endif
                  peer_u_rows(WSP(unsigned, WS_R2), WSP(float, WS_SS), U8, USC, USC + 16384, WSP(unsigned short, WS_EXP), WSP(float, WS_GATE), WSP(float, WS_GATE), lds, G, bid_fresh() & 7, bid_fresh() >> 3);
                  xcd_barrier(xbar);
#if DBG_PROBE_V
                  peer_v_slice(kparams()->out, WSP(float, WS_R1), WSP(float, WS_GATE), ws + WS_UV + (size_t)l * 2 * 16777216 + 16777216, WSP(unsigned short, WS_EXP), WSP(bfu, WS_R1 + 128 * MiB), WSP(float, WS_LFT), lds, G, bid_fresh() & 7, bid_fresh() >> 3);
                  xcd_barrier(xbar);
#endif
                  peer_v_slice(kparams()->out, kparams()->out, WSP(float, WS_GATE), ws + WS_UV + (size_t)l * 2 * 16777216 + 16777216, WSP(unsigned short, WS_EXP), WSP(bfu, WS_XB), WSP(float, WS_SSP), lds, G, bid_fresh() & 7, bid_fresh() >> 3); } break;
        case 9: if (PH_ON(9)) { pg8::Gemm g{WSP(bfu, WS_XB), WSP(const bfu, WS_WINO), M, ODD_PAD, D}; pg8::StaticOrder S; S.init(M, ODD_PAD, G, (int)bid_fresh());
                  pg8::EpiQkv E{WSP(bfu, WS_R1), WSP(float, WS_SSP), WSP(float, WS_LFT), kp->in[13]}; pg8::gemm_phase<pg8::EpiQkv, pg8::StaticOrder, true, true>(lds, g, S, E); } break;
        case 10: if (PH_ON(10)) fox_prep(WSP(bfu, WS_R1), kp->in[14], kp->in[15], WSP(float, WS_LFT), WSP(float, WS_CB), G); break;
        case 11: if (PH_ON(11)) { bfu* R1 = WSP(bfu, WS_R1); const attn_body::AttnTensors AT{(const attn_body::bf16*)R1, (const attn_body::bf16*)(R1 + (size_t)M * D), (const attn_body::bf16*)(R1 + (size_t)2 * M * D), (attn_body::bf16*)R1};
#if DBG_PROBE_ATT
                  { const attn_body::AttnTensors AT2{(const attn_body::bf16*)R1, (const attn_body::bf16*)(R1 + (size_t)M * D), (const attn_body::bf16*)(R1 + (size_t)2 * M * D), (attn_body::bf16*)WSP(bfu, WS_R2)};
                    attn_body::attn_phase_dyn<8>((char*)lds_raw, AT2, WSP(float, WS_CB), kp->in[14], kp->in[15], (unsigned*)(ws + WS_BAR + 15360 + 32)); xcd_barrier(xbar); }
#endif
                  attn_body::attn_phase_dyn<14>((char*)lds_raw, AT, WSP(float, WS_CB), kp->in[14], kp->in[15], (unsigned*)(ws + WS_BAR + 15360)); } break;
        default: break;
        }
        }
        if (ph + 1 < ph_hi) { if (ph == kparams()->ph_lo) grid.sync(); else xcd_barrier(xbar); }
    }
}

extern "C" void kernel_launch(void* const* d_in, const int* in_sizes, int n_in, void* d_out, int out_size, void* d_ws, size_t ws_size, hipStream_t stream) {
    static int grid = 0;
    if (grid == 0) {
        if (n_in != 22 || out_size != M * D || ws_size < WS_END) { fprintf(stderr, "kernel_launch: unexpected problem (n_in %d, out %d, ws %zu)\n", n_in, out_size, ws_size); grid = -1; return; }
        int dev = 0, cus = 0, per_cu = 0;
        (void)hipGetDevice(&dev); (void)hipDeviceGetAttribute(&cus, hipDeviceAttributeMultiprocessorCount, dev);
        if (hipFuncSetAttribute((const void*)trunk_fwd, hipFuncAttributeMaxDynamicSharedMemorySize, LDS_BYTES) != hipSuccess) { fprintf(stderr, "kernel_launch: hipFuncSetAttribute failed\n"); grid = -1; return; }
        if (hipOccupancyMaxActiveBlocksPerMultiprocessor(&per_cu, (const void*)trunk_fwd, NTH, LDS_BYTES) != hipSuccess || per_cu < 1) { fprintf(stderr, "kernel_launch: occupancy query says %d\n", per_cu); per_cu = 1; }
        (void)hipGetLastError();
        grid = (cus / 8) * 8;
        fprintf(stderr, "kernel_launch: grid %d (cus %d, per_cu %d)\n", grid, cus, per_cu);
    }
    if (grid < 0) return;
    Params p{};
    for (int i = 0; i < 22; ++i) p.in[i] = (const float*)d_in[i];
    p.out = (float*)d_out; p.ws = (unsigned char*)d_ws; p.ph_lo = 0; p.ph_hi = N_PHASES;
    (void)hipMemsetAsync((char*)d_ws + WS_BAR, 0, 16384, stream);
    void* args[] = {&p};
    hipError_t e = hipLaunchCooperativeKernel((const void*)trunk_fwd, dim3(grid), dim3(NTH), args, LDS_BYTES, stream);
    if (e != hipSuccess) fprintf(stderr, "cooperative launch failed: %s (grid %d)\n", hipGetErrorString(e), grid);
}
```

```cpp
#include <hip/hip_runtime.h>
#include <hip/hip_cooperative_groups.h>
#include <hip/hip_bf16.h>
#include <cstdio>
#include <cstdint>
#include <cmath>
namespace cg = cooperative_groups;
namespace pg8 {
#define PG8_LAS __attribute__((address_space(3)))
typedef unsigned short bf16_t;
typedef short bf16x8 __attribute__((ext_vector_type(8)));
typedef float f32x4 __attribute__((ext_vector_type(4)));
typedef unsigned u32x4 __attribute__((ext_vector_type(4)));
constexpr int BM = 256, BK = 64, HALF = 128, HTB = HALF * BK * 2  , STAGE_BYTES = 8 * HTB, NXCD = 8, WGM = 8;

__host__ __device__ __forceinline__ int lds_byte(int r, int c) { const int st = (r >> 4) * 2 + (c >> 5), rr = r & 15, cc = c & 31, ob = rr * 64 + cc * 2; return st * 1024 + (ob ^ (((ob >> 9) & 1) << 5)); }
__host__ __device__ __forceinline__ void stage_rc(int b, int& R, int& C) { const int st = b / 1024, sb = b % 1024, swz = sb ^ (((sb >> 9) & 1) << 5); R = (st >> 1) * 16 + swz / 64; C = (st & 1) * 32 + (swz % 64) / 2; }
__host__ __device__ __forceinline__ int perm32(int rho) { const int n = rho >> 4, i = rho & 15; return 8 * (i >> 2) + 4 * n + (i & 3); }

struct Unit { int pm, pn; };
struct Gemm { const bf16_t* A; const bf16_t* Bt; int M, N, K; };

struct StaticOrder {
    int nM, nN, nwg, G, c;
    __host__ __device__ void init(int M, int N, int G_, int c_) { nM = M / BM; nN = N / BM; nwg = nM * nN; G = G_; c = c_; }
    __host__ __device__ bool next(int i, Unit& u) const {
        const long L = (long)i * G + c; if (L >= nwg) return false;
        int wgid = (int)L; { const int q = nwg / NXCD, r = nwg % NXCD, xcd = wgid % NXCD, off = wgid / NXCD; wgid = (xcd < r ? xcd * (q + 1) : r * (q + 1) + (xcd - r) * q) + off; }
        const int nig = WGM * nN, gid = wgid / nig, fm = gid * WGM, gsz = (nM - fm) < WGM ? (nM - fm) : WGM;
        u.pm = fm + ((wgid % nig) % gsz); u.pn = (wgid % nig) / gsz; return true;
    }
    __device__ __forceinline__ void a_ready(const Unit&) const {}
    __device__ __forceinline__ void done(const Unit&) const {}
};
__device__ __forceinline__ unsigned cvt_pk_bf16(float lo, float hi) { unsigned r; asm volatile("v_cvt_pk_bf16_f32 %0, %1, %2" : "=v"(r) : "v"(lo), "v"(hi)); return r; }
constexpr int MROWS = 32768;
template <int SSN> __device__ __forceinline__ float row_rstd(const float* ss, int row) {
    float s;
    if (SSN == 1) s = ss[row];
    else { const f32x4* p = (const f32x4*)(ss + (size_t)row * 16); const f32x4 a = p[0], b = p[1], c = p[2], d = p[3];
        s = (((a[0] + a[1]) + (a[2] + a[3])) + ((b[0] + b[1]) + (b[2] + b[3]))) + (((c[0] + c[1]) + (c[2] + c[3])) + ((d[0] + d[1]) + (d[2] + d[3]))); }
    return __builtin_amdgcn_rsqf(s * (1.0f / 1024.0f) + 1e-6f);
}
template <int SSN> struct EpiScale {
    static constexpr bool PERM = true, AFTER_DRAIN = false;
    bf16_t* O; int ldc; int nvalid; const float* ss;
    __device__ __forceinline__ void operator()(const f32x4 (&acc)[2][2][4][2], const Unit& u, int wr, int wc, int fr, int fq) const {
        const int row0 = u.pm * BM + wr * 64 + fr; const int col0 = u.pn * BM + wc * 32 + 8 * fq;
#pragma unroll
        for (int ai = 0; ai < 2; ++ai)
#pragma unroll
            for (int m = 0; m < 4; ++m) { const int row = row0 + ai * HALF + m * 16; const float rs = row_rstd<SSN>(ss, row); bf16_t* rowp = O + (size_t)row * ldc + col0;
#pragma unroll
                for (int bj = 0; bj < 2; ++bj) { if (col0 + bj * HALF < nvalid) { const f32x4 v0 = acc[ai][bj][m][0] * rs, v1 = acc[ai][bj][m][1] * rs;
                    u32x4 w; w.x = cvt_pk_bf16(v0[0], v0[1]); w.y = cvt_pk_bf16(v0[2], v0[3]); w.z = cvt_pk_bf16(v1[0], v1[1]); w.w = cvt_pk_bf16(v1[2], v1[3]);
                    *(u32x4*)(rowp + bj * HALF) = w; } } }
    }
};
struct EpiResid {
    static constexpr bool PERM = true, AFTER_DRAIN = false;
    const float* xin; float* xout; bf16_t* xb; float* ssp;
    __device__ __forceinline__ void operator()(const f32x4 (&acc)[2][2][4][2], const Unit& u, int wr, int wc, int fr, int fq) const {
        const int row0 = u.pm * BM + wr * 64 + fr; const int col0 = u.pn * BM + wc * 32 + 8 * fq;
#pragma unroll
        for (int ai = 0; ai < 2; ++ai)
#pragma unroll
            for (int m = 0; m < 4; ++m) { const int row = row0 + ai * HALF + m * 16; const size_t off = (size_t)row * 1024 + col0; float s = 0.f;
#pragma unroll
                for (int bj = 0; bj < 2; ++bj) { const f32x4 a0 = *(const f32x4*)(xin + off + bj * HALF), a1 = *(const f32x4*)(xin + off + bj * HALF + 4);
                    const f32x4 v0 = a0 + acc[ai][bj][m][0], v1 = a1 + acc[ai][bj][m][1];
                    *(f32x4*)(xout + off + bj * HALF) = v0; *(f32x4*)(xout + off + bj * HALF + 4) = v1;
                    s += (v0[0] * v0[0] + v0[1] * v0[1]) + (v0[2] * v0[2] + v0[3] * v0[3]) + (v1[0] * v1[0] + v1[1] * v1[1]) + (v1[2] * v1[2] + v1[3] * v1[3]);
                    u32x4 w; w.x = cvt_pk_bf16(v0[0], v0[1]); w.y = cvt_pk_bf16(v0[2], v0[3]); w.z = cvt_pk_bf16(v1[0], v1[1]); w.w = cvt_pk_bf16(v1[2], v1[3]);
                    *(u32x4*)(xb + off + bj * HALF) = w; }
                s += __shfl_xor(s, 16); s += __shfl_xor(s, 32);
                if (fq == 0) ssp[(size_t)row * 16 + u.pn * 4 + wc] = s; }
    }
};
struct EpiQkv {
    static constexpr bool PERM = true, AFTER_DRAIN = false;
    bf16_t* QKV; const float* ss; float* lft; const float* fb;
    __device__ __forceinline__ void operator()(const f32x4 (&acc)[2][2][4][2], const Unit& u, int wr, int wc, int fr, int fq) const {
        const int row0 = u.pm * BM + wr * 64 + fr;
        if (u.pn < 12) {
            bf16_t* base = QKV + (size_t)(u.pn >> 2) * ((size_t)MROWS * 1024); const int col0 = (u.pn & 3) * BM + wc * 32 + 8 * fq;
#pragma unroll
            for (int ai = 0; ai < 2; ++ai)
#pragma unroll
                for (int m = 0; m < 4; ++m) { const int row = row0 + ai * HALF + m * 16; const float rs = row_rstd<16>(ss, row); bf16_t* rowp = base + (size_t)row * 1024 + col0;
#pragma unroll
                    for (int bj = 0; bj < 2; ++bj) { const f32x4 v0 = acc[ai][bj][m][0] * rs, v1 = acc[ai][bj][m][1] * rs;
                        u32x4 w; w.x = cvt_pk_bf16(v0[0], v0[1]); w.y = cvt_pk_bf16(v0[2], v0[3]); w.z = cvt_pk_bf16(v1[0], v1[1]); w.w = cvt_pk_bf16(v1[2], v1[3]);
                        *(u32x4*)(rowp + bj * HALF) = w; } }
        } else if (wc == 0 && fq < 2) {
            const f32x4 f0 = *(const f32x4*)(fb + 8 * fq), f1 = *(const f32x4*)(fb + 8 * fq + 4);
#pragma unroll
            for (int ai = 0; ai < 2; ++ai)
#pragma unroll
                for (int m = 0; m < 4; ++m) { const int row = row0 + ai * HALF + m * 16; const float rs = row_rstd<16>(ss, row);
                    float* dst = lft + (size_t)row * 16 + 8 * fq;
                    *(f32x4*)dst = acc[ai][0][m][0] * rs + f0; *(f32x4*)(dst + 4) = acc[ai][0][m][1] * rs + f1; }
        }
    }
};
template <class Epi, class Sched, bool ALIGN_EPI = false, bool SP2 = false>
__device__ __forceinline__ void gemm_phase(PG8_LAS unsigned char* lds, const Gemm g, const Sched& S, const Epi& E) {
    int tid = threadIdx.x; asm volatile("" : "+v"(tid)); const int wid = __builtin_amdgcn_readfirstlane(tid >> 6), lane = tid & 63, wr = wid >> 2, wc = wid & 3, fr = lane & 15, fq = lane >> 4;
    const int K = g.K, nt = K / BK;
    unsigned voffA[2], voffB[2];
#pragma unroll
    for (int i = 0; i < 2; ++i) { int R, C; stage_rc(tid * 16 + i * 8192, R, C); const int Rb = Epi::PERM ? ((R & ~31) + perm32(R & 31)) : R;
        voffA[i] = (unsigned)(R * K + C) * 2u; voffB[i] = (unsigned)(Rb * K + C) * 2u; }
    const size_t kstep = (size_t)(BK * 2);
    const size_t hstep = (size_t)HALF * K * 2;
    const size_t tstep = 2 * hstep;
    const unsigned ldsw = (unsigned)wid * 1024u;
    const int aoff = lds_byte(wr * 64 + fr, fq * 8), boff = lds_byte(wc * 32 + fr, fq * 8);
#define PG8_SA(b, h) (((b) * 2 + (h)) * HTB)
#define PG8_SB(b, h) ((4 + (b) * 2 + (h)) * HTB)
#define PG8_STAGE(bufoff, gbase, voff) do { _Pragma("unroll") for (int _i = 0; _i < 2; ++_i) \
        __builtin_amdgcn_global_load_lds((const unsigned*)((const char*)(gbase) + (voff)[_i]), (PG8_LAS unsigned*)(lds + (bufoff) + ldsw + _i * 8192), 16, 0, 0); } while (0)
#define PG8_LDA(dst, b, h) do { _Pragma("unroll") for (int m = 0; m < 4; ++m) _Pragma("unroll") for (int k = 0; k < 2; ++k) dst[m][k] = *(const PG8_LAS bf16x8*)(lds + PG8_SA(b, h) + aoff + m * 2048 + k * 1024); } while (0)
#define PG8_LDB(dst, b, h) do { _Pragma("unroll") for (int n = 0; n < 2; ++n) _Pragma("unroll") for (int k = 0; k < 2; ++k) dst[n][k] = *(const PG8_LAS bf16x8*)(lds + PG8_SB(b, h) + boff + n * 2048 + k * 1024); } while (0)
#define PG8_MMA(ai, bj, At, Bt) do { __builtin_amdgcn_s_setprio(1); _Pragma("unroll") for (int m = 0; m < 4; ++m) _Pragma("unroll") for (int n = 0; n < 2; ++n) _Pragma("unroll") for (int k = 0; k < 2; ++k) \
        acc[ai][bj][m][n] = __builtin_amdgcn_mfma_f32_16x16x32_bf16(Bt[n][k], At[m][k], acc[ai][bj][m][n], 0, 0, 0); __builtin_amdgcn_s_setprio(0); } while (0)
#define PG8_WAIT_V(n) asm volatile("s_waitcnt vmcnt(" #n ")" ::: "memory")
#define PG8_WAIT_L(n) asm volatile("s_waitcnt lgkmcnt(" #n ")" ::: "memory")
#define PG8_BAR __builtin_amdgcn_s_barrier()
#define PG8_SCHED __builtin_amdgcn_sched_barrier(0)
    Unit cur, nxt; int ui = 0;
    if (!S.next(0, cur)) return;
    f32x4 acc[2][2][4][2];
#pragma unroll
    for (int a = 0; a < 2; ++a)
#pragma unroll
        for (int b = 0; b < 2; ++b)
#pragma unroll
            for (int m = 0; m < 4; ++m)
#pragma unroll
                for (int n = 0; n < 2; ++n) acc[a][b][m][n] = (f32x4){0.f, 0.f, 0.f, 0.f};
    bf16x8 At[4][2], B0[2][2], B1[2][2];
    const char* cA = (const char*)g.A + (size_t)cur.pm * tstep; const char* cB = (const char*)g.Bt + (size_t)cur.pn * tstep;
    S.a_ready(cur);
    if constexpr (SP2) {
        PG8_STAGE(PG8_SB(0, 0), cB, voffB); PG8_STAGE(PG8_SB(0, 1), cB + hstep, voffB); PG8_STAGE(PG8_SA(0, 0), cA, voffA); PG8_STAGE(PG8_SA(0, 1), cA + hstep, voffA);
        if (wr == 1) PG8_BAR;
        PG8_WAIT_V(2); PG8_BAR;
        PG8_STAGE(PG8_SB(1, 0), cB + kstep, voffB); PG8_STAGE(PG8_SA(1, 0), cA + kstep, voffA); PG8_STAGE(PG8_SB(1, 1), cB + hstep + kstep, voffB);
        PG8_WAIT_V(6); PG8_BAR;
    } else {
        PG8_STAGE(PG8_SB(0, 0), cB, voffB); PG8_STAGE(PG8_SA(0, 0), cA, voffA); PG8_STAGE(PG8_SB(0, 1), cB + hstep, voffB); PG8_STAGE(PG8_SA(0, 1), cA + hstep, voffA);
        if (wr == 1) PG8_BAR;
        PG8_WAIT_V(4); PG8_BAR;
        PG8_STAGE(PG8_SB(1, 0), cB + kstep, voffB); PG8_STAGE(PG8_SA(1, 0), cA + kstep, voffA); PG8_STAGE(PG8_SB(1, 1), cB + hstep + kstep, voffB);
        PG8_WAIT_V(6); PG8_BAR;
    }
    for (;;) {
        const bool has_next = S.next(ui + 1, nxt);
        const char* nA = has_next ? (const char*)g.A + (size_t)nxt.pm * tstep : cA; const char* nB = has_next ? (const char*)g.Bt + (size_t)nxt.pn * tstep : cB;
        for (int t = 0; t < nt; t += 2) {
            const bool last = (t == nt - 2);
            const char* a1 = cA + (size_t)(t + 1) * kstep;
            const char* a2 = last ? nA : cA + (size_t)(t + 2) * kstep; const char* b2 = last ? nB : cB + (size_t)(t + 2) * kstep;
            const char* a3 = a2 + kstep; const char* b3 = b2 + kstep;
            if (last && has_next) S.a_ready(nxt);
            if constexpr (SP2) {
            PG8_LDB(B0, 0, 0); PG8_LDB(B1, 0, 1); PG8_SCHED; PG8_LDA(At, 0, 0); PG8_STAGE(PG8_SA(1, 1), a1 + hstep, voffA);
            PG8_WAIT_V(8); PG8_WAIT_L(0); PG8_BAR; PG8_MMA(0, 0, At, B0); PG8_MMA(0, 1, At, B1); PG8_BAR; PG8_SCHED;
            PG8_LDA(At, 0, 1); PG8_STAGE(PG8_SB(0, 0), b2, voffB); PG8_STAGE(PG8_SB(0, 1), b2 + hstep, voffB); PG8_STAGE(PG8_SA(0, 0), a2, voffA);
            PG8_WAIT_V(8); PG8_WAIT_L(0); PG8_BAR; PG8_MMA(1, 0, At, B0); PG8_MMA(1, 1, At, B1); PG8_BAR; PG8_SCHED;
            PG8_LDB(B0, 1, 0); PG8_LDB(B1, 1, 1); PG8_SCHED; PG8_LDA(At, 1, 0); PG8_STAGE(PG8_SA(0, 1), a2 + hstep, voffA);
            PG8_WAIT_V(8); PG8_WAIT_L(0); PG8_BAR; PG8_MMA(0, 0, At, B0); PG8_MMA(0, 1, At, B1); PG8_BAR; PG8_SCHED;
            PG8_LDA(At, 1, 1); PG8_STAGE(PG8_SB(1, 0), b3, voffB); PG8_STAGE(PG8_SB(1, 1), b3 + hstep, voffB); PG8_STAGE(PG8_SA(1, 0), a3, voffA);
            PG8_WAIT_V(8); PG8_WAIT_L(0); PG8_BAR; PG8_MMA(1, 0, At, B0); PG8_MMA(1, 1, At, B1); PG8_BAR; PG8_SCHED;
            } else {
            PG8_LDB(B0, 0, 0); PG8_SCHED; PG8_LDA(At, 0, 0); PG8_STAGE(PG8_SA(1, 1), a1 + hstep, voffA);
            PG8_WAIT_L(8); PG8_BAR; PG8_WAIT_L(0); PG8_MMA(0, 0, At, B0); PG8_BAR; PG8_SCHED;
            PG8_LDB(B1, 0, 1); PG8_STAGE(PG8_SB(0, 0), b2, voffB);
            PG8_BAR; PG8_WAIT_L(0); PG8_MMA(0, 1, At, B1); PG8_BAR;
            PG8_LDA(At, 0, 1); PG8_STAGE(PG8_SA(0, 0), a2, voffA);
            PG8_BAR; PG8_WAIT_L(0); PG8_MMA(1, 0, At, B0); PG8_BAR; PG8_SCHED;
            PG8_STAGE(PG8_SB(0, 1), b2 + hstep, voffB);
            PG8_WAIT_V(6); PG8_BAR; PG8_MMA(1, 1, At, B1); PG8_BAR;
            PG8_LDB(B0, 1, 0); PG8_SCHED; PG8_LDA(At, 1, 0); PG8_STAGE(PG8_SA(0, 1), a2 + hstep, voffA);
            PG8_WAIT_L(8); PG8_BAR; PG8_WAIT_L(0); PG8_MMA(0, 0, At, B0); PG8_BAR; PG8_SCHED;
            PG8_LDB(B1, 1, 1); PG8_STAGE(PG8_SB(1, 0), b3, voffB);
            PG8_BAR; PG8_WAIT_L(0); PG8_MMA(0, 1, At, B1); PG8_BAR;
            PG8_LDA(At, 1, 1); PG8_STAGE(PG8_SA(1, 0), a3, voffA);
            PG8_BAR; PG8_WAIT_L(0); PG8_MMA(1, 0, At, B0); PG8_BAR; PG8_SCHED;
            PG8_STAGE(PG8_SB(1, 1), b3 + hstep, voffB);
            PG8_WAIT_V(6); PG8_BAR; PG8_MMA(1, 1, At, B1); PG8_BAR;
            }
        }
        if constexpr (ALIGN_EPI) { if (wr == 0) PG8_BAR; }
        if constexpr (!Epi::AFTER_DRAIN) { E(acc, cur, wr, wc, fr, fq); S.done(cur); }
        if (!has_next) break;
#pragma unroll
        for (int a = 0; a < 2; ++a)
#pragma unroll
            for (int b = 0; b < 2; ++b)
#pragma unroll
                for (int m = 0; m < 4; ++m)
#pragma unroll
                    for (int n = 0; n < 2; ++n) acc[a][b][m][n] = (f32x4){0.f, 0.f, 0.f, 0.f};
        cur = nxt; cA = nA; cB = nB; ++ui;
        if constexpr (ALIGN_EPI) { if (wr == 1) PG8_BAR; }
    }
    PG8_WAIT_V(0);
    if constexpr (!ALIGN_EPI) { if (wr == 0) PG8_BAR; }
    PG8_BAR;
    if constexpr (Epi::AFTER_DRAIN) { E.fused(acc, cur, wr, wc, fr, fq, lds, wid, lane); S.done(cur); }
#undef PG8_SA
#undef PG8_SB
#undef PG8_STAGE
#undef PG8_LDA
#undef PG8_LDB
#undef PG8_MMA
#undef PG8_WAIT_V
#undef PG8_WAIT_L
#undef PG8_BAR
#undef PG8_SCHED
}
}
#include <hip/hip_bf16.h>
#include <cmath>
namespace attn_body {
using bf16=__hip_bfloat16;
using bf16x8=__attribute__((ext_vector_type(8)))short;
using s16x4=__attribute__((ext_vector_type(4)))short;
using f32x16=__attribute__((ext_vector_type(16)))float;
using u32x4=__attribute__((ext_vector_type(4)))unsigned;
constexpr int BATCH=4,NHEAD=16,SEQ=8192,D=64,DM=NHEAD*D;
constexpr int NW=8,QBLK=32,QB=QBLK*NW,KVBLK=64,NQB=SEQ/QB;
constexpr int ATTN_PITCH=DM, ATTN_UNIT_ROWS=QB;
__device__ __forceinline__ int crow(int r,int hi){return (r&3)+8*(r>>2)+4*hi;}
#define SBAR() __builtin_amdgcn_sched_barrier(0)
__device__ __forceinline__ void cmask(f32x16&p0,f32x16&p1,int jb,int qrel,int hi){
  const float NEG=-INFINITY; int kb=64*jb+4*hi;
  #pragma unroll
  for(int r=0;r<16;++r){int kv=kb+(r&3)+8*(r>>2); if(kv>qrel)p0[r]=NEG; if(kv+32>qrel)p1[r]=NEG;}
}

constexpr int NSLOT=3, SLOTB=8192;
constexpr int LDS_K=0, LDS_V=NSLOT*SLOTB, LDS_WS=2*NSLOT*SLOTB, LDS_OST=LDS_WS+NW*64*4, LDS_BYTES=LDS_OST+NW*4096;
constexpr float C2=0.125f*1.4426950408889634f;
__device__ __forceinline__ void glds16(const void*gsrc,unsigned lds_dst){unsigned keep;
  asm volatile("s_mov_b32 %0, m0\n\ts_mov_b32 m0, %2\n\ts_nop 0\n\tglobal_load_lds_dwordx4 %1, off\n\ts_mov_b32 m0, %0":"=&s"(keep):"v"(gsrc),"s"(lds_dst):"memory");}
__device__ __forceinline__ float max3f(float a,float b,float c){float r;asm("v_max3_f32 %0, %1, %2, %3":"=v"(r):"v"(a),"v"(b),"v"(c));return r;}
__device__ __forceinline__ float max2f(float a,float b){float r;asm("v_max_f32_e32 %0, %1, %2":"=v"(r):"v"(a),"v"(b));return r;}
__device__ __forceinline__ float fadd_s(float a,float b){float r;asm("v_add_f32_e32 %0, %1, %2":"=v"(r):"v"(a),"v"(b));return r;}
__device__ __forceinline__ float fsub_s(float a,float b){float r;asm("v_sub_f32_e32 %0, %1, %2":"=v"(r):"v"(a),"v"(b));return r;}
typedef float f32x2_t __attribute__((ext_vector_type(2))); typedef __bf16 bf16x2_t __attribute__((ext_vector_type(2)));
__device__ __forceinline__ unsigned cvtpk_s(float lo,float hi){f32x2_t v={lo,hi};bf16x2_t b=__builtin_convertvector(v,bf16x2_t);return __builtin_bit_cast(unsigned,b);}
#define WAIT_BAR(N) asm volatile("s_waitcnt vmcnt(" #N ") lgkmcnt(0)\n\ts_barrier":::"memory")

__device__ __forceinline__ void qkt(f32x16&p0,f32x16&p1,const char*Kslot,const bf16x8*qr,const f32x16&negm,int r32,int hi){
  const char*kb=Kslot+hi*1024+r32*16;
  #pragma unroll
  for(int d0=0;d0<4;++d0){
    const bf16x8 b0=*reinterpret_cast<const bf16x8*>(kb+d0*2048);
    const bf16x8 b1=*reinterpret_cast<const bf16x8*>(kb+d0*2048+512);
    if(d0==0){p0=__builtin_amdgcn_mfma_f32_32x32x16_bf16(b0,qr[0],negm,0,0,0);p1=__builtin_amdgcn_mfma_f32_32x32x16_bf16(b1,qr[0],negm,0,0,0);}
    else{p0=__builtin_amdgcn_mfma_f32_32x32x16_bf16(b0,qr[d0],p0,0,0,0);p1=__builtin_amdgcn_mfma_f32_32x32x16_bf16(b1,qr[d0],p1,0,0,0);}}
}
typedef __attribute__((address_space(3))) const char* lds_cptr;
typedef short v4i16_t __attribute__((ext_vector_type(4)));
__device__ __forceinline__ void kload8(bf16x8*kf,lds_cptr kp){
  kf[0]=*(const __attribute__((address_space(3))) bf16x8*)(kp);      kf[1]=*(const __attribute__((address_space(3))) bf16x8*)(kp+512);
  kf[2]=*(const __attribute__((address_space(3))) bf16x8*)(kp+2048); kf[3]=*(const __attribute__((address_space(3))) bf16x8*)(kp+2560);
  kf[4]=*(const __attribute__((address_space(3))) bf16x8*)(kp+4096); kf[5]=*(const __attribute__((address_space(3))) bf16x8*)(kp+4608);
  kf[6]=*(const __attribute__((address_space(3))) bf16x8*)(kp+6144); kf[7]=*(const __attribute__((address_space(3))) bf16x8*)(kp+6656);
}
__device__ __forceinline__ void kload2(bf16x8*kf,lds_cptr kp,int j){ kf[2*j]=*(const __attribute__((address_space(3))) bf16x8*)(kp+j*2048); kf[2*j+1]=*(const __attribute__((address_space(3))) bf16x8*)(kp+j*2048+512); }
__device__ __forceinline__ s16x4 vtr(lds_cptr p){ return __builtin_bit_cast(s16x4,__builtin_amdgcn_ds_read_tr16_b64_v4i16((__attribute__((address_space(3))) v4i16_t*)p)); }
__device__ __forceinline__ float rowmax(const f32x16&p0,const f32x16&p1){
  float a=max3f(p0[0],p0[1],p1[0]),b=max3f(p0[2],p0[3],p1[1]);a=max3f(a,p1[2],p1[3]);
  #pragma unroll
  for(int r=4;r<16;r+=4){a=max3f(a,p0[r],p0[r+1]);b=max3f(b,p0[r+2],p0[r+3]);a=max3f(a,p1[r],p1[r+1]);b=max3f(b,p1[r+2],p1[r+3]);}
  const float m=max2f(a,b);
  auto rr=__builtin_amdgcn_permlane32_swap(__float_as_uint(m),__float_as_uint(m),false,false);
  return max2f(__uint_as_float(rr[0]),__uint_as_float(rr[1]));
}
__device__ __forceinline__ void pv(f32x16*o,int vb,bf16x8 pa0,bf16x8 pa1,bf16x8 pa2,bf16x8 pa3){
  #pragma unroll
  for(int d0=0;d0<2;++d0){s16x4 lo[4],hi[4];
    #pragma unroll
    for(int ks=0;ks<4;++ks){
      asm volatile("ds_read_b64_tr_b16 %0,%1 offset:%c2":"=&v"(lo[ks]):"v"(vb),"i"(d0*4096+ks*1024):"memory");
      asm volatile("ds_read_b64_tr_b16 %0,%1 offset:%c2":"=&v"(hi[ks]):"v"(vb),"i"(d0*4096+ks*1024+512):"memory");}
    asm volatile("s_waitcnt lgkmcnt(0)":::"memory");SBAR();
    #define PK(k) (bf16x8){lo[k][0],lo[k][1],lo[k][2],lo[k][3],hi[k][0],hi[k][1],hi[k][2],hi[k][3]}
    o[d0]=__builtin_amdgcn_mfma_f32_32x32x16_bf16(pa0,PK(0),o[d0],0,0,0);
    o[d0]=__builtin_amdgcn_mfma_f32_32x32x16_bf16(pa1,PK(1),o[d0],0,0,0);
    o[d0]=__builtin_amdgcn_mfma_f32_32x32x16_bf16(pa2,PK(2),o[d0],0,0,0);
    o[d0]=__builtin_amdgcn_mfma_f32_32x32x16_bf16(pa3,PK(3),o[d0],0,0,0);
    #undef PK
  }
}

typedef float f32x4_t __attribute__((ext_vector_type(4)));
typedef __attribute__((address_space(3))) const float* lds_fptr;
typedef __attribute__((address_space(3))) const f32x4_t* lds_f4ptr;
#define BIAS(P0,P1,t) do{ const lds_f4ptr bp_=(lds_f4ptr)(bl+(t)*64+4*hi); \
  _Pragma("unroll") for(int g_=0;g_<4;++g_){ { const f32x4_t v0_=bp_[2*g_]; \
    P0[4*g_]+=v0_[0];P0[4*g_+1]+=v0_[1];P0[4*g_+2]+=v0_[2];P0[4*g_+3]+=v0_[3]; } SBAR(); \
    { const f32x4_t v1_=bp_[8+2*g_]; \
    P1[4*g_]+=v1_[0];P1[4*g_+1]+=v1_[1];P1[4*g_+2]+=v1_[2];P1[4*g_+3]+=v1_[3]; } SBAR(); } }while(0)
#define PREFILL(P0,P1,t) do{ const lds_f4ptr bp_=(lds_f4ptr)(bl+(t)*64+4*hi); \
  _Pragma("unroll") for(int g_=0;g_<4;++g_){ { const f32x4_t v0_=bp_[2*g_]; \
    P0[4*g_]=v0_[0]-mhat;P0[4*g_+1]=v0_[1]-mhat;P0[4*g_+2]=v0_[2]-mhat;P0[4*g_+3]=v0_[3]-mhat; } SBAR(); \
    { const f32x4_t v1_=bp_[8+2*g_]; \
    P1[4*g_]=v1_[0]-mhat;P1[4*g_+1]=v1_[1]-mhat;P1[4*g_+2]=v1_[2]-mhat;P1[4*g_+3]=v1_[3]-mhat; } SBAR(); } }while(0)
#ifndef ATTN_STORE16
#define ATTN_STORE16(p,v) (*(u32x4*)(p)=(v))
#endif
template<int THRL> __device__ __forceinline__ void attn_unit(int b,int h,int qb,const bf16*Q,const bf16*__restrict__ K,const bf16*__restrict__ V,bf16*O,char*shm,lds_fptr bl,int t0){
  int tid=threadIdx.x; asm volatile("":"+v"(tid)); const int lane=tid&63,r32=lane&31,hi=lane>>5; const int wid=__builtin_amdgcn_readfirstlane(tid>>6);
  const long rowbase=(long)b*SEQ; const int q0=qb*QB;
  const bf16*Qw=Q+(rowbase+q0+wid*QBLK)*DM+h*D;
  const bf16*Kh=K+(rowbase+(long)t0*KVBLK)*DM+h*D,*Vh=V+(rowbase+(long)t0*KVBLK)*DM+h*D;
  const unsigned lds0=(unsigned)(uintptr_t)shm;
  float*wsf=(float*)(shm+LDS_WS)+wid*64;
  const bf16*ksrc=Kh+(long)lane*DM+wid*8;
  const bf16*vsrc=Vh+(long)(16*(wid&3)+(lane>>2))*DM+(wid>>2)*32+(lane&3)*8;
  const unsigned kdst=lds0+LDS_K+wid*1024, vdst=lds0+LDS_V+wid*1024;
  #define DMA_K(t,slot) glds16(ksrc+(long)(t)*KVBLK*DM,(unsigned)__builtin_amdgcn_readfirstlane(kdst+(slot)))
  #define DMA_V(t,slot) glds16(vsrc+(long)(t)*KVBLK*DM,(unsigned)__builtin_amdgcn_readfirstlane(vdst+(slot)))
  const int vb0=(int)(lds0+LDS_V)+((lane>>4)&1)*32+(lane&3)*8+(4*hi+((lane&15)>>2))*64;
  const char*Kbase=shm+LDS_K; bf16x8 kf[8];
  const lds_cptr shm3=(lds_cptr)shm; const lds_cptr kp0=shm3+LDS_K+hi*1024+r32*16; const lds_cptr vp0=shm3+LDS_V+((lane>>4)&1)*32+(lane&3)*8+(4*hi+((lane&15)>>2))*64;
  const int NT=(q0+QB)/KVBLK-t0;
  DMA_K(0,0);DMA_V(0,0);DMA_K(1,SLOTB);
  bf16x8 qr[4];
  #pragma unroll
  for(int d0=0;d0<4;++d0)qr[d0]=*reinterpret_cast<const bf16x8*>(&Qw[(long)r32*DM+d0*16+hi*8]);
  float mhat=0.f,l_reg=0.f;f32x16 o[2];o[0]=f32x16{};o[1]=f32x16{};f32x16 negm=f32x16{};asm volatile("":"+v"(negm));
  const int qrel=wid*QBLK+r32;
  #define CMASK(P0,P1,t) do{int jb_=(t)-(NT-4); if(jb_>=0)cmask(P0,P1,jb_,qrel,hi);}while(0)
  bool resc=false;
  #define START(P0,P1) do{ const float rm=rowmax(P0,P1); resc=false; \
    { const float dl=rm; mhat=fadd_s(mhat,dl); \
      _Pragma("unroll") for(int r=0;r<16;++r){P0[r]=fsub_s(P0[r],dl);P1[r]=fsub_s(P1[r],dl);} \
      } \
    _Pragma("unroll") for(int r=0;r<16;++r)P0[r]=__builtin_amdgcn_exp2f(P0[r]); }while(0)
  #define RESC() do{ if(resc){ asm volatile("s_waitcnt lgkmcnt(0)":::"memory"); \
      _Pragma("unroll") for(int d_=0;d_<2;++d_) _Pragma("unroll") for(int r=0;r<16;++r)o[d_][r]*=wsf[crow(r,hi)]; } }while(0)
  f32x16 pA0,pA1,pB0,pB1;
  int sl_prev=0,sl_cur=0,sl_next=SLOTB;
  #define ROT() do{sl_prev=sl_cur;sl_cur=sl_next;sl_next=(sl_next==(NSLOT-1)*SLOTB)?0:sl_next+SLOTB;}while(0)
  DMA_K(2,2*SLOTB);
  WAIT_BAR(3);
  qkt(pA0,pA1,Kbase,qr,negm,r32,hi);asm volatile("s_nop 15\n\ts_nop 7":"+v"(pA0),"+v"(pA1));BIAS(pA0,pA1,0);CMASK(pA0,pA1,0);
  START(pA0,pA1);
  PREFILL(pB0,pB1,1);
  _Pragma("unroll") for(int r=0;r<16;++r)pA1[r]=__builtin_amdgcn_exp2f(pA1[r]);
  WAIT_BAR(0);
  DMA_K(3,0);DMA_V(1,SLOTB);
  ROT();
  kload8(kf,kp0+sl_cur);
  WAIT_BAR(2);
  s16x4 vlo[8],vhi[8]; u32x4 pw0,pw1,pw2,pw3;
  #define PKW(P,B) cvtpk_s(P[B],P[B+1])
  #define PAF(k) __builtin_bit_cast(bf16x8,pw##k)
  #define VFR(i) (bf16x8){vlo[i][0],vlo[i][1],vlo[i][2],vlo[i][3],vhi[i][0],vhi[i][1],vhi[i][2],vhi[i][3]}
  #define PIN(x) asm volatile("":"+v"(x))
  #define MX3(a,b,c) __builtin_fmaxf(__builtin_fmaxf((a),(b)),(c))
  #define GAPA(MF,A0,A1,A2,A3,W0,W1,PW) do{ MF; sacc+=A0; sacc+=A1; sacc+=A2; sacc+=A3; PIN(sacc); W0; W1; PIN(PW); SBAR(); }while(0)
  #define EX(v) __builtin_amdgcn_exp2f(v)
  #define GAPB(MF,X,B,PRE) do{ MF; PRE; X[B]=EX(X[B]); X[B+1]=EX(X[B+1]); X[B+2]=EX(X[B+2]); X[B+3]=EX(X[B+3]); PIN(X); SBAR(); }while(0)
  #define PREF(P,g,nf4) do{ P[4*(g)]=vq_[0]-mhat; P[4*(g)+1]=vq_[1]-mhat; P[4*(g)+2]=vq_[2]-mhat; P[4*(g)+3]=vq_[3]-mhat; vq_=bpn_[nf4]; }while(0)
  #define VRD(i) do{ vlo[i]=vtr(vp_+(((i)>>2)*4096+((i)&3)*1024)); vhi[i]=vtr(vp_+(((i)>>2)*4096+((i)&3)*1024+512)); }while(0)
  #define KRD(G,j) do{ if(G){ kload2(kf,kp0+sl_next,j); SBAR(); } }while(0)
  #define STEP(C0,C1,P0,P1,t,GK,GV,GL) do{ SBAR(); \
    const lds_cptr vp_=vp0+sl_prev; \
    VRD(0); SBAR(); float sacc=(P0[0]+P0[1]); \
    GAPA(C0=__builtin_amdgcn_mfma_f32_32x32x16_bf16(kf[0],qr[0],C0,0,0,0), P0[2],P0[3],P0[4],P0[5],     pw0[0]=PKW(P0,0), pw0[1]=PKW(P0,2), pw0); \
    VRD(4); SBAR(); GAPA(C1=__builtin_amdgcn_mfma_f32_32x32x16_bf16(kf[1],qr[0],C1,0,0,0), P0[6],P0[7],P0[8],P0[9],     pw0[2]=PKW(P0,4), pw0[3]=PKW(P0,6), pw0); \
    VRD(1); SBAR(); GAPA(C0=__builtin_amdgcn_mfma_f32_32x32x16_bf16(kf[2],qr[1],C0,0,0,0),   P0[10],P0[11],P0[12],P0[13], pw1[0]=PKW(P0,8), pw1[1]=PKW(P0,10), pw1); \
    VRD(5); SBAR(); GAPA(C1=__builtin_amdgcn_mfma_f32_32x32x16_bf16(kf[3],qr[1],C1,0,0,0),   P0[14],P0[15],P1[0],P1[1],   pw1[2]=PKW(P0,12),pw1[3]=PKW(P0,14), pw1); \
    VRD(2); SBAR(); GAPA(C0=__builtin_amdgcn_mfma_f32_32x32x16_bf16(kf[4],qr[2],C0,0,0,0),   P1[2],P1[3],P1[4],P1[5],     pw2[0]=PKW(P1,0), pw2[1]=PKW(P1,2), pw2); \
    VRD(6); SBAR(); GAPA(C1=__builtin_amdgcn_mfma_f32_32x32x16_bf16(kf[5],qr[2],C1,0,0,0),   P1[6],P1[7],P1[8],P1[9],     pw2[2]=PKW(P1,4), pw2[3]=PKW(P1,6), pw2); \
    VRD(3); SBAR(); GAPA(C0=__builtin_amdgcn_mfma_f32_32x32x16_bf16(kf[6],qr[3],C0,0,0,0),   P1[10],P1[11],P1[12],P1[13], pw3[0]=PKW(P1,8), pw3[1]=PKW(P1,10), pw3); \
    VRD(7); SBAR(); GAPA(C1=__builtin_amdgcn_mfma_f32_32x32x16_bf16(kf[7],qr[3],C1,0,0,0),   P1[14],P1[15],0.f,0.f,       pw3[2]=PKW(P1,12),pw3[3]=PKW(P1,14), pw3); \
    l_reg+=sacc; \
    if(GK){DMA_K((t)+3,sl_cur);} if(GV){DMA_V((t)+1,sl_next);} \
    CMASK(C0,C1,t); \
    { float a=MX3(C0[0],C0[1],C1[0]),b=MX3(C0[2],C0[3],C1[1]); a=MX3(a,C1[2],C1[3]); \
      _Pragma("unroll") for(int r=4;r<16;r+=4){a=MX3(a,C0[r],C0[r+1]);b=MX3(b,C0[r+2],C0[r+3]);a=MX3(a,C1[r],C1[r+1]);b=MX3(b,C1[r+2],C1[r+3]);} \
      float rm=__builtin_fmaxf(a,b); { auto rr=__builtin_amdgcn_permlane32_swap(__float_as_uint(rm),__float_as_uint(rm),false,false); rm=__builtin_fmaxf(__uint_as_float(rr[0]),__uint_as_float(rr[1])); } \
      resc=false; \
      if(__builtin_expect(__any(rm>(float)THRL),0)){ const float dl=__builtin_fmaxf(rm,0.f); mhat+=dl; \
        _Pragma("unroll") for(int r=0;r<16;++r){C0[r]-=dl;C1[r]-=dl;} \
        const float f=__builtin_amdgcn_exp2f(-dl); l_reg*=f; if(hi==0)wsf[r32]=f; resc=true; } } \
    const lds_f4ptr bpn_=(lds_f4ptr)(bl+((t)+1)*64+4*hi); f32x4_t vq_=bpn_[0]; \
    SBAR(); \
    GAPB(o[0]=__builtin_amdgcn_mfma_f32_32x32x16_bf16(PAF(0),VFR(0),o[0],0,0,0), C0,0, PREF(P0,0,2)); \
    GAPB(o[1]=__builtin_amdgcn_mfma_f32_32x32x16_bf16(PAF(0),VFR(4),o[1],0,0,0), C0,4, PREF(P0,1,4)); \
    KRD(GL,0); GAPB(o[0]=__builtin_amdgcn_mfma_f32_32x32x16_bf16(PAF(1),VFR(1),o[0],0,0,0), C0,8, PREF(P0,2,6)); \
    KRD(GL,1); GAPB(o[1]=__builtin_amdgcn_mfma_f32_32x32x16_bf16(PAF(1),VFR(5),o[1],0,0,0), C0,12, PREF(P0,3,8)); \
    KRD(GL,2); GAPB(o[0]=__builtin_amdgcn_mfma_f32_32x32x16_bf16(PAF(2),VFR(2),o[0],0,0,0), C1,0, PREF(P1,0,10)); \
    KRD(GL,3); GAPB(o[1]=__builtin_amdgcn_mfma_f32_32x32x16_bf16(PAF(2),VFR(6),o[1],0,0,0), C1,4, PREF(P1,1,12)); \
    GAPB(o[0]=__builtin_amdgcn_mfma_f32_32x32x16_bf16(PAF(3),VFR(3),o[0],0,0,0), C1,8, PREF(P1,2,14)); \
    GAPB(o[1]=__builtin_amdgcn_mfma_f32_32x32x16_bf16(PAF(3),VFR(7),o[1],0,0,0), C1,12, PREF(P1,3,14)); \
    }while(0)
  int t=1;
  #undef CMASK
  #define CMASK(P0,P1,t) do{}while(0)
  for(;t+5<NT;t+=2){
    STEP(pB0,pB1,pA0,pA1,t,true,true,true);     WAIT_BAR(2); RESC(); ROT();
    STEP(pA0,pA1,pB0,pB1,t+1,true,true,true);   WAIT_BAR(2); RESC(); ROT();
  }
  #undef CMASK
  #define CMASK(P0,P1,t) do{int jb_=(t)-(NT-4); if(jb_>=0)cmask(P0,P1,jb_,qrel,hi);}while(0)
  #define ENDW(tt) do{ if((tt)+3<NT){WAIT_BAR(2);} else if((tt)+2<NT){WAIT_BAR(1);} else {WAIT_BAR(0);} }while(0)
  for(;t+1<NT;t+=2){
    STEP(pB0,pB1,pA0,pA1,t,(t+3<NT),(t+1<NT),(t+1<NT));       ENDW(t);   RESC(); ROT();
    STEP(pA0,pA1,pB0,pB1,t+1,(t+4<NT),(t+2<NT),(t+2<NT));     ENDW(t+1); RESC(); ROT();
  }
  STEP(pB0,pB1,pA0,pA1,NT-1,false,false,false); RESC();
  { float sacc=pB0[0]+pB0[1]; _Pragma("unroll") for(int r=2;r<16;++r)sacc+=pB0[r]; _Pragma("unroll") for(int r=0;r<16;++r)sacc+=pB1[r]; l_reg+=sacc;
    pw0=(u32x4){PKW(pB0,0),PKW(pB0,2),PKW(pB0,4),PKW(pB0,6)};pw1=(u32x4){PKW(pB0,8),PKW(pB0,10),PKW(pB0,12),PKW(pB0,14)};pw2=(u32x4){PKW(pB1,0),PKW(pB1,2),PKW(pB1,4),PKW(pB1,6)};pw3=(u32x4){PKW(pB1,8),PKW(pB1,10),PKW(pB1,12),PKW(pB1,14)};
    SBAR(); pv(o,vb0+sl_cur,PAF(0),PAF(1),PAF(2),PAF(3)); }
  #undef PKW
  #undef PAF
  #undef VFR
  #undef PIN
  #undef MX3
  #undef GAPA
  #undef GAPB
  #undef PREF
  #undef EX
  #undef VRD
  #undef KRD
  #undef STEP
  #undef ENDW
  {auto rr=__builtin_amdgcn_permlane32_swap(__float_as_uint(l_reg),__float_as_uint(l_reg),false,false);l_reg=__uint_as_float(rr[0])+__uint_as_float(rr[1]);}
  if(hi==0)wsf[32+r32]=l_reg;asm volatile("s_waitcnt lgkmcnt(0)":::"memory");
  float rli[16];
  #pragma unroll
  for(int r=0;r<16;++r)rli[r]=__builtin_amdgcn_rcpf(wsf[32+crow(r,hi)]);
  bf16*Ow=O+(rowbase+q0+wid*QBLK)*DM+h*D;
  { bf16*stg=(bf16*)(shm+LDS_OST)+wid*2048;
    #pragma unroll
    for(int r=0;r<16;++r){const int orow=crow(r,hi);
      #pragma unroll
      for(int d0=0;d0<2;++d0)stg[orow*64+d0*32+r32]=__float2bfloat16(o[d0][r]*rli[r]);}
    asm volatile("s_waitcnt lgkmcnt(0)":::"memory");
    #pragma unroll
    for(int i=0;i<4;++i){const int row=i*8+(lane>>3),ch=lane&7; const u32x4 v=*(const u32x4*)(stg+row*64+ch*8); ATTN_STORE16(Ow+(long)row*DM+ch*8,v);} }
  asm volatile("s_waitcnt lgkmcnt(0)\n\ts_barrier":::"memory");
  #undef DMA_K
  #undef DMA_V
  #undef CMASK
  #undef START
  #undef RESC
  #undef ROT
}
constexpr int ATTN_LDS_BYTES=LDS_BYTES;
struct AttnTensors { const bf16* Q; const bf16* K; const bf16* V; bf16* O; };
struct AttnUnit { int bh; int qb; };
struct StaticOrder {
  int vcu, G;
  __device__ __forceinline__ explicit StaticOrder(int grid,int block):vcu((grid%8==0)?(block%8)*(grid/8)+block/8:block),G(grid){}
  __device__ __forceinline__ bool next(int i,AttnUnit&u)const{
    if(G==256){ if(i>=8)return false; const int s=vcu&3; u.bh=vcu>>2; const int base=8*(i>>1); u.qb=(i&1)?base+7-s:base+s; return true; }
    const int L=i*G+vcu; if(L>=BATCH*NHEAD*NQB)return false; u.bh=L/NQB; u.qb=NQB-1-(L%NQB); return true; }
  __device__ __forceinline__ void a_ready(const AttnUnit&)const{}
  __device__ __forceinline__ void done(const AttnUnit&)const{}
};
constexpr float PRUNE_LOG2=40.0f;
template<int THRL=8> __device__ __forceinline__ void attn_phase_dyn(char*lds,const AttnTensors&T,const float*CB,const float*qg,const float*kg,unsigned*ctr){
  int tid=threadIdx.x; asm volatile("":"+v"(tid)); const int lane=tid&63;
  __attribute__((address_space(3))) int* sh=(__attribute__((address_space(3))) int*)(lds+LDS_BYTES+32768);
  float gq=fabsf(qg[lane]),gk=fabsf(kg[lane]);
  #pragma unroll
  for(int o=1;o<64;o<<=1){gq=fmaxf(gq,__shfl_xor(gq,o));gk=fmaxf(gk,__shfl_xor(gk,o));}
  const float thresh=2.0f*(8.25f*gq*gk*1.4426950408889634f)+PRUNE_LOG2;
  for(;;){
    __syncthreads();
    if(tid<64){ int ui=0; if(tid==0)ui=(int)atomicAdd(ctr,1u); ui=__shfl(ui,0);
      int t0=0;
      if(ui<BATCH*NHEAD*NQB){ const int qb=NQB-1-ui/(BATCH*NHEAD),bh=ui%(BATCH*NHEAD),q0=qb*QB,NT=(q0+QB)/KVBLK; const float*row=CB+(long)bh*SEQ; const float cq=row[q0];
        int cnt=0;
        #pragma unroll
        for(int j=0;j<2;++j){ const int t=lane+64*j; const bool p=(t<NT)&&(cq-row[t*64+63]>thresh); cnt+=__popcll(__ballot(p)); }
        t0=cnt&~1; if(t0>NT-4)t0=NT-4; }
      if(tid==0){sh[0]=ui;sh[1]=t0;} }
    __syncthreads();
    const int ui=sh[0],t0=sh[1];
    if(ui>=BATCH*NHEAD*NQB)break;
    const int qb=NQB-1-ui/(BATCH*NHEAD),bh=ui%(BATCH*NHEAD);
    { float*bl=(float*)(lds+LDS_BYTES); const f32x4_t*src=(const f32x4_t*)(CB+(long)bh*SEQ); const int lo=t0*16,hi4=(qb+1)*64;
      for(int j=lo+tid;j<hi4;j+=NW*64)((f32x4_t*)bl)[j]=src[j]; }
    __syncthreads();
    attn_unit<THRL>(bh/NHEAD,bh%NHEAD,qb,T.Q,T.K,T.V,T.O,lds,(lds_fptr)(lds+LDS_BYTES)+t0*64,t0);
  }
}
#undef BIAS
#undef PREFILL
#undef SBAR
#undef WAIT_BAR
}
#define LAS __attribute__((address_space(3)))
typedef unsigned short bfu;
typedef unsigned v4u __attribute__((ext_vector_type(4)));
typedef unsigned v2u __attribute__((ext_vector_type(2)));
typedef float f32x4 __attribute__((ext_vector_type(4)));
typedef float f32x2 __attribute__((ext_vector_type(2)));
typedef float f32x16 __attribute__((ext_vector_type(16)));
typedef short bf16x8 __attribute__((ext_vector_type(8)));
typedef __bf16 bf16x2_t __attribute__((ext_vector_type(2)));
constexpr int M = 32768, D = 1024, SEQ = 8192, NWV = 8, NTH = 512;
constexpr int EVEN_IN = 2576, EVEN_PAD = 2816, ODD_PAD = 3328, ODD_IN = 3088;
constexpr size_t MiB = 1u << 20;
constexpr size_t WS_SS = 0, WS_SSP = 1 * MiB, WS_LFT = 3 * MiB, WS_CB = 5 * MiB, WS_DEC = 7 * MiB, WS_USC = 7 * MiB + 512 * 1024, WS_BAR = 7 * MiB + 768 * 1024, WS_KEYS = 8 * MiB, WS_WINE = 9 * MiB, WS_WOUTE = 15 * MiB,
                 WS_WINO = 17 * MiB, WS_WOUTO = 24 * MiB, WS_WQ = 26 * MiB, WS_UV = 34 * MiB, WS_XB = 162 * MiB, WS_R1 = 226 * MiB, WS_R2 = 418 * MiB,
                 WS_EXP = 482 * MiB, WS_GATE = 490 * MiB, WS_END = 506 * MiB;
constexpr int LDS_BYTES = 147456;
constexpr float EPSF = 1e-6f;

__device__ __forceinline__ int tid_fresh() { int t = threadIdx.x; asm volatile("" : "+v"(t)); return t; }
__device__ __forceinline__ int bid_fresh() { int b = __builtin_amdgcn_workgroup_id_x(); asm volatile("" : "+s"(b)); return b; }
#define LDS_WAIT() asm volatile("s_waitcnt lgkmcnt(0)" ::: "memory")
__device__ __forceinline__ void lds_barrier() { asm volatile("s_waitcnt lgkmcnt(0)\n\ts_barrier" ::: "memory"); }
__device__ __forceinline__ float bf2f(unsigned u16) { return __uint_as_float(u16 << 16); }
__device__ __forceinline__ float bflo(unsigned w) { return __uint_as_float(w << 16); }
__device__ __forceinline__ float bfhi(unsigned w) { return __uint_as_float(w & 0xffff0000u); }
__device__ __forceinline__ unsigned pk2(float lo, float hi) { f32x2 v = {lo, hi}; bf16x2_t b = __builtin_convertvector(v, bf16x2_t); return __builtin_bit_cast(unsigned, b); }
__device__ __forceinline__ unsigned short f2bf(float f) { return (unsigned short)(pk2(f, 0.f) & 0xffffu); }
__device__ __forceinline__ float wave_sum(float v) {
#pragma unroll
    for (int o = 1; o < 64; o <<= 1) v += __shfl_xor(v, o);
    return v;
}
__device__ __forceinline__ float sigmoidf_(float x) { return __builtin_amdgcn_rcpf(1.0f + __builtin_amdgcn_exp2f(-1.4426950408889634f * x)); }
__device__ __forceinline__ float logsigf_(float z) { return fminf(z, 0.f) - 0.69314718056f * __builtin_amdgcn_logf(1.0f + __builtin_amdgcn_exp2f(-1.4426950408889634f * fabsf(z))); }
__device__ __forceinline__ int crow(int r, int hi) { return (r & 3) + 8 * (r >> 2) + 4 * hi; }

__device__ __forceinline__ void transpose_item(const float* W, const float* gain, int K, int N, bfu* WT, LAS float* scr, int item, int nblk, int lane) {
    const int kb = item / nblk, nb = item % nblk, k0 = 64 * kb, n0 = 32 * nb; const int n = n0 + (lane & 31); const bool ok = n < N;
#pragma unroll 8
    for (int i = 0; i < 32; ++i) { const int kk = 2 * i + (lane >> 5); float v = 0.f; if (ok) { v = W[(size_t)(k0 + kk) * N + n]; if (gain) v *= gain[k0 + kk]; } scr[kk * 33 + (lane & 31)] = v; }
    LDS_WAIT();
    const int c = lane & 7;
#pragma unroll
    for (int j = 0; j < 4; ++j) { const int nn = (lane >> 3) + 8 * j; const LAS float* s = scr + (8 * c) * 33 + nn;
        v4u o; o.x = pk2(s[0 * 33], s[1 * 33]); o.y = pk2(s[2 * 33], s[3 * 33]); o.z = pk2(s[4 * 33], s[5 * 33]); o.w = pk2(s[6 * 33], s[7 * 33]);
        *(v4u*)(WT + (size_t)(n0 + nn) * K + k0 + 8 * c) = o; }
    LDS_WAIT();
}
__device__ __forceinline__ void cvt8(const float* src, bfu* dst) {
    const f32x4 a = *(const f32x4*)src, b = *(const f32x4*)(src + 4);
    v4u o; o.x = pk2(a[0], a[1]); o.y = pk2(a[2], a[3]); o.z = pk2(b[0], b[1]); o.w = pk2(b[2], b[3]); *(v4u*)dst = o;
}
__device__ __forceinline__ void p0_prologue(const float* const* in, unsigned char* ws, LAS unsigned char* lds, int G) {
    const int tid = tid_fresh(), lane = tid & 63, wave = tid >> 6; const int gw = bid_fresh() * NWV + wave, NGW = G * NWV;
    LAS float* scr = (LAS float*)(lds + wave * 16384);
    for (int st = 0; st < 3; ++st) { const int kind = (wave & 1) ? st : (st + 1) % 3;
    if (kind == 0) {
    const int I0 = 16 * (EVEN_PAD / 32), I1 = 16 * 32, I2 = 16 * (ODD_PAD / 32), I3 = 16 * 32, I4 = 16 * 64, I5 = 16 * 64;
    const int NIT = I0 + I1 + I2 + I3 + I4 + I5;
    for (int it = gw; it < NIT; it += NGW) {
        int r = it;
        if (r < I0) { transpose_item(in[2], in[1], 1024, EVEN_IN, (bfu*)(ws + WS_WINE), scr, r, EVEN_PAD / 32, lane); continue; } r -= I0;
        if (r < I1) { transpose_item(in[10], nullptr, 1024, 1024, (bfu*)(ws + WS_WOUTE), scr, r, 32, lane); continue; } r -= I1;
        if (r < I2) { transpose_item(in[12], in[11], 1024, ODD_IN, (bfu*)(ws + WS_WINO), scr, r, ODD_PAD / 32, lane); continue; } r -= I2;
        if (r < I3) { transpose_item(in[16], nullptr, 1024, 1024, (bfu*)(ws + WS_WOUTO), scr, r, 32, lane); continue; } r -= I3;
        if (r < I4) { transpose_item(in[18], in[17], 1024, 2048, (bfu*)(ws + WS_WQ), scr, r, 64, lane); continue; } r -= I4;
        transpose_item(in[18] + (size_t)1024 * 2048, in[17] + 1024, 1024, 2048, (bfu*)(ws + WS_WQ + 4 * MiB), scr, r, 64, lane);
    }
    } else if (kind == 1) {
    const int gt = bid_fresh() * NTH + tid, NGT = G * NTH;
    for (int r = gw; r < 65536; r += NGW) { const int chunk = r >> 14, row = r & 16383;
        const float* src = ((chunk & 1) ? in[21] : in[20]) + (size_t)(chunk >> 1) * 16777216 + (size_t)row * 1024 + 16 * lane;
        f32x4 a[4]; float mx = 0.f;
#pragma unroll
        for (int q = 0; q < 4; ++q) { a[q] = *(const f32x4*)(src + 4 * q); mx = fmaxf(mx, fmaxf(fmaxf(fabsf(a[q][0]), fabsf(a[q][1])), fmaxf(fabsf(a[q][2]), fabsf(a[q][3])))); }
#pragma unroll
        for (int o = 1; o < 64; o <<= 1) mx = fmaxf(mx, __shfl_xor(mx, o));
        const float scale = (mx > 0.f) ? mx * (1.0f / 127.0f) : 1.0f, inv = 1.0f / scale; const int off = 0;
        v4u o;
#pragma unroll
        for (int q = 0; q < 4; ++q) { unsigned w = 0;
#pragma unroll
            for (int k = 0; k < 4; ++k) { const int qi = (int)__builtin_rintf(a[q][k] * inv) + off; w |= ((unsigned)qi & 0xffu) << (8 * k); }
            o[q] = w; }
        if (chunk & 1) *(v4u*)(ws + WS_UV + (size_t)chunk * 16777216 + ((size_t)(lane >> 3) * 16384 + row) * 128 + 16 * (lane & 7)) = o;
        else *(v4u*)(ws + WS_UV + (size_t)chunk * 16777216 + (size_t)row * 1024 + 16 * lane) = o;
        if (lane == 0) ((float*)(ws + WS_USC))[r] = scale; }
    for (int g = gt; g < 65536; g += NGT) cvt8(in[19] + (size_t)g * 8, (bfu*)(ws + WS_KEYS) + (size_t)g * 8);
    } else {
    for (int m = gw; m < M; m += NGW) { const f32x4* xr = (const f32x4*)(in[0] + (size_t)m * D) + lane; v2u* o8 = (v2u*)((bfu*)(ws + WS_XB) + (size_t)m * D) + lane; float s = 0.f;
#pragma unroll
        for (int j = 0; j < 4; ++j) { const f32x4 v = xr[64 * j]; s += (v[0] * v[0] + v[1] * v[1]) + (v[2] * v[2] + v[3] * v[3]); v2u o; o.x = pk2(v[0], v[1]); o.y = pk2(v[2], v[3]); o8[64 * j] = o; }
        s = wave_sum(s); if (lane == 0) ((float*)(ws + WS_SS))[m] = s;     } }
}
}
__device__ __forceinline__ float row_rstd16(const float* ss, int row) { return pg8::row_rstd<16>(ss, row); }
__device__ __forceinline__ void conv_unit(const bfu* P, const float* cw, const float* cb, const float* lng, const float* lnb, bfu* Y, LAS unsigned char* lds, int unit) {
    const int tid = tid_fresh(), lane = tid & 63, wave = tid >> 6, c = tid; const int row0 = unit * 32, tseq0 = row0 & (SEQ - 1);
    LAS float* U = (LAS float*)lds;
    float u[62];
#pragma unroll
    for (int i = 0; i < 62; ++i) { const int trel = i - 30; float v = 0.f;
        if (tseq0 + trel >= 0) { const bfu* pr = P + (size_t)(row0 + trel) * EVEN_IN; const float val = bf2f(pr[c]), gate = bf2f(pr[512 + c]); v = val * sigmoidf_(gate); }
        u[i] = v; }
    float w[31];
#pragma unroll
    for (int j = 0; j < 31; ++j) w[j] = cw[j * 512 + c];
    const float bias = cb[c];
#pragma unroll
    for (int i = 0; i < 32; ++i) { float a = bias;
#pragma unroll
        for (int j = 0; j < 31; ++j) a += w[j] * u[i + j];
        U[i * 512 + c] = a; }
    lds_barrier();
    const f32x4 g0 = *(const f32x4*)(lng + 8 * lane), g1 = *(const f32x4*)(lng + 8 * lane + 4), b0 = *(const f32x4*)(lnb + 8 * lane), b1 = *(const f32x4*)(lnb + 8 * lane + 4);
#pragma unroll
    for (int q = 0; q < 4; ++q) { const int i = wave * 4 + q; const f32x4 v0 = *(const LAS f32x4*)(U + i * 512 + 8 * lane), v1 = *(const LAS f32x4*)(U + i * 512 + 8 * lane + 4);
        const float mean = wave_sum((v0[0] + v0[1]) + (v0[2] + v0[3]) + (v1[0] + v1[1]) + (v1[2] + v1[3])) * (1.f / 512.f);
        const f32x4 d0 = v0 - mean, d1 = v1 - mean;
        const float var = wave_sum((d0[0] * d0[0] + d0[1] * d0[1]) + (d0[2] * d0[2] + d0[3] * d0[3]) + (d1[0] * d1[0] + d1[1] * d1[1]) + (d1[2] * d1[2] + d1[3] * d1[3])) * (1.f / 512.f);
        const float rstd = __builtin_amdgcn_rsqf(var + EPSF);
        f32x4 o0 = d0 * rstd * g0 + b0, o1 = d1 * rstd * g1 + b1;
#pragma unroll
        for (int k = 0; k < 4; ++k) { o0[k] = o0[k] * sigmoidf_(o0[k]); o1[k] = o1[k] * sigmoidf_(o1[k]); }
        v4u o; o.x = pk2(o0[0], o0[1]); o.y = pk2(o0[2], o0[3]); o.z = pk2(o1[0], o1[1]); o.w = pk2(o1[2], o1[3]);
        *(v4u*)(Y + (size_t)(row0 + i) * D + 8 * lane) = o; }
    lds_barrier();
}

constexpr int GL_GLR = 0, GL_TOT = 4096, GL_B = 6144, GL_KT = 22528, GL_VT = 31744, GL_Q = 50176, GL_K = 59392, GL_ST = 68608, GL_AT = 87040, GL_O = 96256;
constexpr int GLD = 72;
__device__ __forceinline__ void gla_decay(const bfu* P, const float* gw2, const float* gb, LAS unsigned char* lds, int row0, int h, float (&bl)[8], float& blast) {
    const int tid = tid_fresh(), lane = tid & 63, wave = tid >> 6;
    LAS float* GLR = (LAS float*)(lds + GL_GLR); LAS float* TOT = (LAS float*)(lds + GL_TOT);
    { const int idx = tid * 2, t = idx >> 4, j = idx & 15; const unsigned w = *(const unsigned*)(P + (size_t)(row0 + t) * EVEN_IN + 2560 + j); GLR[idx] = bflo(w); GLR[idx + 1] = bfhi(w); }
    float w2[16];
#pragma unroll
    for (int j = 0; j < 16; ++j) w2[j] = gw2[j * 256 + h * 64 + lane];
    const float gbv = gb[h * 64 + lane];
    lds_barrier();
    float run = 0.f;
#pragma unroll
    for (int i = 0; i < 8; ++i) { const int t = wave * 8 + i; float z = gbv;
#pragma unroll
        for (int j4 = 0; j4 < 4; ++j4) { const f32x4 g = *(const LAS f32x4*)(GLR + t * 16 + 4 * j4); z += g[0] * w2[4 * j4] + g[1] * w2[4 * j4 + 1] + g[2] * w2[4 * j4 + 2] + g[3] * w2[4 * j4 + 3]; }
        run += logsigf_(z) * (1.0f / 16.0f); bl[i] = run; }
    TOT[wave * 64 + lane] = run;
    lds_barrier();
    float off = 0.f, tot = 0.f;
#pragma unroll
    for (int s = 0; s < 8; ++s) { const float v = TOT[s * 64 + lane]; if (s < wave) off += v; tot += v; }
#pragma unroll
    for (int i = 0; i < 8; ++i) bl[i] += off;
    blast = tot;
}
struct VtRaw { unsigned short e[2][8]; };
__device__ __forceinline__ void gla_load_vt(VtRaw& r, const bfu* P, int row0, int h, int tid) {
#pragma unroll
    for (int q = 0; q < 2; ++q) { const int p = tid + q * 512, vv = p & 127, sg = p >> 7; const bfu* src = P + (size_t)(row0 + 8 * sg) * EVEN_IN + 1536 + h * 128 + vv;
#pragma unroll
        for (int i = 0; i < 8; ++i) r.e[q][i] = src[(size_t)i * EVEN_IN]; }
}
__device__ __forceinline__ void gla_store_vt(const VtRaw& r, LAS unsigned char* lds, int tid) {
#pragma unroll
    for (int q = 0; q < 2; ++q) { const int p = tid + q * 512, vv = p & 127, sg = p >> 7; const unsigned short* e = r.e[q];
        v4u o; o.x = e[0] | ((unsigned)e[1] << 16); o.y = e[2] | ((unsigned)e[3] << 16); o.z = e[4] | ((unsigned)e[5] << 16); o.w = e[6] | ((unsigned)e[7] << 16);
        *(LAS v4u*)(lds + GL_VT + (vv * GLD + 8 * sg) * 2) = o; }
}
__device__ __forceinline__ bf16x8 lds_frag(LAS unsigned char* lds, int base, int row, int kofs) { return *(const LAS bf16x8*)(lds + base + (row * GLD + kofs) * 2); }

__device__ __forceinline__ void gla_g1_unit(const bfu* P, const float* gw2, const float* gb, float* ST, float* DEC, LAS unsigned char* lds, int ug) {
    const int tid = tid_fresh(), lane = tid & 63, wave = tid >> 6, r32 = lane & 31, hi = lane >> 5;
    const int bh = ug >> 7, n = ug & 127, b = bh >> 2, h = bh & 3, row0 = b * SEQ + 64 * n;
    VtRaw vraw; gla_load_vt(vraw, P, row0, h, tid); unsigned short kraw[8];
#pragma unroll
    for (int i = 0; i < 8; ++i) kraw[i] = P[(size_t)(row0 + wave * 8 + i) * EVEN_IN + 1280 + h * 64 + lane];
    float bl[8], blast; gla_decay(P, gw2, gb, lds, row0, h, bl, blast);
    { unsigned short e[8];
#pragma unroll
      for (int i = 0; i < 8; ++i) { const float kv = bf2f(kraw[i]); e[i] = f2bf(kv * __expf(blast - bl[i])); }
      v4u o; o.x = e[0] | ((unsigned)e[1] << 16); o.y = e[2] | ((unsigned)e[3] << 16); o.z = e[4] | ((unsigned)e[5] << 16); o.w = e[6] | ((unsigned)e[7] << 16);
      *(LAS v4u*)(lds + GL_KT + (lane * GLD + 8 * wave) * 2) = o;
      if (wave == 0) DEC[(size_t)ug * 64 + lane] = __expf(blast); }
    gla_store_vt(vraw, lds, tid);
    lds_barrier();
    const int vb = wave >> 1, kb = wave & 1; f32x16 acc = {};
#pragma unroll
    for (int ks = 0; ks < 4; ++ks) acc = __builtin_amdgcn_mfma_f32_32x32x16_bf16(lds_frag(lds, GL_VT, vb * 32 + r32, 16 * ks + 8 * hi), lds_frag(lds, GL_KT, kb * 32 + r32, 16 * ks + 8 * hi), acc, 0, 0, 0);
    float* dst = ST + (size_t)ug * 8192 + kb * 32 + r32;
#pragma unroll
    for (int r = 0; r < 16; ++r) dst[(vb * 32 + crow(r, hi)) * 64] = acc[r];
    lds_barrier();
}
__device__ __forceinline__ void gla_g2(float* ST, const float* DEC, int G) {
    for (int gid = bid_fresh() * NTH + tid_fresh(); gid < 16 * 8192; gid += G * NTH) { const int bh = gid >> 13, e = gid & 8191, kk = e & 63;
        float* p = ST + (size_t)bh * 128 * 8192 + e; const float* d = DEC + (size_t)bh * 128 * 64 + kk; float s = 0.f;
        for (int n0 = 0; n0 < 128; n0 += 8) { float loc[8], dc[8];
#pragma unroll
            for (int i = 0; i < 8; ++i) { loc[i] = p[(size_t)(n0 + i) * 8192]; dc[i] = d[(n0 + i) * 64]; }
#pragma unroll
            for (int i = 0; i < 8; ++i) { p[(size_t)(n0 + i) * 8192] = s; s = s * dc[i] + loc[i]; } } }
}
__device__ __forceinline__ void gla_g3_unit(const bfu* P, const float* gw2, const float* gb, const float* ng, const float* ST, bfu* Y, LAS unsigned char* lds, int ug) {
    const int tid = tid_fresh(), lane = tid & 63, wave = tid >> 6, r32 = lane & 31, hi = lane >> 5;
    const int bh = ug >> 7, n = ug & 127, b = bh >> 2, h = bh & 3, row0 = b * SEQ + 64 * n;
    VtRaw vraw; gla_load_vt(vraw, P, row0, h, tid); unsigned short qraw[8], kraw[8]; unsigned rraw[8]; f32x4 sraw[2][2];
#pragma unroll
    for (int i = 0; i < 8; ++i) { const int t = wave * 8 + i; const bfu* pr = P + (size_t)(row0 + t) * EVEN_IN + h * 64 + lane; qraw[i] = pr[1024]; kraw[i] = pr[1280];
        rraw[i] = *(const unsigned*)(P + (size_t)(row0 + t) * EVEN_IN + 2048 + h * 128 + 2 * lane); }
#pragma unroll
    for (int q = 0; q < 2; ++q) { const int gq = tid + q * 512, vv = gq >> 3, k8 = (gq & 7) * 8; const float* src = ST + (size_t)ug * 8192 + vv * 64 + k8; sraw[q][0] = *(const f32x4*)src; sraw[q][1] = *(const f32x4*)(src + 4); }
    float bl[8], blast; gla_decay(P, gw2, gb, lds, row0, h, bl, blast);
#pragma unroll
    for (int i = 0; i < 8; ++i) { const int t = wave * 8 + i;
        const float qv = bf2f(qraw[i]) * 0.125f * __expf(bl[i]), kv = bf2f(kraw[i]) * __expf(-bl[i]);
        *(LAS unsigned short*)(lds + GL_Q + (t * GLD + lane) * 2) = f2bf(qv); *(LAS unsigned short*)(lds + GL_K + (t * GLD + lane) * 2) = f2bf(kv); }
    gla_store_vt(vraw, lds, tid);
#pragma unroll
    for (int q = 0; q < 2; ++q) { const int g = tid + q * 512, vv = g >> 3, k8 = (g & 7) * 8;
        const f32x4 a = sraw[q][0], c = sraw[q][1]; v4u o; o.x = pk2(a[0], a[1]); o.y = pk2(a[2], a[3]); o.z = pk2(c[0], c[1]); o.w = pk2(c[2], c[3]);
        *(LAS v4u*)(lds + GL_ST + (vv * GLD + k8) * 2) = o; }
    lds_barrier();
    if (wave < 4) { const int tb = wave >> 1, sb = wave & 1; f32x16 acc = {};
        if (sb <= tb) {
#pragma unroll
            for (int ks = 0; ks < 4; ++ks) acc = __builtin_amdgcn_mfma_f32_32x32x16_bf16(lds_frag(lds, GL_Q, tb * 32 + r32, 16 * ks + 8 * hi), lds_frag(lds, GL_K, sb * 32 + r32, 16 * ks + 8 * hi), acc, 0, 0, 0);
        }
        const int s = sb * 32 + r32;
#pragma unroll
        for (int r = 0; r < 16; ++r) { const int t = tb * 32 + crow(r, hi); const float v = (s <= t) ? acc[r] : 0.f; *(LAS unsigned short*)(lds + GL_AT + (t * GLD + s) * 2) = f2bf(v); } }
    lds_barrier();
    { const int tb = wave >> 2, vb = wave & 3; f32x16 acc = {};
#pragma unroll
      for (int ks = 0; ks < 4; ++ks) acc = __builtin_amdgcn_mfma_f32_32x32x16_bf16(lds_frag(lds, GL_Q, tb * 32 + r32, 16 * ks + 8 * hi), lds_frag(lds, GL_ST, vb * 32 + r32, 16 * ks + 8 * hi), acc, 0, 0, 0);
#pragma unroll
      for (int ks = 0; ks < 4; ++ks) acc = __builtin_amdgcn_mfma_f32_32x32x16_bf16(lds_frag(lds, GL_AT, tb * 32 + r32, 16 * ks + 8 * hi), lds_frag(lds, GL_VT, vb * 32 + r32, 16 * ks + 8 * hi), acc, 0, 0, 0);
      LAS float* O = (LAS float*)(lds + GL_O);
#pragma unroll
      for (int r = 0; r < 16; ++r) O[(tb * 32 + crow(r, hi)) * 132 + vb * 32 + r32] = acc[r]; }
    lds_barrier();
    { const LAS float* O = (const LAS float*)(lds + GL_O); const f32x2 g = *(const f32x2*)(ng + 2 * lane);
#pragma unroll
      for (int i = 0; i < 8; ++i) { const int t = wave * 8 + i; const f32x2 o = *(const LAS f32x2*)(O + t * 132 + 2 * lane);
          const float rstd = __builtin_amdgcn_rsqf(wave_sum(o[0] * o[0] + o[1] * o[1]) * (1.f / 128.f) + EPSF);
          const unsigned rw = rraw[i]; const float r0 = bflo(rw), r1 = bfhi(rw);
          const float y0 = o[0] * rstd * g[0] * (r0 * sigmoidf_(r0)), y1 = o[1] * rstd * g[1] * (r1 * sigmoidf_(r1));
          *(unsigned*)(Y + (size_t)(row0 + t) * D + 512 + h * 128 + 2 * lane) = pk2(y0, y1); } }
    lds_barrier();
}

__device__ __forceinline__ float pair_max(float m) { auto rr = __builtin_amdgcn_permlane32_swap(__float_as_uint(m), __float_as_uint(m), false, false); return fmaxf(__uint_as_float(rr[0]), __uint_as_float(rr[1])); }
constexpr int TK_PITCH = 272;
__device__ __forceinline__ void top16_of_scores(const bfu* qp, const LAS unsigned char* kl, int hi, float (&top)[16]) {
    f32x16 acc[4] = {};
    bf16x8 bq[8];
#pragma unroll
    for (int ks = 0; ks < 8; ++ks) bq[ks] = *(const bf16x8*)(qp + 16 * ks);
#pragma unroll
    for (int ks = 0; ks < 8; ++ks) { bf16x8 ak[4];
#pragma unroll
        for (int kb = 0; kb < 4; ++kb) ak[kb] = *(const LAS bf16x8*)(kl + kb * 32 * TK_PITCH + 32 * ks);
#pragma unroll
        for (int kb = 0; kb < 4; ++kb) acc[kb] = __builtin_amdgcn_mfma_f32_32x32x16_bf16(ak[kb], bq[ks], acc[kb], 0, 0, 0);
        if (ks & 1) asm volatile("" ::: "memory"); }
    float val[64];
#pragma unroll
    for (int kb = 0; kb < 4; ++kb)
#pragma unroll
        for (int r = 0; r < 16; ++r) { const unsigned idx = 32 * kb + crow(r, hi); val[kb * 16 + r] = __uint_as_float((__float_as_uint(acc[kb][r]) & ~127u) | idx); }
#define CE_D(a,b) do{ const float hi_=fmaxf(a,b), lo_=fminf(a,b); a=hi_; b=lo_; }while(0)
    {
        CE_D(val[0],val[1]);
        CE_D(val[3],val[2]);
        CE_D(val[4],val[5]);
        CE_D(val[7],val[6]);
        CE_D(val[8],val[9]);
        CE_D(val[11],val[10]);
        CE_D(val[12],val[13]);
        CE_D(val[15],val[14]);
        CE_D(val[0],val[2]);
        CE_D(val[1],val[3]);
        CE_D(val[6],val[4]);
        CE_D(val[7],val[5]);
        CE_D(val[8],val[10]);
        CE_D(val[9],val[11]);
        CE_D(val[14],val[12]);
        CE_D(val[15],val[13]);
        CE_D(val[0],val[1]);
        CE_D(val[2],val[3]);
        CE_D(val[5],val[4]);
        CE_D(val[7],val[6]);
        CE_D(val[8],val[9]);
        CE_D(val[10],val[11]);
        CE_D(val[13],val[12]);
        CE_D(val[15],val[14]);
        CE_D(val[0],val[4]);
        CE_D(val[1],val[5]);
        CE_D(val[2],val[6]);
        CE_D(val[3],val[7]);
        CE_D(val[12],val[8]);
        CE_D(val[13],val[9]);
        CE_D(val[14],val[10]);
        CE_D(val[15],val[11]);
        CE_D(val[0],val[2]);
        CE_D(val[1],val[3]);
        CE_D(val[4],val[6]);
        CE_D(val[5],val[7]);
        CE_D(val[10],val[8]);
        CE_D(val[11],val[9]);
        CE_D(val[14],val[12]);
        CE_D(val[15],val[13]);
        CE_D(val[0],val[1]);
        CE_D(val[2],val[3]);
        CE_D(val[4],val[5]);
        CE_D(val[6],val[7]);
        CE_D(val[9],val[8]);
        CE_D(val[11],val[10]);
        CE_D(val[13],val[12]);
        CE_D(val[15],val[14]);
        CE_D(val[0],val[8]);
        CE_D(val[1],val[9]);
        CE_D(val[2],val[10]);
        CE_D(val[3],val[11]);
        CE_D(val[4],val[12]);
        CE_D(val[5],val[13]);
        CE_D(val[6],val[14]);
        CE_D(val[7],val[15]);
        CE_D(val[0],val[4]);
        CE_D(val[1],val[5]);
        CE_D(val[2],val[6]);
        CE_D(val[3],val[7]);
        CE_D(val[8],val[12]);
        CE_D(val[9],val[13]);
        CE_D(val[10],val[14]);
        CE_D(val[11],val[15]);
        CE_D(val[0],val[2]);
        CE_D(val[1],val[3]);
        CE_D(val[4],val[6]);
        CE_D(val[5],val[7]);
        CE_D(val[8],val[10]);
        CE_D(val[9],val[11]);
        CE_D(val[12],val[14]);
        CE_D(val[13],val[15]);
        CE_D(val[0],val[1]);
        CE_D(val[2],val[3]);
        CE_D(val[4],val[5]);
        CE_D(val[6],val[7]);
        CE_D(val[8],val[9]);
        CE_D(val[10],val[11]);
        CE_D(val[12],val[13]);
        CE_D(val[14],val[15]);
        CE_D(val[16],val[17]);
        CE_D(val[19],val[18]);
        CE_D(val[20],val[21]);
        CE_D(val[23],val[22]);
        CE_D(val[24],val[25]);
        CE_D(val[27],val[26]);
        CE_D(val[28],val[29]);
        CE_D(val[31],val[30]);
        CE_D(val[16],val[18]);
        CE_D(val[17],val[19]);
        CE_D(val[22],val[20]);
        CE_D(val[23],val[21]);
        CE_D(val[24],val[26]);
        CE_D(val[25],val[27]);
        CE_D(val[30],val[28]);
        CE_D(val[31],val[29]);
        CE_D(val[16],val[17]);
        CE_D(val[18],val[19]);
        CE_D(val[21],val[20]);
        CE_D(val[23],val[22]);
        CE_D(val[24],val[25]);
        CE_D(val[26],val[27]);
        CE_D(val[29],val[28]);
        CE_D(val[31],val[30]);
        CE_D(val[16],val[20]);
        CE_D(val[17],val[21]);
        CE_D(val[18],val[22]);
        CE_D(val[19],val[23]);
        CE_D(val[28],val[24]);
        CE_D(val[29],val[25]);
        CE_D(val[30],val[26]);
        CE_D(val[31],val[27]);
        CE_D(val[16],val[18]);
        CE_D(val[17],val[19]);
        CE_D(val[20],val[22]);
        CE_D(val[21],val[23]);
        CE_D(val[26],val[24]);
        CE_D(val[27],val[25]);
        CE_D(val[30],val[28]);
        CE_D(val[31],val[29]);
        CE_D(val[16],val[17]);
        CE_D(val[18],val[19]);
        CE_D(val[20],val[21]);
        CE_D(val[22],val[23]);
        CE_D(val[25],val[24]);
        CE_D(val[27],val[26]);
        CE_D(val[29],val[28]);
        CE_D(val[31],val[30]);
        CE_D(val[16],val[24]);
        CE_D(val[17],val[25]);
        CE_D(val[18],val[26]);
        CE_D(val[19],val[27]);
        CE_D(val[20],val[28]);
        CE_D(val[21],val[29]);
        CE_D(val[22],val[30]);
        CE_D(val[23],val[31]);
        CE_D(val[16],val[20]);
        CE_D(val[17],val[21]);
        CE_D(val[18],val[22]);
        CE_D(val[19],val[23]);
        CE_D(val[24],val[28]);
        CE_D(val[25],val[29]);
        CE_D(val[26],val[30]);
        CE_D(val[27],val[31]);
        CE_D(val[16],val[18]);
        CE_D(val[17],val[19]);
        CE_D(val[20],val[22]);
        CE_D(val[21],val[23]);
        CE_D(val[24],val[26]);
        CE_D(val[25],val[27]);
        CE_D(val[28],val[30]);
        CE_D(val[29],val[31]);
        CE_D(val[16],val[17]);
        CE_D(val[18],val[19]);
        CE_D(val[20],val[21]);
        CE_D(val[22],val[23]);
        CE_D(val[24],val[25]);
        CE_D(val[26],val[27]);
        CE_D(val[28],val[29]);
        CE_D(val[30],val[31]);
        CE_D(val[32],val[33]);
        CE_D(val[35],val[34]);
        CE_D(val[36],val[37]);
        CE_D(val[39],val[38]);
        CE_D(val[40],val[41]);
        CE_D(val[43],val[42]);
        CE_D(val[44],val[45]);
        CE_D(val[47],val[46]);
        CE_D(val[32],val[34]);
        CE_D(val[33],val[35]);
        CE_D(val[38],val[36]);
        CE_D(val[39],val[37]);
        CE_D(val[40],val[42]);
        CE_D(val[41],val[43]);
        CE_D(val[46],val[44]);
        CE_D(val[47],val[45]);
        CE_D(val[32],val[33]);
        CE_D(val[34],val[35]);
        CE_D(val[37],val[36]);
        CE_D(val[39],val[38]);
        CE_D(val[40],val[41]);
        CE_D(val[42],val[43]);
        CE_D(val[45],val[44]);
        CE_D(val[47],val[46]);
        CE_D(val[32],val[36]);
        CE_D(val[33],val[37]);
        CE_D(val[34],val[38]);
        CE_D(val[35],val[39]);
        CE_D(val[44],val[40]);
        CE_D(val[45],val[41]);
        CE_D(val[46],val[42]);
        CE_D(val[47],val[43]);
        CE_D(val[32],val[34]);
        CE_D(val[33],val[35]);
        CE_D(val[36],val[38]);
        CE_D(val[37],val[39]);
        CE_D(val[42],val[40]);
        CE_D(val[43],val[41]);
        CE_D(val[46],val[44]);
        CE_D(val[47],val[45]);
        CE_D(val[32],val[33]);
        CE_D(val[34],val[35]);
        CE_D(val[36],val[37]);
        CE_D(val[38],val[39]);
        CE_D(val[41],val[40]);
        CE_D(val[43],val[42]);
        CE_D(val[45],val[44]);
        CE_D(val[47],val[46]);
        CE_D(val[32],val[40]);
        CE_D(val[33],val[41]);
        CE_D(val[34],val[42]);
        CE_D(val[35],val[43]);
        CE_D(val[36],val[44]);
        CE_D(val[37],val[45]);
        CE_D(val[38],val[46]);
        CE_D(val[39],val[47]);
        CE_D(val[32],val[36]);
        CE_D(val[33],val[37]);
        CE_D(val[34],val[38]);
        CE_D(val[35],val[39]);
        CE_D(val[40],val[44]);
        CE_D(val[41],val[45]);
        CE_D(val[42],val[46]);
        CE_D(val[43],val[47]);
        CE_D(val[32],val[34]);
        CE_D(val[33],val[35]);
        CE_D(val[36],val[38]);
        CE_D(val[37],val[39]);
        CE_D(val[40],val[42]);
        CE_D(val[41],val[43]);
        CE_D(val[44],val[46]);
        CE_D(val[45],val[47]);
        CE_D(val[32],val[33]);
        CE_D(val[34],val[35]);
        CE_D(val[36],val[37]);
        CE_D(val[38],val[39]);
        CE_D(val[40],val[41]);
        CE_D(val[42],val[43]);
        CE_D(val[44],val[45]);
        CE_D(val[46],val[47]);
        CE_D(val[48],val[49]);
        CE_D(val[51],val[50]);
        CE_D(val[52],val[53]);
        CE_D(val[55],val[54]);
        CE_D(val[56],val[57]);
        CE_D(val[59],val[58]);
        CE_D(val[60],val[61]);
        CE_D(val[63],val[62]);
        CE_D(val[48],val[50]);
        CE_D(val[49],val[51]);
        CE_D(val[54],val[52]);
        CE_D(val[55],val[53]);
        CE_D(val[56],val[58]);
        CE_D(val[57],val[59]);
        CE_D(val[62],val[60]);
        CE_D(val[63],val[61]);
        CE_D(val[48],val[49]);
        CE_D(val[50],val[51]);
        CE_D(val[53],val[52]);
        CE_D(val[55],val[54]);
        CE_D(val[56],val[57]);
        CE_D(val[58],val[59]);
        CE_D(val[61],val[60]);
        CE_D(val[63],val[62]);
        CE_D(val[48],val[52]);
        CE_D(val[49],val[53]);
        CE_D(val[50],val[54]);
        CE_D(val[51],val[55]);
        CE_D(val[60],val[56]);
        CE_D(val[61],val[57]);
        CE_D(val[62],val[58]);
        CE_D(val[63],val[59]);
        CE_D(val[48],val[50]);
        CE_D(val[49],val[51]);
        CE_D(val[52],val[54]);
        CE_D(val[53],val[55]);
        CE_D(val[58],val[56]);
        CE_D(val[59],val[57]);
        CE_D(val[62],val[60]);
        CE_D(val[63],val[61]);
        CE_D(val[48],val[49]);
        CE_D(val[50],val[51]);
        CE_D(val[52],val[53]);
        CE_D(val[54],val[55]);
        CE_D(val[57],val[56]);
        CE_D(val[59],val[58]);
        CE_D(val[61],val[60]);
        CE_D(val[63],val[62]);
        CE_D(val[48],val[56]);
        CE_D(val[49],val[57]);
        CE_D(val[50],val[58]);
        CE_D(val[51],val[59]);
        CE_D(val[52],val[60]);
        CE_D(val[53],val[61]);
        CE_D(val[54],val[62]);
        CE_D(val[55],val[63]);
        CE_D(val[48],val[52]);
        CE_D(val[49],val[53]);
        CE_D(val[50],val[54]);
        CE_D(val[51],val[55]);
        CE_D(val[56],val[60]);
        CE_D(val[57],val[61]);
        CE_D(val[58],val[62]);
        CE_D(val[59],val[63]);
        CE_D(val[48],val[50]);
        CE_D(val[49],val[51]);
        CE_D(val[52],val[54]);
        CE_D(val[53],val[55]);
        CE_D(val[56],val[58]);
        CE_D(val[57],val[59]);
        CE_D(val[60],val[62]);
        CE_D(val[61],val[63]);
        CE_D(val[48],val[49]);
        CE_D(val[50],val[51]);
        CE_D(val[52],val[53]);
        CE_D(val[54],val[55]);
        CE_D(val[56],val[57]);
        CE_D(val[58],val[59]);
        CE_D(val[60],val[61]);
        CE_D(val[62],val[63]);
        val[0]=fmaxf(val[0],val[31]);
        val[1]=fmaxf(val[1],val[30]);
        val[2]=fmaxf(val[2],val[29]);
        val[3]=fmaxf(val[3],val[28]);
        val[4]=fmaxf(val[4],val[27]);
        val[5]=fmaxf(val[5],val[26]);
        val[6]=fmaxf(val[6],val[25]);
        val[7]=fmaxf(val[7],val[24]);
        val[8]=fmaxf(val[8],val[23]);
        val[9]=fmaxf(val[9],val[22]);
        val[10]=fmaxf(val[10],val[21]);
        val[11]=fmaxf(val[11],val[20]);
        val[12]=fmaxf(val[12],val[19]);
        val[13]=fmaxf(val[13],val[18]);
        val[14]=fmaxf(val[14],val[17]);
        val[15]=fmaxf(val[15],val[16]);
        CE_D(val[0],val[8]);
        CE_D(val[1],val[9]);
        CE_D(val[2],val[10]);
        CE_D(val[3],val[11]);
        CE_D(val[4],val[12]);
        CE_D(val[5],val[13]);
        CE_D(val[6],val[14]);
        CE_D(val[7],val[15]);
        CE_D(val[0],val[4]);
        CE_D(val[1],val[5]);
        CE_D(val[2],val[6]);
        CE_D(val[3],val[7]);
        CE_D(val[8],val[12]);
        CE_D(val[9],val[13]);
        CE_D(val[10],val[14]);
        CE_D(val[11],val[15]);
        CE_D(val[0],val[2]);
        CE_D(val[1],val[3]);
        CE_D(val[4],val[6]);
        CE_D(val[5],val[7]);
        CE_D(val[8],val[10]);
        CE_D(val[9],val[11]);
        CE_D(val[12],val[14]);
        CE_D(val[13],val[15]);
        CE_D(val[0],val[1]);
        CE_D(val[2],val[3]);
        CE_D(val[4],val[5]);
        CE_D(val[6],val[7]);
        CE_D(val[8],val[9]);
        CE_D(val[10],val[11]);
        CE_D(val[12],val[13]);
        CE_D(val[14],val[15]);
        val[32]=fmaxf(val[32],val[63]);
        val[33]=fmaxf(val[33],val[62]);
        val[34]=fmaxf(val[34],val[61]);
        val[35]=fmaxf(val[35],val[60]);
        val[36]=fmaxf(val[36],val[59]);
        val[37]=fmaxf(val[37],val[58]);
        val[38]=fmaxf(val[38],val[57]);
        val[39]=fmaxf(val[39],val[56]);
        val[40]=fmaxf(val[40],val[55]);
        val[41]=fmaxf(val[41],val[54]);
        val[42]=fmaxf(val[42],val[53]);
        val[43]=fmaxf(val[43],val[52]);
        val[44]=fmaxf(val[44],val[51]);
        val[45]=fmaxf(val[45],val[50]);
        val[46]=fmaxf(val[46],val[49]);
        val[47]=fmaxf(val[47],val[48]);
        CE_D(val[32],val[40]);
        CE_D(val[33],val[41]);
        CE_D(val[34],val[42]);
        CE_D(val[35],val[43]);
        CE_D(val[36],val[44]);
        CE_D(val[37],val[45]);
        CE_D(val[38],val[46]);
        CE_D(val[39],val[47]);
        CE_D(val[32],val[36]);
        CE_D(val[33],val[37]);
        CE_D(val[34],val[38]);
        CE_D(val[35],val[39]);
        CE_D(val[40],val[44]);
        CE_D(val[41],val[45]);
        CE_D(val[42],val[46]);
        CE_D(val[43],val[47]);
        CE_D(val[32],val[34]);
        CE_D(val[33],val[35]);
        CE_D(val[36],val[38]);
        CE_D(val[37],val[39]);
        CE_D(val[40],val[42]);
        CE_D(val[41],val[43]);
        CE_D(val[44],val[46]);
        CE_D(val[45],val[47]);
        CE_D(val[32],val[33]);
        CE_D(val[34],val[35]);
        CE_D(val[36],val[37]);
        CE_D(val[38],val[39]);
        CE_D(val[40],val[41]);
        CE_D(val[42],val[43]);
        CE_D(val[44],val[45]);
        CE_D(val[46],val[47]);
        val[0]=fmaxf(val[0],val[47]);
        val[1]=fmaxf(val[1],val[46]);
        val[2]=fmaxf(val[2],val[45]);
        val[3]=fmaxf(val[3],val[44]);
        val[4]=fmaxf(val[4],val[43]);
        val[5]=fmaxf(val[5],val[42]);
        val[6]=fmaxf(val[6],val[41]);
        val[7]=fmaxf(val[7],val[40]);
        val[8]=fmaxf(val[8],val[39]);
        val[9]=fmaxf(val[9],val[38]);
        val[10]=fmaxf(val[10],val[37]);
        val[11]=fmaxf(val[11],val[36]);
        val[12]=fmaxf(val[12],val[35]);
        val[13]=fmaxf(val[13],val[34]);
        val[14]=fmaxf(val[14],val[33]);
        val[15]=fmaxf(val[15],val[32]);
        CE_D(val[0],val[8]);
        CE_D(val[1],val[9]);
        CE_D(val[2],val[10]);
        CE_D(val[3],val[11]);
        CE_D(val[4],val[12]);
        CE_D(val[5],val[13]);
        CE_D(val[6],val[14]);
        CE_D(val[7],val[15]);
        CE_D(val[0],val[4]);
        CE_D(val[1],val[5]);
        CE_D(val[2],val[6]);
        CE_D(val[3],val[7]);
        CE_D(val[8],val[12]);
        CE_D(val[9],val[13]);
        CE_D(val[10],val[14]);
        CE_D(val[11],val[15]);
        CE_D(val[0],val[2]);
        CE_D(val[1],val[3]);
        CE_D(val[4],val[6]);
        CE_D(val[5],val[7]);
        CE_D(val[8],val[10]);
        CE_D(val[9],val[11]);
        CE_D(val[12],val[14]);
        CE_D(val[13],val[15]);
        CE_D(val[0],val[1]);
        CE_D(val[2],val[3]);
        CE_D(val[4],val[5]);
        CE_D(val[6],val[7]);
        CE_D(val[8],val[9]);
        CE_D(val[10],val[11]);
        CE_D(val[12],val[13]);
        CE_D(val[14],val[15]);
        { auto r_=__builtin_amdgcn_permlane32_swap(__float_as_uint(val[15]),__float_as_uint(val[15]),false,false); const float p_=__uint_as_float(hi?r_[0]:r_[1]); top[0]=fmaxf(val[0],p_); }
        { auto r_=__builtin_amdgcn_permlane32_swap(__float_as_uint(val[14]),__float_as_uint(val[14]),false,false); const float p_=__uint_as_float(hi?r_[0]:r_[1]); top[1]=fmaxf(val[1],p_); }
        { auto r_=__builtin_amdgcn_permlane32_swap(__float_as_uint(val[13]),__float_as_uint(val[13]),false,false); const float p_=__uint_as_float(hi?r_[0]:r_[1]); top[2]=fmaxf(val[2],p_); }
        { auto r_=__builtin_amdgcn_permlane32_swap(__float_as_uint(val[12]),__float_as_uint(val[12]),false,false); const float p_=__uint_as_float(hi?r_[0]:r_[1]); top[3]=fmaxf(val[3],p_); }
        { auto r_=__builtin_amdgcn_permlane32_swap(__float_as_uint(val[11]),__float_as_uint(val[11]),false,false); const float p_=__uint_as_float(hi?r_[0]:r_[1]); top[4]=fmaxf(val[4],p_); }
        { auto r_=__builtin_amdgcn_permlane32_swap(__float_as_uint(val[10]),__float_as_uint(val[10]),false,false); const float p_=__uint_as_float(hi?r_[0]:r_[1]); top[5]=fmaxf(val[5],p_); }
        { auto r_=__builtin_amdgcn_permlane32_swap(__float_as_uint(val[9]),__float_as_uint(val[9]),false,false); const float p_=__uint_as_float(hi?r_[0]:r_[1]); top[6]=fmaxf(val[6],p_); }
        { auto r_=__builtin_amdgcn_permlane32_swap(__float_as_uint(val[8]),__float_as_uint(val[8]),false,false); const float p_=__uint_as_float(hi?r_[0]:r_[1]); top[7]=fmaxf(val[7],p_); }
        { auto r_=__builtin_amdgcn_permlane32_swap(__float_as_uint(val[7]),__float_as_uint(val[7]),false,false); const float p_=__uint_as_float(hi?r_[0]:r_[1]); top[8]=fmaxf(val[8],p_); }
        { auto r_=__builtin_amdgcn_permlane32_swap(__float_as_uint(val[6]),__float_as_uint(val[6]),false,false); const float p_=__uint_as_float(hi?r_[0]:r_[1]); top[9]=fmaxf(val[9],p_); }
        { auto r_=__builtin_amdgcn_permlane32_swap(__float_as_uint(val[5]),__float_as_uint(val[5]),false,false); const float p_=__uint_as_float(hi?r_[0]:r_[1]); top[10]=fmaxf(val[10],p_); }
        { auto r_=__builtin_amdgcn_permlane32_swap(__float_as_uint(val[4]),__float_as_uint(val[4]),false,false); const float p_=__uint_as_float(hi?r_[0]:r_[1]); top[11]=fmaxf(val[11],p_); }
        { auto r_=__builtin_amdgcn_permlane32_swap(__float_as_uint(val[3]),__float_as_uint(val[3]),false,false); const float p_=__uint_as_float(hi?r_[0]:r_[1]); top[12]=fmaxf(val[12],p_); }
        { auto r_=__builtin_amdgcn_permlane32_swap(__float_as_uint(val[2]),__float_as_uint(val[2]),false,false); const float p_=__uint_as_float(hi?r_[0]:r_[1]); top[13]=fmaxf(val[13],p_); }
        { auto r_=__builtin_amdgcn_permlane32_swap(__float_as_uint(val[1]),__float_as_uint(val[1]),false,false); const float p_=__uint_as_float(hi?r_[0]:r_[1]); top[14]=fmaxf(val[14],p_); }
        { auto r_=__builtin_amdgcn_permlane32_swap(__float_as_uint(val[0]),__float_as_uint(val[0]),false,false); const float p_=__uint_as_float(hi?r_[0]:r_[1]); top[15]=fmaxf(val[15],p_); }
        CE_D(top[0],top[8]);
        CE_D(top[1],top[9]);
        CE_D(top[2],top[10]);
        CE_D(top[3],top[11]);
        CE_D(top[4],top[12]);
        CE_D(top[5],top[13]);
        CE_D(top[6],top[14]);
        CE_D(top[7],top[15]);
        CE_D(top[0],top[4]);
        CE_D(top[1],top[5]);
        CE_D(top[2],top[6]);
        CE_D(top[3],top[7]);
        CE_D(top[8],top[12]);
        CE_D(top[9],top[13]);
        CE_D(top[10],top[14]);
        CE_D(top[11],top[15]);
        CE_D(top[0],top[2]);
        CE_D(top[1],top[3]);
        CE_D(top[4],top[6]);
        CE_D(top[5],top[7]);
        CE_D(top[8],top[10]);
        CE_D(top[9],top[11]);
        CE_D(top[12],top[14]);
        CE_D(top[13],top[15]);
        CE_D(top[0],top[1]);
        CE_D(top[2],top[3]);
        CE_D(top[4],top[5]);
        CE_D(top[6],top[7]);
        CE_D(top[8],top[9]);
        CE_D(top[10],top[11]);
        CE_D(top[12],top[13]);
        CE_D(top[14],top[15]);
    }
#undef CE_D
}
__device__ __forceinline__ void peer_topk(const bfu* PQ, const bfu* KEYS, unsigned short* EXP, float* GATE, LAS unsigned char* lds, int G) {
    const int tid = tid_fresh(), lane = tid & 63, wave = tid >> 6, r32 = lane & 31, hi = lane >> 5; const int bid = bid_fresh(), h = bid & 7, g = bid >> 3, NG = G >> 3;
    { const bfu* src = KEYS + (size_t)h * 32768;
#pragma unroll
      for (int q = 0; q < 8; ++q) { const int c = tid + q * 512, row = c >> 4, piece = c & 15; *(LAS v4u*)(lds + row * TK_PITCH + piece * 16) = *(const v4u*)(src + (size_t)c * 8); } }
    __syncthreads();
    const LAS unsigned char* kl0 = lds + r32 * TK_PITCH + 16 * hi;
    for (int tile = g + NG * wave; tile < M / 32; tile += NG * NWV) { const int tok = tile * 32 + r32;
        float v1[16], v2[16];
        top16_of_scores(PQ + (size_t)tok * 2048 + h * 256 + 8 * hi, kl0, hi, v1);
        top16_of_scores(PQ + (size_t)tok * 2048 + h * 256 + 128 + 8 * hi, kl0 + 128 * TK_PITCH, hi, v2);
        float cand[25]; unsigned pay[25];
#define CAND(c, a0, b0, a1, b1) do { const float s_ = hi ? (v1[a1] + v2[b1]) : (v1[a0] + v2[b0]); const unsigned code_ = hi ? (unsigned)((a1) * 16 + (b1)) : (unsigned)((a0) * 16 + (b0)); \
        cand[c] = __uint_as_float((__float_as_uint(s_) & ~255u) | code_); \
        pay[c] = hi ? (((__float_as_uint(v1[a1]) & 127u) << 7) | (__float_as_uint(v2[b1]) & 127u)) : (((__float_as_uint(v1[a0]) & 127u) << 7) | (__float_as_uint(v2[b0]) & 127u)); } while (0)
    CAND(0, 0, 0, 0, 1);
    CAND(1, 0, 2, 0, 3);
    CAND(2, 0, 4, 0, 5);
    CAND(3, 0, 6, 0, 7);
    CAND(4, 0, 8, 0, 9);
    CAND(5, 0, 10, 0, 11);
    CAND(6, 0, 12, 0, 13);
    CAND(7, 0, 14, 0, 15);
    CAND(8, 1, 0, 1, 1);
    CAND(9, 1, 2, 1, 3);
    CAND(10, 1, 4, 1, 5);
    CAND(11, 1, 6, 1, 7);
    CAND(12, 2, 0, 2, 1);
    CAND(13, 2, 2, 2, 3);
    CAND(14, 2, 4, 3, 0);
    CAND(15, 3, 1, 3, 2);
    CAND(16, 3, 3, 4, 0);
    CAND(17, 4, 1, 4, 2);
    CAND(18, 5, 0, 5, 1);
    CAND(19, 6, 0, 6, 1);
    CAND(20, 7, 0, 7, 1);
    CAND(21, 8, 0, 9, 0);
    CAND(22, 10, 0, 11, 0);
    CAND(23, 12, 0, 13, 0);
    CAND(24, 14, 0, 15, 0);
#undef CAND
        float sc[16]; unsigned ex[16];
#pragma unroll
        for (int i = 0; i < 16; ++i) { float m = cand[0];
#pragma unroll
            for (int j = 1; j < 25; ++j) m = fmaxf(m, cand[j]);
            m = pair_max(m); unsigned pl = 0u;
#pragma unroll
            for (int j = 0; j < 25; ++j) { const bool eq = (cand[j] == m); pl = eq ? pay[j] : pl; cand[j] = eq ? -INFINITY : cand[j]; }
            { auto rr = __builtin_amdgcn_permlane32_swap(pl, pl, false, false); pl = rr[0] | rr[1]; }
            sc[i] = m; ex[i] = pl; }
        float z = 0.f; const float scmax = sc[0];
#pragma unroll
        for (int i = 0; i < 16; ++i) { sc[i] = __expf(sc[i] - scmax); z += sc[i]; }
        const float rz = 1.0f / z;
        if (hi == 0) { v4u o0, o1; o0.x = ex[0] | (ex[1] << 16); o0.y = ex[2] | (ex[3] << 16); o0.z = ex[4] | (ex[5] << 16); o0.w = ex[6] | (ex[7] << 16);
            o1.x = ex[8] | (ex[9] << 16); o1.y = ex[10] | (ex[11] << 16); o1.z = ex[12] | (ex[13] << 16); o1.w = ex[14] | (ex[15] << 16);
            v4u* d = (v4u*)(EXP + (size_t)tok * 128 + h * 16); d[0] = o0; d[1] = o1; }
        else { f32x4* d = (f32x4*)(GATE + (size_t)tok * 128 + h * 16);
#pragma unroll
            for (int q = 0; q < 4; ++q) d[q] = (f32x4){sc[4 * q] * rz, sc[4 * q + 1] * rz, sc[4 * q + 2] * rz, sc[4 * q + 3] * rz}; } }
}
#ifndef DBG_CUMSUM_REP
#define DBG_CUMSUM_REP 1
#endif
#ifndef DBG_GATHER_REP
#define DBG_GATHER_REP 1
#endif
__device__ __forceinline__ float gelu_erf(float x) { return 0.5f * x * (1.0f + erff(x * 0.70710678118654752f)); }
__device__ __forceinline__ float row16_sum(float v) {
    v += __builtin_bit_cast(float, __builtin_amdgcn_update_dpp(0, __builtin_bit_cast(int, v), 0x128, 0xf, 0xf, false));
    v += __builtin_bit_cast(float, __builtin_amdgcn_update_dpp(0, __builtin_bit_cast(int, v), 0x124, 0xf, 0xf, false));
    v += __builtin_bit_cast(float, __builtin_amdgcn_update_dpp(0, __builtin_bit_cast(int, v), 0x122, 0xf, 0xf, false));
    v += __builtin_bit_cast(float, __builtin_amdgcn_update_dpp(0, __builtin_bit_cast(int, v), 0x121, 0xf, 0xf, false));
    return v;
}
__device__ __forceinline__ float ub0(unsigned w) { return (float)(w & 0xffu); }
__device__ __forceinline__ float ub1(unsigned w) { return (float)((w >> 8) & 0xffu); }
__device__ __forceinline__ float ub2(unsigned w) { return (float)((w >> 16) & 0xffu); }
__device__ __forceinline__ float ub3(unsigned w) { return (float)(w >> 24); }
__device__ __forceinline__ float gelu_poly(float v) {
    const float av = fabsf(v), t = __builtin_amdgcn_rcpf(av * 0.2316418882f + 1.0f);
    float q = t * 0.5307027145f + (-0.7265760135f); q = q * t + 0.7107068705f; q = q * t + (-0.142248368f); q = q * t + 0.127414796f; q = q * t;
    const float m = v * (q * __builtin_amdgcn_exp2f(v * v * (-0.72134752044f)));
    return v < 0.f ? m : v - m;
}
__device__ __forceinline__ void peer_hq(const float* XF, const float* SSP, const float* gain, unsigned* HQ, float* SH, int G) {
    const int tid = tid_fresh(), lane = tid & 63, wave = tid >> 6; const int gw = bid_fresh() * NWV + wave, NGW = G * NWV;
    const f32x4 g0 = *(const f32x4*)(gain + 16 * lane), g1 = *(const f32x4*)(gain + 16 * lane + 4), g2 = *(const f32x4*)(gain + 16 * lane + 8), g3 = *(const f32x4*)(gain + 16 * lane + 12);
    for (int tok = gw; tok < M; tok += NGW) {
        const float rstd = row_rstd16(SSP, tok); const float* xr = XF + (size_t)tok * D + 16 * lane;
        const f32x4 a[4] = {*(const f32x4*)xr * rstd * g0, *(const f32x4*)(xr + 4) * rstd * g1, *(const f32x4*)(xr + 8) * rstd * g2, *(const f32x4*)(xr + 12) * rstd * g3};
        float mx = 0.f;
#pragma unroll
        for (int q = 0; q < 4; ++q) mx = fmaxf(mx, fmaxf(fmaxf(fabsf(a[q][0]), fabsf(a[q][1])), fmaxf(fabsf(a[q][2]), fabsf(a[q][3]))));
#pragma unroll
        for (int o = 1; o < 64; o <<= 1) mx = fmaxf(mx, __shfl_xor(mx, o));
        const float sh = (mx > 0.f) ? mx * (1.0f / 127.0f) : 1.0f, inv = 1.0f / sh;
        v4u oh, ol;
#pragma unroll
        for (int k = 0; k < 4; ++k) { unsigned wh = 0, wl = 0;
#pragma unroll
            for (int b = 0; b < 4; ++b) { const float t = a[k][b] * inv; const float qh = __builtin_rintf(t); const int ql = (int)__builtin_rintf((t - qh) * 128.0f);
                wh |= ((unsigned)(int)qh & 0xffu) << (8 * b); wl |= ((unsigned)ql & 0xffu) << (8 * b); }
            oh[k] = wh; ol[k] = wl; }
        unsigned* dst = HQ + (size_t)tok * 512 + lane * 4;
        *(v4u*)dst = oh;
        if (lane == 0) SH[tok] = sh;
    }
}
struct URow { v4u hh[4]; float sh, ga, gb; int ea, eb; };
__device__ __forceinline__ void urow_prefetch(URow& n, const unsigned* HQ, const float* SH, const unsigned short* EXP, const float* GATE, int tok, int j, int lane) {
    const unsigned* hq = HQ + (size_t)tok * 512 + j * 4;
#pragma unroll
    for (int q = 0; q < 4; ++q) n.hh[q] = *(const v4u*)(hq + 64 * q);
    n.sh = SH[tok]; n.ea = EXP[(size_t)tok * 128 + lane]; n.eb = EXP[(size_t)tok * 128 + 64 + lane]; n.ga = GATE[(size_t)tok * 128 + lane]; n.gb = GATE[(size_t)tok * 128 + 64 + lane];
}
__device__ __forceinline__ float urow_dot(const v4u (&w)[4], const v4u (&hh)[4]) {
    int dh = 0;
#pragma unroll
    for (int c = 0; c < 4; ++c)
#pragma unroll
        for (int k = 0; k < 4; ++k) dh = __builtin_amdgcn_sdot4((int)w[c][k], (int)hh[c][k], dh, false);
    return row16_sum((float)dh);
}
__device__ __forceinline__ void peer_u_rows(const unsigned* HQ, const float* SH, const unsigned char* U8, const float* USC, const float* VSC, const unsigned short* EXP, const float* GATE_WGT, float* WOUT,
                                            LAS unsigned char* lds, int G, int x, int sub) {
    const int tid = tid_fresh(), lane = tid & 63, wave = tid >> 6, j = lane & 15, g16 = lane >> 4;
    const int w8 = sub * NWV + wave, NW8 = (G >> 3) * NWV;
    LAS int* lst = (LAS int*)(lds + wave * 2048); LAS float* dbuf = (LAS float*)(lds + wave * 2048 + 512);
    const unsigned uoff0 = 16u * (unsigned)j;
    LAS float* usl = (LAS float*)(lds + 16384); LAS float* vsl = usl + 2048;
    { const int i4 = tid * 4; *(LAS f32x4*)(usl + i4) = *(const f32x4*)(USC + x * 2048 + i4); *(LAS f32x4*)(vsl + i4) = *(const f32x4*)(VSC + x * 2048 + i4); }
    __syncthreads();
    URow cur; if (w8 < M) urow_prefetch(cur, HQ, SH, EXP, GATE_WGT, w8, j, lane);
    for (int tok = w8; tok < M; tok += NW8) {
        v4u hh[4];
#pragma unroll
        for (int q = 0; q < 4; ++q) hh[q] = cur.hh[q];
        const float sh = cur.sh, ga = cur.ga, gb = cur.gb; const int ea = cur.ea, eb = cur.eb;
        const bool ina = (ea >> 11) == x, inb = (eb >> 11) == x;
        const unsigned long long ma = __ballot(ina), mb = __ballot(inb);
        const int na = __popcll(ma), n = na + __popcll(mb);
        const int pa = __builtin_amdgcn_mbcnt_hi((unsigned)(ma >> 32), __builtin_amdgcn_mbcnt_lo((unsigned)ma, 0u)), pb = na + __builtin_amdgcn_mbcnt_hi((unsigned)(mb >> 32), __builtin_amdgcn_mbcnt_lo((unsigned)mb, 0u));
        if (ina) lst[pa] = (ea << 8) | lane;
        if (inb) lst[pb] = (eb << 8) | (64 + lane);
        float usa = 0.f, vsa = 0.f, usb = 0.f, vsb = 0.f;
        if (ina) { usa = usl[ea & 2047]; vsa = vsl[ea & 2047]; }
        if (inb) { usb = usl[eb & 2047]; vsb = vsl[eb & 2047]; }
        LDS_WAIT();
        v4u w[6][4]; int ent[6];
#pragma unroll
        for (int it = 0; it < 6; ++it) { ent[it] = -1;
            if (4 * it < n) { const int idx = 4 * it + g16; if (idx < n) { ent[it] = lst[idx]; const unsigned char* rp = U8 + (uoff0 + (unsigned)(ent[it] >> 8) * 1024u);
#pragma unroll
                for (int c = 0; c < 4; ++c) w[it][c] = *(const v4u*)(rp + 256 * c); } } }
        if (tok + NW8 < M) urow_prefetch(cur, HQ, SH, EXP, GATE_WGT, tok + NW8, j, lane);
#pragma unroll
        for (int it = 0; it < 6; ++it) if (4 * it < n) { const float d = urow_dot(w[it], hh); if (j == 0 && ent[it] >= 0) dbuf[ent[it] & 255] = d; }
        for (int it = 6; 4 * it < n; ++it) { const int idx = 4 * it + g16; int e1 = -1; v4u w1[4] = {};
            if (idx < n) { e1 = lst[idx]; const unsigned char* rp = U8 + (uoff0 + (unsigned)(e1 >> 8) * 1024u);
#pragma unroll
                for (int c = 0; c < 4; ++c) w1[c] = *(const v4u*)(rp + 256 * c); }
            const float d = urow_dot(w1, hh); if (j == 0 && e1 >= 0) dbuf[e1 & 255] = d; }
        LDS_WAIT();
        if (ina) WOUT[(size_t)tok * 128 + lane] = ga * gelu_poly(dbuf[lane] * (sh * usa)) * vsa;
        if (inb) WOUT[(size_t)tok * 128 + 64 + lane] = gb * gelu_poly(dbuf[64 + lane] * (sh * usb)) * vsb;
        LDS_WAIT();
    }
}
__device__ __forceinline__ float sum_groups8(float v) {
    v += __builtin_bit_cast(float, __builtin_amdgcn_update_dpp(0, __builtin_bit_cast(int, v), 0x128, 0xf, 0xf, false));
    { auto r = __builtin_amdgcn_permlane16_swap(__float_as_uint(v), __float_as_uint(v), false, false); v = __uint_as_float(r[0]) + __uint_as_float(r[1]); }
    { auto r = __builtin_amdgcn_permlane32_swap(__float_as_uint(v), __float_as_uint(v), false, false); v = __uint_as_float(r[0]) + __uint_as_float(r[1]); }
    return v;
}
struct VPre { float wa, wb; int ea, eb; };
__device__ __forceinline__ void v_prefetch(VPre& n, const float* WGT, const unsigned short* EXP, int tok, int lane) {
    n.wa = WGT[(size_t)tok * 128 + lane]; n.wb = WGT[(size_t)tok * 128 + 64 + lane]; n.ea = EXP[(size_t)tok * 128 + lane]; n.eb = EXP[(size_t)tok * 128 + 64 + lane];
}
__device__ __forceinline__ void peer_v_slice(const float* XF, float* XO, const float* WGT, const unsigned char* V8T, const unsigned short* EXP,
                                             bfu* XB, float* SSP, LAS unsigned char* lds, int G, int x, int sub, bool last) {
    const int tid = tid_fresh(), lane = tid & 63, wave = tid >> 6, j8 = lane & 7, g8 = lane >> 3;
    const int w8 = sub * NWV + wave, NW8 = (G >> 3) * NWV;
    const unsigned voff0 = (unsigned)x * (16384u * 128u) + 16u * (unsigned)j8;
    const int wqa = (lane >> 5) * 32 + (lane & 7) * 4 + ((lane >> 3) & 3);
    const int coff = 128 * x + 16 * j8 + ((lane >> 5) & 1) * 8 + ((lane >> 4) & 1) * 4;
    VPre cur[2];
#pragma unroll
    for (int h = 0; h < 2; ++h) if (w8 + h * NW8 < M) v_prefetch(cur[h], WGT, EXP, w8 + h * NW8, lane);
    for (int tok0 = w8; tok0 < M; tok0 += 2 * NW8) {
        float sw[2]; v4u rows[2][16]; int wq[2][4]; f32x4 xin[2]; bool live[2];
#pragma unroll
        for (int h = 0; h < 2; ++h) { live[h] = (tok0 + h * NW8 < M);
            LAS int* ebuf = (LAS int*)(lds + wave * 2048 + h * 1024); LAS char* wq8 = (LAS char*)(lds + wave * 2048 + h * 1024 + 512);
            float wmax = fmaxf(fabsf(cur[h].wa), fabsf(cur[h].wb));
#pragma unroll
            for (int o = 1; o < 64; o <<= 1) wmax = fmaxf(wmax, __shfl_xor(wmax, o));
            sw[h] = (wmax > 0.f) ? wmax * (1.0f / 127.0f) : 1.0f; const float inv = 1.0f / sw[h];
            ebuf[lane] = cur[h].ea; ebuf[64 + lane] = cur[h].eb;
            wq8[wqa] = (char)(int)__builtin_rintf(cur[h].wa * inv); wq8[64 + wqa] = (char)(int)__builtin_rintf(cur[h].wb * inv); }
        LDS_WAIT();
#pragma unroll
        for (int h = 0; h < 2; ++h) if (live[h]) { const int tok = tok0 + h * NW8;
            LAS int* ebuf = (LAS int*)(lds + wave * 2048 + h * 1024); LAS char* wq8 = (LAS char*)(lds + wave * 2048 + h * 1024 + 512);
#pragma unroll
            for (int it = 0; it < 16; ++it) rows[h][it] = *(const v4u*)(V8T + (voff0 + (unsigned)ebuf[8 * it + g8] * 128u));
#pragma unroll
            for (int q = 0; q < 4; ++q) wq[h][q] = *(const LAS int*)(wq8 + q * 32 + g8 * 4);
            xin[h] = *(const f32x4*)(XF + (size_t)tok * D + coff); }
#pragma unroll
        for (int h = 0; h < 2; ++h) if (tok0 + (2 + h) * NW8 < M) v_prefetch(cur[h], WGT, EXP, tok0 + (2 + h) * NW8, lane);
#pragma unroll
        for (int h = 0; h < 2; ++h) if (live[h]) { const int tok = tok0 + h * NW8;
            int acc[16];
#pragma unroll
            for (int i = 0; i < 16; ++i) acc[i] = 0;
#pragma unroll
            for (int q = 0; q < 4; ++q)
#pragma unroll
                for (int k = 0; k < 4; ++k) { const unsigned A = rows[h][4 * q][k], B = rows[h][4 * q + 1][k], C = rows[h][4 * q + 2][k], Dd = rows[h][4 * q + 3][k];
                    const unsigned p0 = __builtin_amdgcn_perm(A, B, 0x01050004u), p1 = __builtin_amdgcn_perm(A, B, 0x03070206u), q0 = __builtin_amdgcn_perm(C, Dd, 0x01050004u), q1 = __builtin_amdgcn_perm(C, Dd, 0x03070206u);
                    const unsigned t0 = __builtin_amdgcn_perm(p0, q0, 0x01000504u), t1 = __builtin_amdgcn_perm(p0, q0, 0x03020706u), t2 = __builtin_amdgcn_perm(p1, q1, 0x01000504u), t3 = __builtin_amdgcn_perm(p1, q1, 0x03020706u);
                    acc[4 * k] = __builtin_amdgcn_sdot4((int)t0, wq[h][q], acc[4 * k], false); acc[4 * k + 1] = __builtin_amdgcn_sdot4((int)t1, wq[h][q], acc[4 * k + 1], false);
                    acc[4 * k + 2] = __builtin_amdgcn_sdot4((int)t2, wq[h][q], acc[4 * k + 2], false); acc[4 * k + 3] = __builtin_amdgcn_sdot4((int)t3, wq[h][q], acc[4 * k + 3], false); }
            int r8[8];
#pragma unroll
            for (int i = 0; i < 8; ++i) { auto r = __builtin_amdgcn_permlane32_swap((unsigned)acc[i], (unsigned)acc[i + 8], false, false); r8[i] = (int)r[0] + (int)r[1]; }
            f32x4 c4;
#pragma unroll
            for (int i = 0; i < 4; ++i) { auto r = __builtin_amdgcn_permlane16_swap((unsigned)r8[i], (unsigned)r8[i + 4], false, false); const int v = (int)r[0] + (int)r[1];
                c4[i] = (float)(v + __builtin_amdgcn_update_dpp(0, v, 0x128, 0xf, 0xf, false)) * sw[h]; }
            float ss = 0.f;
            if ((lane & 8) == 0) { const f32x4 o = xin[h] + c4;
                ss = (o[0] * o[0] + o[1] * o[1]) + (o[2] * o[2] + o[3] * o[3]);
                *(f32x4*)(XO + (size_t)tok * D + coff) = o;
                if (!last) { v2u b; b.x = pk2(o[0], o[1]); b.y = pk2(o[2], o[3]); *(v2u*)(XB + (size_t)tok * D + coff) = b; } }
            if (!last) { ss = wave_sum(ss);
                if (lane == 0) { SSP[(size_t)tok * 16 + 2 * x] = ss; SSP[(size_t)tok * 16 + 2 * x + 1] = 0.f; } } }
        LDS_WAIT();
    }
}
__device__ __forceinline__ void fox_prep(bfu* QKV, const float* qg, const float* kg, const float* LFT, float* CB, int G) {
    const int tid = tid_fresh(), lane = tid & 63, wave = tid >> 6; const int gw = bid_fresh() * NWV + wave, NGW = G * NWV;
    for (int crep = 0; crep < DBG_CUMSUM_REP; ++crep)
    if (wave == 0 && (bid_fresh() & 3) == 0 && (bid_fresh() >> 2) < 64 && G >= 256) {
        const int bh = bid_fresh() >> 2, b = bh >> 4, h = bh & 15; const float* src = LFT + (size_t)b * SEQ * 16 + h; float* dst = CB + (size_t)bh * SEQ; float carry = 0.f;
#pragma unroll 4
        for (int r = 0; r < 32; ++r) { const float* sp = src + (size_t)(256 * r + 4 * lane) * 16; const float p0 = logsigf_(sp[0]), p1 = p0 + logsigf_(sp[16]), p2 = p1 + logsigf_(sp[32]), p3 = p2 + logsigf_(sp[48]);
            float inc = p3;
#pragma unroll
            for (int o = 1; o < 64; o <<= 1) { const float t = __shfl_up(inc, o); if (lane >= o) inc += t; }
            const float base = carry + (inc - p3); const float k = -1.4426950408889634f;
            *(f32x4*)(dst + 256 * r + 4 * lane) = (f32x4){k * (base + p0), k * (base + p1), k * (base + p2), k * (base + p3)};
            carry += __shfl(inc, 63); }
    } else if (G < 256 && gw < 64) {
        const int bh = gw, b = bh >> 4, h = bh & 15; const float* src = LFT + (size_t)b * SEQ * 16 + h; float* dst = CB + (size_t)bh * SEQ; float carry = 0.f;
        for (int r = 0; r < 32; ++r) { const float* sp = src + (size_t)(256 * r + 4 * lane) * 16; const float p0 = logsigf_(sp[0]), p1 = p0 + logsigf_(sp[16]), p2 = p1 + logsigf_(sp[32]), p3 = p2 + logsigf_(sp[48]);
            float inc = p3;
#pragma unroll
            for (int o = 1; o < 64; o <<= 1) { const float t = __shfl_up(inc, o); if (lane >= o) inc += t; }
            const float base = carry + (inc - p3); const float k = -1.4426950408889634f;
            *(f32x4*)(dst + 256 * r + 4 * lane) = (f32x4){k * (base + p0), k * (base + p1), k * (base + p2), k * (base + p3)};
            carry += __shfl(inc, 63); }
    }
    const float C2 = 0.125f * 1.4426950408889634f;
    int wi = gw, nwk = NGW;
    if (G == 256) { if ((gw & 31) == 0) return; wi = gw - ((gw >> 5) + 1); nwk = NGW - 64; }
    for (int it = wi; it < 2 * M; it += nwk) { const int row = it >> 1, which = it & 1; bfu* p = QKV + (size_t)which * ((size_t)M * D) + (size_t)row * D + 8 * lane; const float* gn = which ? kg : qg; const float sc = which ? 1.0f : C2;
        const f32x4 g0 = *(const f32x4*)(gn + 8 * (lane & 7)), g1 = *(const f32x4*)(gn + 8 * (lane & 7) + 4);
#pragma unroll
        for (int q = 0; q < 2; ++q) { const v4u w = *(const v4u*)(p + 512 * q);
            float v[8] = {bflo(w.x), bfhi(w.x), bflo(w.y), bfhi(w.y), bflo(w.z), bfhi(w.z), bflo(w.w), bfhi(w.w)};
            float s = 0.f;
#pragma unroll
            for (int i = 0; i < 8; ++i) s += v[i] * v[i];
            s += __shfl_xor(s, 1); s += __shfl_xor(s, 2); s += __shfl_xor(s, 4);
            const float rs = sc * __builtin_amdgcn_rsqf(s * (1.f / 64.f) + EPSF);
            v4u o; o.x = pk2(v[0] * rs * g0[0], v[1] * rs * g0[1]); o.y = pk2(v[2] * rs * g0[2], v[3] * rs * g0[3]); o.z = pk2(v[4] * rs * g1[0], v[5] * rs * g1[1]); o.w = pk2(v[6] * rs * g1[2], v[7] * rs * g1[3]);
            *(v4u*)(p + 512 * q) = o; } }
}
#define RLX_AGENT __ATOMIC_RELAXED, __HIP_MEMORY_SCOPE_AGENT
#define XB_TMO      128
#define XB_XCNT(j)  (256  + 64 * (j))
#define XB_XSUB(j)  (1280 + 64 * (j))
#define XB_XGEN(j)  (2304 + 64 * (j))
#define XB_TOP      3328
#define XB_TOPGEN   3392
#define XCD_BAR_WORDS 3456
#define XB_SPIN_CAP (1u << 18)

__device__ __forceinline__ unsigned xb_ld(unsigned* p)              { return __hip_atomic_load(p, __ATOMIC_RELAXED, __HIP_MEMORY_SCOPE_AGENT); }
__device__ __forceinline__ unsigned xb_add(unsigned* p, unsigned v) { return __hip_atomic_fetch_add(p, v, __ATOMIC_RELAXED, __HIP_MEMORY_SCOPE_AGENT); }
__device__ __forceinline__ unsigned xb_xcc_id() { return (unsigned)__builtin_amdgcn_s_getreg((3 << 11) | 20) & 0xFu; }
#define XB_SPIN(cond, bar) do { unsigned _sp = 0; while (cond) { __builtin_amdgcn_s_sleep(1); \
    if ((++_sp & 255u) == 0u) { if (xb_ld(&(bar)[XB_TMO])) break; if (_sp > XB_SPIN_CAP) { atomicAdd(&(bar)[XB_TMO], 1u); break; } } } } while (0)

struct XcdBarrier {
    unsigned* bar; unsigned x;
    volatile LAS unsigned* st;
};

__device__ __forceinline__ XcdBarrier xcd_barrier_post(unsigned* bar, volatile LAS unsigned* st) {
    XcdBarrier b; b.bar = bar; b.x = xb_xcc_id(); b.st = st;
    if (threadIdx.x == 0) (void)xb_add(&bar[XB_XCNT(b.x)], 1u);
    return b;
}
__device__ __forceinline__ void xcd_barrier_complete(unsigned* bar, unsigned x, unsigned& nloc, unsigned& nx) {
    const unsigned G = gridDim.x * gridDim.y * gridDim.z;
    unsigned sum, cnt, mine, sp = 0u;
    for (;;) {
        sum = 0u; cnt = 0u; mine = 0u;
#pragma unroll
        for (unsigned j = 0; j < 16; ++j) { const unsigned c = xb_ld(&bar[XB_XCNT(j)]); sum += c; cnt += (c > 0u) ? 1u : 0u; mine = (j == x) ? c : mine; }
        if (sum == G) break;
        __builtin_amdgcn_s_sleep(1);
        if ((++sp & 255u) == 0u) { if (xb_ld(&bar[XB_TMO])) break; if (sp > XB_SPIN_CAP) { atomicAdd(&bar[XB_TMO], 1u); break; } }
    }
    nloc = mine > 0u ? mine : 1u; nx = cnt > 0u ? cnt : 1u;
}

__device__ __forceinline__ void xcd_barrier(const XcdBarrier& b) {
    asm volatile("s_waitcnt vmcnt(0)" ::: "memory");
    __syncthreads();
    if (threadIdx.x == 0) {
        unsigned* bar = b.bar;
        __builtin_amdgcn_s_waitcnt(0);
        unsigned nloc = b.st[0], nx = b.st[1];
        if (nloc == 0u) { xcd_barrier_complete(bar, b.x, nloc, nx); b.st[0] = nloc; b.st[1] = nx; }
        const unsigned old = xb_add(&bar[XB_XSUB(b.x)], 1u);
        const unsigned gen = old / nloc;
        if (old + 1u == (gen + 1u) * nloc) {
            __builtin_amdgcn_fence(__ATOMIC_RELEASE, "agent");
            asm volatile("s_waitcnt vmcnt(0)" ::: "memory");
            const unsigned og = xb_add(&bar[XB_TOP], 1u);
            const unsigned tg = og / nx;
            if (og + 1u == (tg + 1u) * nx) xb_add(&bar[XB_TOPGEN], 1u);
            else XB_SPIN(xb_ld(&bar[XB_TOPGEN]) == tg, bar);
            __builtin_amdgcn_fence(__ATOMIC_ACQUIRE, "agent");
            xb_add(&bar[XB_XGEN(b.x)], 1u);
            asm volatile("s_waitcnt vmcnt(0)" ::: "memory");
        } else {
            XB_SPIN(xb_ld(&bar[XB_XGEN(b.x)]) == gen, bar);
            __builtin_amdgcn_fence(__ATOMIC_ACQUIRE, "agent");
            asm volatile("s_waitcnt vmcnt(0)" ::: "memory");
        }
    }
    __syncthreads();
}

struct Params { const float* in[22]; float* out; unsigned char* ws; int ph_lo, ph_hi; };
constexpr int N_PHASES = 16;
#ifndef DBG_PROBE_U
#define DBG_PROBE_U 0
#endif
#ifndef DBG_PROBE_V
#define DBG_PROBE_V 0
#endif
#ifndef DBG_PROBE_ATT
#define DBG_PROBE_ATT 0
#endif
#ifndef DBG_DUP
#define DBG_DUP 0
#endif
#ifndef SKIPMASK
#define SKIPMASK 0
#endif
#define PH_ON(n) (!((SKIPMASK >> (n)) & 1))
typedef const __attribute__((address_space(4))) Params* KP;
__device__ __forceinline__ KP kparams() { KP k = (KP)__builtin_amdgcn_kernarg_segment_ptr(); asm volatile("" : "+s"(k)); return k; }
#define WSP(T, off) ((T*)(ws + (off)))
__global__ void __launch_bounds__(NTH, 2) trunk_fwd(Params p_unused) {
    extern __shared__ __attribute__((aligned(16))) unsigned char lds_raw[];
    LAS unsigned char* lds = (LAS unsigned char*)lds_raw;
    cg::grid_group grid = cg::this_grid();
    volatile LAS unsigned* xst = (volatile LAS unsigned*)(lds + LDS_BYTES - 64);
    if (threadIdx.x < 2) xst[threadIdx.x] = 0u;
    __syncthreads();
    XcdBarrier xbar = xcd_barrier_post((unsigned*)(kparams()->ws + WS_BAR), xst);
    int ph_hi; { KP k0 = kparams(); ph_hi = k0->ph_hi; }
    for (int ph = kparams()->ph_lo; ph < ph_hi; ++ph) {
        for (int rep = 0; rep < (((DBG_DUP >> ph) & 1) ? 2 : 1); ++rep) {
        if (rep) xcd_barrier(xbar);
        KP kp = kparams(); unsigned char* ws = kp->ws; int G = gridDim.x; asm volatile("" : "+s"(G));
        switch (ph) {
        case 0: if (PH_ON(0)) { const float* inl[22];
#pragma unroll
                  for (int i = 0; i < 22; ++i) inl[i] = kp->in[i];
                  p0_prologue(inl, ws, lds, G); } break;
        case 1: if (PH_ON(1)) { pg8::Gemm g{WSP(bfu, WS_XB), WSP(const bfu, WS_WINE), M, EVEN_PAD, D}; pg8::StaticOrder S; S.init(M, EVEN_PAD, G, (int)bid_fresh());
                  pg8::EpiScale<1> E{WSP(bfu, WS_R1), EVEN_IN, EVEN_IN, WSP(float, WS_SS)}; pg8::gemm_phase<pg8::EpiScale<1>, pg8::StaticOrder, true, true>(lds, g, S, E); } break;
        case 2: if (PH_ON(2)) { for (int u = bid_fresh(); u < M / 32; u += G) conv_unit(WSP(bfu, WS_R1), kp->in[3], kp->in[4], kp->in[5], kp->in[6], WSP(bfu, WS_R2), lds, u);
                  for (int u = bid_fresh(); u < 2048; u += G) gla_g1_unit(WSP(bfu, WS_R1), kp->in[7], kp->in[8], kp->out, WSP(float, WS_DEC), lds, u); } break;
        case 3: if (PH_ON(3)) gla_g2(kp->out, WSP(float, WS_DEC), G); break;
        case 4: if (PH_ON(4)) { for (int u = bid_fresh(); u < 2048; u += G) gla_g3_unit(WSP(bfu, WS_R1), kp->in[7], kp->in[8], kp->in[9], kp->out, WSP(bfu, WS_R2), lds, u); } break;
        case 5: case 12: if (PH_ON(5)) { const bool odd = (ph == 12); pg8::Gemm g{odd ? WSP(bfu, WS_R1) : WSP(bfu, WS_R2), (const bfu*)(ws + (odd ? WS_WOUTO : WS_WOUTE)), M, D, D}; pg8::StaticOrder S; S.init(M, D, G, (int)bid_fresh());
                  pg8::EpiResid E{odd ? (const float*)kp->out : kp->in[0], kp->out, WSP(bfu, WS_XB), WSP(float, WS_SSP)}; pg8::gemm_phase<pg8::EpiResid, pg8::StaticOrder, true, true>(lds, g, S, E); } break;
        case 6: case 13: if (PH_ON(6)) { const int l = (ph == 13); pg8::Gemm g{WSP(bfu, WS_XB), (const bfu*)(ws + WS_WQ + (size_t)l * 4 * MiB), M, 2048, D}; pg8::StaticOrder S; S.init(M, 2048, G, (int)bid_fresh());
                  pg8::EpiScale<16> E{WSP(bfu, WS_R1), 2048, 2048, WSP(float, WS_SSP)}; pg8::gemm_phase<pg8::EpiScale<16>, pg8::StaticOrder, true, true>(lds, g, S, E); } break;
        case 7: case 14: if (PH_ON(7)) { const int l = (ph == 14);
                  peer_hq(kp->out, WSP(float, WS_SSP), kp->in[17] + l * 1024, WSP(unsigned, WS_R2), WSP(float, WS_SS), G);
                  peer_topk(WSP(bfu, WS_R1), WSP(const bfu, WS_KEYS) + (size_t)l * 262144, WSP(unsigned short, WS_EXP), WSP(float, WS_GATE), lds, G); } break;
        case 8: case 15: if (PH_ON(8)) { const int l = (ph == 15); const unsigned char* U8 = ws + WS_UV + (size_t)l * 2 * 16777216; const float* USC = WSP(const float, WS_USC) + l * 2 * 16384;
#if DBG_PROBE_U
                  peer_u_rows(WSP(unsigned, WS_R2), WSP(float, WS_SS), U8, USC, USC + 16384, WSP(unsigned short, WS_EXP), WSP(float, WS_GATE), WSP(float, WS_R1), lds, G, bid_fresh() & 7, bid_fresh() >> 3);
                  xcd_barrier(xbar);
#endif
                  peer_u_rows(WSP(unsigned, WS_R2), WSP(float, WS_SS), U8, USC, USC + 16384, WSP(unsigned short, WS_EXP), WSP(float, WS_GATE), WSP(float, WS_GATE), lds, G, bid_fresh() & 7, bid_fresh() >> 3);
                  xcd_barrier(xbar);
#if DBG_PROBE_V
                  peer_v_slice(kparams()->out, WSP(float, WS_R1), WSP(float, WS_GATE), ws + WS_UV + (size_t)l * 2 * 16777216 + 16777216, WSP(unsigned short, WS_EXP), WSP(bfu, WS_R1 + 128 * MiB), WSP(float, WS_LFT), lds, G, bid_fresh() & 7, bid_fresh() >> 3, false);
                  xcd_barrier(xbar);
#endif
                  peer_v_slice(kparams()->out, kparams()->out, WSP(float, WS_GATE), ws + WS_UV + (size_t)l * 2 * 16777216 + 16777216, WSP(unsigned short, WS_EXP), WSP(bfu, WS_XB), WSP(float, WS_SSP), lds, G, bid_fresh() & 7, bid_fresh() >> 3, l == 1); } break;
        case 9: if (PH_ON(9)) { pg8::Gemm g{WSP(bfu, WS_XB), WSP(const bfu, WS_WINO), M, ODD_PAD, D}; pg8::StaticOrder S; S.init(M, ODD_PAD, G, (int)bid_fresh());
                  pg8::EpiQkv E{WSP(bfu, WS_R1), WSP(float, WS_SSP), WSP(float, WS_LFT), kp->in[13]}; pg8::gemm_phase<pg8::EpiQkv, pg8::StaticOrder, true, true>(lds, g, S, E); } break;
        case 10: if (PH_ON(10)) fox_prep(WSP(bfu, WS_R1), kp->in[14], kp->in[15], WSP(float, WS_LFT), WSP(float, WS_CB), G); break;
        case 11: if (PH_ON(11)) { bfu* R1 = WSP(bfu, WS_R1); const attn_body::AttnTensors AT{(const attn_body::bf16*)R1, (const attn_body::bf16*)(R1 + (size_t)M * D), (const attn_body::bf16*)(R1 + (size_t)2 * M * D), (attn_body::bf16*)R1};
#if DBG_PROBE_ATT
                  { const attn_body::AttnTensors AT2{(const attn_body::bf16*)R1, (const attn_body::bf16*)(R1 + (size_t)M * D), (const attn_body::bf16*)(R1 + (size_t)2 * M * D), (attn_body::bf16*)WSP(bfu, WS_R2)};
                    attn_body::attn_phase_dyn<8>((char*)lds_raw, AT2, WSP(float, WS_CB), kp->in[14], kp->in[15], (unsigned*)(ws + WS_BAR + 15360 + 32)); xcd_barrier(xbar); }
#endif
                  attn_body::attn_phase_dyn<14>((char*)lds_raw, AT, WSP(float, WS_CB), kp->in[14], kp->in[15], (unsigned*)(ws + WS_BAR + 15360)); } break;
        default: break;
        }
        }
        if (ph + 1 < ph_hi) { if (ph == kparams()->ph_lo) grid.sync(); else xcd_barrier(xbar); }
    }
}

extern "C" void kernel_launch(void* const* d_in, const int* in_sizes, int n_in, void* d_out, int out_size, void* d_ws, size_t ws_size, hipStream_t stream) {
    static int grid = 0;
    if (grid == 0) {
        if (n_in != 22 || out_size != M * D || ws_size < WS_END) { fprintf(stderr, "kernel_launch: unexpected problem (n_in %d, out %d, ws %zu)\n", n_in, out_size, ws_size); grid = -1; return; }
        int dev = 0, cus = 0, per_cu = 0;
        (void)hipGetDevice(&dev); (void)hipDeviceGetAttribute(&cus, hipDeviceAttributeMultiprocessorCount, dev);
        if (hipFuncSetAttribute((const void*)trunk_fwd, hipFuncAttributeMaxDynamicSharedMemorySize, LDS_BYTES) != hipSuccess) { fprintf(stderr, "kernel_launch: hipFuncSetAttribute failed\n"); grid = -1; return; }
        if (hipOccupancyMaxActiveBlocksPerMultiprocessor(&per_cu, (const void*)trunk_fwd, NTH, LDS_BYTES) != hipSuccess || per_cu < 1) { fprintf(stderr, "kernel_launch: occupancy query says %d\n", per_cu); per_cu = 1; }
        (void)hipGetLastError();
        grid = (cus / 8) * 8;
        fprintf(stderr, "kernel_launch: grid %d (cus %d, per_cu %d)\n", grid, cus, per_cu);
    }
    if (grid < 0) return;
    Params p{};
    for (int i = 0; i < 22; ++i) p.in[i] = (const float*)d_in[i];
    p.out = (float*)d_out; p.ws = (unsigned char*)d_ws; p.ph_lo = 0; p.ph_hi = N_PHASES;
    (void)hipMemsetAsync((char*)d_ws + WS_BAR, 0, 16384, stream);
    void* args[] = {&p};
    hipError_t e = hipLaunchCooperativeKernel((const void*)trunk_fwd, dim3(grid), dim3(NTH), args, LDS_BYTES, stream);
    if (e != hipSuccess) fprintf(stderr, "cooperative launch failed: %s (grid %d)\n", hipGetErrorString(e), grid);
}
```

```cpp
#include <hip/hip_runtime.h>
#include <hip/hip_cooperative_groups.h>
#include <hip/hip_bf16.h>
#include <cstdio>
#include <cstdint>
#include <cmath>
namespace cg = cooperative_groups;
namespace pg8 {
#define PG8_LAS __attribute__((address_space(3)))
typedef unsigned short bf16_t;
typedef short bf16x8 __attribute__((ext_vector_type(8)));
typedef float f32x4 __attribute__((ext_vector_type(4)));
typedef unsigned u32x4 __attribute__((ext_vector_type(4)));
constexpr int BM = 256, BK = 64, HALF = 128, HTB = HALF * BK * 2  , STAGE_BYTES = 8 * HTB, NXCD = 8, WGM = 8;

__host__ __device__ __forceinline__ int lds_byte(int r, int c) { const int st = (r >> 4) * 2 + (c >> 5), rr = r & 15, cc = c & 31, ob = rr * 64 + cc * 2; return st * 1024 + (ob ^ (((ob >> 9) & 1) << 5)); }
__host__ __device__ __forceinline__ void stage_rc(int b, int& R, int& C) { const int st = b / 1024, sb = b % 1024, swz = sb ^ (((sb >> 9) & 1) << 5); R = (st >> 1) * 16 + swz / 64; C = (st & 1) * 32 + (swz % 64) / 2; }
__host__ __device__ __forceinline__ int perm32(int rho) { const int n = rho >> 4, i = rho & 15; return 8 * (i >> 2) + 4 * n + (i & 3); }

struct Unit { int pm, pn; };
struct Gemm { const bf16_t* A; const bf16_t* Bt; int M, N, K; };

struct StaticOrder {
    int nM, nN, nwg, G, c;
    __host__ __device__ void init(int M, int N, int G_, int c_) { nM = M / BM; nN = N / BM; nwg = nM * nN; G = G_; c = c_; }
    __host__ __device__ bool next(int i, Unit& u) const {
        const long L = (long)i * G + c; if (L >= nwg) return false;
        int wgid = (int)L; { const int q = nwg / NXCD, r = nwg % NXCD, xcd = wgid % NXCD, off = wgid / NXCD; wgid = (xcd < r ? xcd * (q + 1) : r * (q + 1) + (xcd - r) * q) + off; }
        const int nig = WGM * nN, gid = wgid / nig, fm = gid * WGM, gsz = (nM - fm) < WGM ? (nM - fm) : WGM;
        u.pm = fm + ((wgid % nig) % gsz); u.pn = (wgid % nig) / gsz; return true;
    }
    __device__ __forceinline__ void a_ready(const Unit&) const {}
    __device__ __forceinline__ void done(const Unit&) const {}
};
__device__ __forceinline__ unsigned cvt_pk_bf16(float lo, float hi) { unsigned r; asm volatile("v_cvt_pk_bf16_f32 %0, %1, %2" : "=v"(r) : "v"(lo), "v"(hi)); return r; }
constexpr int MROWS = 32768;
template <int SSN> __device__ __forceinline__ float row_rstd(const float* ss, int row) {
    float s;
    if (SSN == 1) s = ss[row];
    else { const f32x4* p = (const f32x4*)(ss + (size_t)row * 16); const f32x4 a = p[0], b = p[1], c = p[2], d = p[3];
        s = (((a[0] + a[1]) + (a[2] + a[3])) + ((b[0] + b[1]) + (b[2] + b[3]))) + (((c[0] + c[1]) + (c[2] + c[3])) + ((d[0] + d[1]) + (d[2] + d[3]))); }
    return __builtin_amdgcn_rsqf(s * (1.0f / 1024.0f) + 1e-6f);
}
template <int SSN> struct EpiScale {
    static constexpr bool PERM = true, AFTER_DRAIN = false;
    bf16_t* O; int ldc; int nvalid; const float* ss;
    __device__ __forceinline__ void operator()(const f32x4 (&acc)[2][2][4][2], const Unit& u, int wr, int wc, int fr, int fq) const {
        const int row0 = u.pm * BM + wr * 64 + fr; const int col0 = u.pn * BM + wc * 32 + 8 * fq;
#pragma unroll
        for (int ai = 0; ai < 2; ++ai)
#pragma unroll
            for (int m = 0; m < 4; ++m) { const int row = row0 + ai * HALF + m * 16; const float rs = row_rstd<SSN>(ss, row); bf16_t* rowp = O + (size_t)row * ldc + col0;
#pragma unroll
                for (int bj = 0; bj < 2; ++bj) { if (col0 + bj * HALF < nvalid) { const f32x4 v0 = acc[ai][bj][m][0] * rs, v1 = acc[ai][bj][m][1] * rs;
                    u32x4 w; w.x = cvt_pk_bf16(v0[0], v0[1]); w.y = cvt_pk_bf16(v0[2], v0[3]); w.z = cvt_pk_bf16(v1[0], v1[1]); w.w = cvt_pk_bf16(v1[2], v1[3]);
                    *(u32x4*)(rowp + bj * HALF) = w; } } }
    }
};
struct EpiResid {
    static constexpr bool PERM = true, AFTER_DRAIN = false;
    const float* xin; float* xout; bf16_t* xb; float* ssp;
    __device__ __forceinline__ void operator()(const f32x4 (&acc)[2][2][4][2], const Unit& u, int wr, int wc, int fr, int fq) const {
        const int row0 = u.pm * BM + wr * 64 + fr; const int col0 = u.pn * BM + wc * 32 + 8 * fq;
#pragma unroll
        for (int ai = 0; ai < 2; ++ai)
#pragma unroll
            for (int m = 0; m < 4; ++m) { const int row = row0 + ai * HALF + m * 16; const size_t off = (size_t)row * 1024 + col0; float s = 0.f;
#pragma unroll
                for (int bj = 0; bj < 2; ++bj) { const f32x4 a0 = *(const f32x4*)(xin + off + bj * HALF), a1 = *(const f32x4*)(xin + off + bj * HALF + 4);
                    const f32x4 v0 = a0 + acc[ai][bj][m][0], v1 = a1 + acc[ai][bj][m][1];
                    *(f32x4*)(xout + off + bj * HALF) = v0; *(f32x4*)(xout + off + bj * HALF + 4) = v1;
                    s += (v0[0] * v0[0] + v0[1] * v0[1]) + (v0[2] * v0[2] + v0[3] * v0[3]) + (v1[0] * v1[0] + v1[1] * v1[1]) + (v1[2] * v1[2] + v1[3] * v1[3]);
                    u32x4 w; w.x = cvt_pk_bf16(v0[0], v0[1]); w.y = cvt_pk_bf16(v0[2], v0[3]); w.z = cvt_pk_bf16(v1[0], v1[1]); w.w = cvt_pk_bf16(v1[2], v1[3]);
                    *(u32x4*)(xb + off + bj * HALF) = w; }
                s += __shfl_xor(s, 16); s += __shfl_xor(s, 32);
                if (fq == 0) ssp[(size_t)row * 16 + u.pn * 4 + wc] = s; }
    }
};
struct EpiQkv {
    static constexpr bool PERM = true, AFTER_DRAIN = false;
    bf16_t* QKV; const float* ss; float* lft; const float* fb;
    __device__ __forceinline__ void operator()(const f32x4 (&acc)[2][2][4][2], const Unit& u, int wr, int wc, int fr, int fq) const {
        const int row0 = u.pm * BM + wr * 64 + fr;
        if (u.pn < 12) {
            bf16_t* base = QKV + (size_t)(u.pn >> 2) * ((size_t)MROWS * 1024); const int col0 = (u.pn & 3) * BM + wc * 32 + 8 * fq;
#pragma unroll
            for (int ai = 0; ai < 2; ++ai)
#pragma unroll
                for (int m = 0; m < 4; ++m) { const int row = row0 + ai * HALF + m * 16; const float rs = row_rstd<16>(ss, row); bf16_t* rowp = base + (size_t)row * 1024 + col0;
#pragma unroll
                    for (int bj = 0; bj < 2; ++bj) { const f32x4 v0 = acc[ai][bj][m][0] * rs, v1 = acc[ai][bj][m][1] * rs;
                        u32x4 w; w.x = cvt_pk_bf16(v0[0], v0[1]); w.y = cvt_pk_bf16(v0[2], v0[3]); w.z = cvt_pk_bf16(v1[0], v1[1]); w.w = cvt_pk_bf16(v1[2], v1[3]);
                        *(u32x4*)(rowp + bj * HALF) = w; } }
        } else if (wc == 0 && fq < 2) {
            const f32x4 f0 = *(const f32x4*)(fb + 8 * fq), f1 = *(const f32x4*)(fb + 8 * fq + 4);
#pragma unroll
            for (int ai = 0; ai < 2; ++ai)
#pragma unroll
                for (int m = 0; m < 4; ++m) { const int row = row0 + ai * HALF + m * 16; const float rs = row_rstd<16>(ss, row);
                    float* dst = lft + (size_t)row * 16 + 8 * fq;
                    *(f32x4*)dst = acc[ai][0][m][0] * rs + f0; *(f32x4*)(dst + 4) = acc[ai][0][m][1] * rs + f1; }
        }
    }
};
template <class Epi, class Sched, bool ALIGN_EPI = false, bool SP2 = false>
__device__ __forceinline__ void gemm_phase(PG8_LAS unsigned char* lds, const Gemm g, const Sched& S, const Epi& E) {
    int tid = threadIdx.x; asm volatile("" : "+v"(tid)); const int wid = __builtin_amdgcn_readfirstlane(tid >> 6), lane = tid & 63, wr = wid >> 2, wc = wid & 3, fr = lane & 15, fq = lane >> 4;
    const int K = g.K, nt = K / BK;
    unsigned voffA[2], voffB[2];
#pragma unroll
    for (int i = 0; i < 2; ++i) { int R, C; stage_rc(tid * 16 + i * 8192, R, C); const int Rb = Epi::PERM ? ((R & ~31) + perm32(R & 31)) : R;
        voffA[i] = (unsigned)(R * K + C) * 2u; voffB[i] = (unsigned)(Rb * K + C) * 2u; }
    const size_t kstep = (size_t)(BK * 2);
    const size_t hstep = (size_t)HALF * K * 2;
    const size_t tstep = 2 * hstep;
    const unsigned ldsw = (unsigned)wid * 1024u;
    const int aoff = lds_byte(wr * 64 + fr, fq * 8), boff = lds_byte(wc * 32 + fr, fq * 8);
#define PG8_SA(b, h) (((b) * 2 + (h)) * HTB)
#define PG8_SB(b, h) ((4 + (b) * 2 + (h)) * HTB)
#define PG8_STAGE(bufoff, gbase, voff) do { _Pragma("unroll") for (int _i = 0; _i < 2; ++_i) \
        __builtin_amdgcn_global_load_lds((const unsigned*)((const char*)(gbase) + (voff)[_i]), (PG8_LAS unsigned*)(lds + (bufoff) + ldsw + _i * 8192), 16, 0, 0); } while (0)
#define PG8_LDA(dst, b, h) do { _Pragma("unroll") for (int m = 0; m < 4; ++m) _Pragma("unroll") for (int k = 0; k < 2; ++k) dst[m][k] = *(const PG8_LAS bf16x8*)(lds + PG8_SA(b, h) + aoff + m * 2048 + k * 1024); } while (0)
#define PG8_LDB(dst, b, h) do { _Pragma("unroll") for (int n = 0; n < 2; ++n) _Pragma("unroll") for (int k = 0; k < 2; ++k) dst[n][k] = *(const PG8_LAS bf16x8*)(lds + PG8_SB(b, h) + boff + n * 2048 + k * 1024); } while (0)
#define PG8_MMA(ai, bj, At, Bt) do { __builtin_amdgcn_s_setprio(1); _Pragma("unroll") for (int m = 0; m < 4; ++m) _Pragma("unroll") for (int n = 0; n < 2; ++n) _Pragma("unroll") for (int k = 0; k < 2; ++k) \
        acc[ai][bj][m][n] = __builtin_amdgcn_mfma_f32_16x16x32_bf16(Bt[n][k], At[m][k], acc[ai][bj][m][n], 0, 0, 0); __builtin_amdgcn_s_setprio(0); } while (0)
#define PG8_WAIT_V(n) asm volatile("s_waitcnt vmcnt(" #n ")" ::: "memory")
#define PG8_WAIT_L(n) asm volatile("s_waitcnt lgkmcnt(" #n ")" ::: "memory")
#define PG8_BAR __builtin_amdgcn_s_barrier()
#define PG8_SCHED __builtin_amdgcn_sched_barrier(0)
    Unit cur, nxt; int ui = 0;
    if (!S.next(0, cur)) return;
    f32x4 acc[2][2][4][2];
#pragma unroll
    for (int a = 0; a < 2; ++a)
#pragma unroll
        for (int b = 0; b < 2; ++b)
#pragma unroll
            for (int m = 0; m < 4; ++m)
#pragma unroll
                for (int n = 0; n < 2; ++n) acc[a][b][m][n] = (f32x4){0.f, 0.f, 0.f, 0.f};
    bf16x8 At[4][2], B0[2][2], B1[2][2];
    const char* cA = (const char*)g.A + (size_t)cur.pm * tstep; const char* cB = (const char*)g.Bt + (size_t)cur.pn * tstep;
    S.a_ready(cur);
    if constexpr (SP2) {
        PG8_STAGE(PG8_SB(0, 0), cB, voffB); PG8_STAGE(PG8_SB(0, 1), cB + hstep, voffB); PG8_STAGE(PG8_SA(0, 0), cA, voffA); PG8_STAGE(PG8_SA(0, 1), cA + hstep, voffA);
        if (wr == 1) PG8_BAR;
        PG8_WAIT_V(2); PG8_BAR;
        PG8_STAGE(PG8_SB(1, 0), cB + kstep, voffB); PG8_STAGE(PG8_SA(1, 0), cA + kstep, voffA); PG8_STAGE(PG8_SB(1, 1), cB + hstep + kstep, voffB);
        PG8_WAIT_V(6); PG8_BAR;
    } else {
        PG8_STAGE(PG8_SB(0, 0), cB, voffB); PG8_STAGE(PG8_SA(0, 0), cA, voffA); PG8_STAGE(PG8_SB(0, 1), cB + hstep, voffB); PG8_STAGE(PG8_SA(0, 1), cA + hstep, voffA);
        if (wr == 1) PG8_BAR;
        PG8_WAIT_V(4); PG8_BAR;
        PG8_STAGE(PG8_SB(1, 0), cB + kstep, voffB); PG8_STAGE(PG8_SA(1, 0), cA + kstep, voffA); PG8_STAGE(PG8_SB(1, 1), cB + hstep + kstep, voffB);
        PG8_WAIT_V(6); PG8_BAR;
    }
    for (;;) {
        const bool has_next = S.next(ui + 1, nxt);
        const char* nA = has_next ? (const char*)g.A + (size_t)nxt.pm * tstep : cA; const char* nB = has_next ? (const char*)g.Bt + (size_t)nxt.pn * tstep : cB;
        for (int t = 0; t < nt; t += 2) {
            const bool last = (t == nt - 2);
            const char* a1 = cA + (size_t)(t + 1) * kstep;
            const char* a2 = last ? nA : cA + (size_t)(t + 2) * kstep; const char* b2 = last ? nB : cB + (size_t)(t + 2) * kstep;
            const char* a3 = a2 + kstep; const char* b3 = b2 + kstep;
            if (last && has_next) S.a_ready(nxt);
            if constexpr (SP2) {
            PG8_LDB(B0, 0, 0); PG8_LDB(B1, 0, 1); PG8_SCHED; PG8_LDA(At, 0, 0); PG8_STAGE(PG8_SA(1, 1), a1 + hstep, voffA);
            PG8_WAIT_V(8); PG8_WAIT_L(0); PG8_BAR; PG8_MMA(0, 0, At, B0); PG8_MMA(0, 1, At, B1); PG8_BAR; PG8_SCHED;
            PG8_LDA(At, 0, 1); PG8_STAGE(PG8_SB(0, 0), b2, voffB); PG8_STAGE(PG8_SB(0, 1), b2 + hstep, voffB); PG8_STAGE(PG8_SA(0, 0), a2, voffA);
            PG8_WAIT_V(8); PG8_WAIT_L(0); PG8_BAR; PG8_MMA(1, 0, At, B0); PG8_MMA(1, 1, At, B1); PG8_BAR; PG8_SCHED;
            PG8_LDB(B0, 1, 0); PG8_LDB(B1, 1, 1); PG8_SCHED; PG8_LDA(At, 1, 0); PG8_STAGE(PG8_SA(0, 1), a2 + hstep, voffA);
            PG8_WAIT_V(8); PG8_WAIT_L(0); PG8_BAR; PG8_MMA(0, 0, At, B0); PG8_MMA(0, 1, At, B1); PG8_BAR; PG8_SCHED;
            PG8_LDA(At, 1, 1); PG8_STAGE(PG8_SB(1, 0), b3, voffB); PG8_STAGE(PG8_SB(1, 1), b3 + hstep, voffB); PG8_STAGE(PG8_SA(1, 0), a3, voffA);
            PG8_WAIT_V(8); PG8_WAIT_L(0); PG8_BAR; PG8_MMA(1, 0, At, B0); PG8_MMA(1, 1, At, B1); PG8_BAR; PG8_SCHED;
            } else {
            PG8_LDB(B0, 0, 0); PG8_SCHED; PG8_LDA(At, 0, 0); PG8_STAGE(PG8_SA(1, 1), a1 + hstep, voffA);
            PG8_WAIT_L(8); PG8_BAR; PG8_WAIT_L(0); PG8_MMA(0, 0, At, B0); PG8_BAR; PG8_SCHED;
            PG8_LDB(B1, 0, 1); PG8_STAGE(PG8_SB(0, 0), b2, voffB);
            PG8_BAR; PG8_WAIT_L(0); PG8_MMA(0, 1, At, B1); PG8_BAR;
            PG8_LDA(At, 0, 1); PG8_STAGE(PG8_SA(0, 0), a2, voffA);
            PG8_BAR; PG8_WAIT_L(0); PG8_MMA(1, 0, At, B0); PG8_BAR; PG8_SCHED;
            PG8_STAGE(PG8_SB(0, 1), b2 + hstep, voffB);
            PG8_WAIT_V(6); PG8_BAR; PG8_MMA(1, 1, At, B1); PG8_BAR;
            PG8_LDB(B0, 1, 0); PG8_SCHED; PG8_LDA(At, 1, 0); PG8_STAGE(PG8_SA(0, 1), a2 + hstep, voffA);
            PG8_WAIT_L(8); PG8_BAR; PG8_WAIT_L(0); PG8_MMA(0, 0, At, B0); PG8_BAR; PG8_SCHED;
            PG8_LDB(B1, 1, 1); PG8_STAGE(PG8_SB(1, 0), b3, voffB);
            PG8_BAR; PG8_WAIT_L(0); PG8_MMA(0, 1, At, B1); PG8_BAR;
            PG8_LDA(At, 1, 1); PG8_STAGE(PG8_SA(1, 0), a3, voffA);
            PG8_BAR; PG8_WAIT_L(0); PG8_MMA(1, 0, At, B0); PG8_BAR; PG8_SCHED;
            PG8_STAGE(PG8_SB(1, 1), b3 + hstep, voffB);
            PG8_WAIT_V(6); PG8_BAR; PG8_MMA(1, 1, At, B1); PG8_BAR;
            }
        }
        if constexpr (ALIGN_EPI) { if (wr == 0) PG8_BAR; }
        if constexpr (!Epi::AFTER_DRAIN) { E(acc, cur, wr, wc, fr, fq); S.done(cur); }
        if (!has_next) break;
#pragma unroll
        for (int a = 0; a < 2; ++a)
#pragma unroll
            for (int b = 0; b < 2; ++b)
#pragma unroll
                for (int m = 0; m < 4; ++m)
#pragma unroll
                    for (int n = 0; n < 2; ++n) acc[a][b][m][n] = (f32x4){0.f, 0.f, 0.f, 0.f};
        cur = nxt; cA = nA; cB = nB; ++ui;
        if constexpr (ALIGN_EPI) { if (wr == 1) PG8_BAR; }
    }
    PG8_WAIT_V(0);
    if constexpr (!ALIGN_EPI) { if (wr == 0) PG8_BAR; }
    PG8_BAR;
    if constexpr (Epi::AFTER_DRAIN) { E.fused(acc, cur, wr, wc, fr, fq, lds, wid, lane); S.done(cur); }
#undef PG8_SA
#undef PG8_SB
#undef PG8_STAGE
#undef PG8_LDA
#undef PG8_LDB
#undef PG8_MMA
#undef PG8_WAIT_V
#undef PG8_WAIT_L
#undef PG8_BAR
#undef PG8_SCHED
}
}
#include <hip/hip_bf16.h>
#include <cmath>
namespace attn_body {
using bf16=__hip_bfloat16;
using bf16x8=__attribute__((ext_vector_type(8)))short;
using s16x4=__attribute__((ext_vector_type(4)))short;
using f32x16=__attribute__((ext_vector_type(16)))float;
using u32x4=__attribute__((ext_vector_type(4)))unsigned;
constexpr int BATCH=4,NHEAD=16,SEQ=8192,D=64,DM=NHEAD*D;
constexpr int NW=8,QBLK=32,QB=QBLK*NW,KVBLK=64,NQB=SEQ/QB;
constexpr int ATTN_PITCH=DM, ATTN_UNIT_ROWS=QB;
__device__ __forceinline__ int crow(int r,int hi){return (r&3)+8*(r>>2)+4*hi;}
#define SBAR() __builtin_amdgcn_sched_barrier(0)
__device__ __forceinline__ void cmask(f32x16&p0,f32x16&p1,int jb,int qrel,int hi){
  const float NEG=-INFINITY; int kb=64*jb+4*hi;
  #pragma unroll
  for(int r=0;r<16;++r){int kv=kb+(r&3)+8*(r>>2); if(kv>qrel)p0[r]=NEG; if(kv+32>qrel)p1[r]=NEG;}
}

constexpr int NSLOT=3, SLOTB=8192;
constexpr int LDS_K=0, LDS_V=NSLOT*SLOTB, LDS_WS=2*NSLOT*SLOTB, LDS_OST=LDS_WS+NW*64*4, LDS_BYTES=LDS_OST+NW*4096;
constexpr float C2=0.125f*1.4426950408889634f;
__device__ __forceinline__ void glds16(const void*gsrc,unsigned lds_dst){unsigned keep;
  asm volatile("s_mov_b32 %0, m0\n\ts_mov_b32 m0, %2\n\ts_nop 0\n\tglobal_load_lds_dwordx4 %1, off\n\ts_mov_b32 m0, %0":"=&s"(keep):"v"(gsrc),"s"(lds_dst):"memory");}
__device__ __forceinline__ float max3f(float a,float b,float c){float r;asm("v_max3_f32 %0, %1, %2, %3":"=v"(r):"v"(a),"v"(b),"v"(c));return r;}
__device__ __forceinline__ float max2f(float a,float b){float r;asm("v_max_f32_e32 %0, %1, %2":"=v"(r):"v"(a),"v"(b));return r;}
__device__ __forceinline__ float fadd_s(float a,float b){float r;asm("v_add_f32_e32 %0, %1, %2":"=v"(r):"v"(a),"v"(b));return r;}
__device__ __forceinline__ float fsub_s(float a,float b){float r;asm("v_sub_f32_e32 %0, %1, %2":"=v"(r):"v"(a),"v"(b));return r;}
typedef float f32x2_t __attribute__((ext_vector_type(2))); typedef __bf16 bf16x2_t __attribute__((ext_vector_type(2)));
__device__ __forceinline__ unsigned cvtpk_s(float lo,float hi){f32x2_t v={lo,hi};bf16x2_t b=__builtin_convertvector(v,bf16x2_t);return __builtin_bit_cast(unsigned,b);}
#define WAIT_BAR(N) asm volatile("s_waitcnt vmcnt(" #N ") lgkmcnt(0)\n\ts_barrier":::"memory")

__device__ __forceinline__ void qkt(f32x16&p0,f32x16&p1,const char*Kslot,const bf16x8*qr,const f32x16&negm,int r32,int hi){
  const char*kb=Kslot+hi*1024+r32*16;
  #pragma unroll
  for(int d0=0;d0<4;++d0){
    const bf16x8 b0=*reinterpret_cast<const bf16x8*>(kb+d0*2048);
    const bf16x8 b1=*reinterpret_cast<const bf16x8*>(kb+d0*2048+512);
    if(d0==0){p0=__builtin_amdgcn_mfma_f32_32x32x16_bf16(b0,qr[0],negm,0,0,0);p1=__builtin_amdgcn_mfma_f32_32x32x16_bf16(b1,qr[0],negm,0,0,0);}
    else{p0=__builtin_amdgcn_mfma_f32_32x32x16_bf16(b0,qr[d0],p0,0,0,0);p1=__builtin_amdgcn_mfma_f32_32x32x16_bf16(b1,qr[d0],p1,0,0,0);}}
}
typedef __attribute__((address_space(3))) const char* lds_cptr;
typedef short v4i16_t __attribute__((ext_vector_type(4)));
__device__ __forceinline__ void kload8(bf16x8*kf,lds_cptr kp){
  kf[0]=*(const __attribute__((address_space(3))) bf16x8*)(kp);      kf[1]=*(const __attribute__((address_space(3))) bf16x8*)(kp+512);
  kf[2]=*(const __attribute__((address_space(3))) bf16x8*)(kp+2048); kf[3]=*(const __attribute__((address_space(3))) bf16x8*)(kp+2560);
  kf[4]=*(const __attribute__((address_space(3))) bf16x8*)(kp+4096); kf[5]=*(const __attribute__((address_space(3))) bf16x8*)(kp+4608);
  kf[6]=*(const __attribute__((address_space(3))) bf16x8*)(kp+6144); kf[7]=*(const __attribute__((address_space(3))) bf16x8*)(kp+6656);
}
__device__ __forceinline__ void kload2(bf16x8*kf,lds_cptr kp,int j){ kf[2*j]=*(const __attribute__((address_space(3))) bf16x8*)(kp+j*2048); kf[2*j+1]=*(const __attribute__((address_space(3))) bf16x8*)(kp+j*2048+512); }
__device__ __forceinline__ s16x4 vtr(lds_cptr p){ return __builtin_bit_cast(s16x4,__builtin_amdgcn_ds_read_tr16_b64_v4i16((__attribute__((address_space(3))) v4i16_t*)p)); }
__device__ __forceinline__ float rowmax(const f32x16&p0,const f32x16&p1){
  float a=max3f(p0[0],p0[1],p1[0]),b=max3f(p0[2],p0[3],p1[1]);a=max3f(a,p1[2],p1[3]);
  #pragma unroll
  for(int r=4;r<16;r+=4){a=max3f(a,p0[r],p0[r+1]);b=max3f(b,p0[r+2],p0[r+3]);a=max3f(a,p1[r],p1[r+1]);b=max3f(b,p1[r+2],p1[r+3]);}
  const float m=max2f(a,b);
  auto rr=__builtin_amdgcn_permlane32_swap(__float_as_uint(m),__float_as_uint(m),false,false);
  return max2f(__uint_as_float(rr[0]),__uint_as_float(rr[1]));
}
__device__ __forceinline__ void pv(f32x16*o,int vb,bf16x8 pa0,bf16x8 pa1,bf16x8 pa2,bf16x8 pa3){
  #pragma unroll
  for(int d0=0;d0<2;++d0){s16x4 lo[4],hi[4];
    #pragma unroll
    for(int ks=0;ks<4;++ks){
      asm volatile("ds_read_b64_tr_b16 %0,%1 offset:%c2":"=&v"(lo[ks]):"v"(vb),"i"(d0*4096+ks*1024):"memory");
      asm volatile("ds_read_b64_tr_b16 %0,%1 offset:%c2":"=&v"(hi[ks]):"v"(vb),"i"(d0*4096+ks*1024+512):"memory");}
    asm volatile("s_waitcnt lgkmcnt(0)":::"memory");SBAR();
    #define PK(k) (bf16x8){lo[k][0],lo[k][1],lo[k][2],lo[k][3],hi[k][0],hi[k][1],hi[k][2],hi[k][3]}
    o[d0]=__builtin_amdgcn_mfma_f32_32x32x16_bf16(pa0,PK(0),o[d0],0,0,0);
    o[d0]=__builtin_amdgcn_mfma_f32_32x32x16_bf16(pa1,PK(1),o[d0],0,0,0);
    o[d0]=__builtin_amdgcn_mfma_f32_32x32x16_bf16(pa2,PK(2),o[d0],0,0,0);
    o[d0]=__builtin_amdgcn_mfma_f32_32x32x16_bf16(pa3,PK(3),o[d0],0,0,0);
    #undef PK
  }
}

typedef float f32x4_t __attribute__((ext_vector_type(4)));
typedef __attribute__((address_space(3))) const float* lds_fptr;
typedef __attribute__((address_space(3))) const f32x4_t* lds_f4ptr;
#define BIAS(P0,P1,t) do{ const lds_f4ptr bp_=(lds_f4ptr)(bl+(t)*64+4*hi); \
  _Pragma("unroll") for(int g_=0;g_<4;++g_){ { const f32x4_t v0_=bp_[2*g_]; \
    P0[4*g_]+=v0_[0];P0[4*g_+1]+=v0_[1];P0[4*g_+2]+=v0_[2];P0[4*g_+3]+=v0_[3]; } SBAR(); \
    { const f32x4_t v1_=bp_[8+2*g_]; \
    P1[4*g_]+=v1_[0];P1[4*g_+1]+=v1_[1];P1[4*g_+2]+=v1_[2];P1[4*g_+3]+=v1_[3]; } SBAR(); } }while(0)
#define PREFILL(P0,P1,t) do{ const lds_f4ptr bp_=(lds_f4ptr)(bl+(t)*64+4*hi); \
  _Pragma("unroll") for(int g_=0;g_<4;++g_){ { const f32x4_t v0_=bp_[2*g_]; \
    P0[4*g_]=v0_[0]-mhat;P0[4*g_+1]=v0_[1]-mhat;P0[4*g_+2]=v0_[2]-mhat;P0[4*g_+3]=v0_[3]-mhat; } SBAR(); \
    { const f32x4_t v1_=bp_[8+2*g_]; \
    P1[4*g_]=v1_[0]-mhat;P1[4*g_+1]=v1_[1]-mhat;P1[4*g_+2]=v1_[2]-mhat;P1[4*g_+3]=v1_[3]-mhat; } SBAR(); } }while(0)
#ifndef ATTN_STORE16
#define ATTN_STORE16(p,v) (*(u32x4*)(p)=(v))
#endif
template<int THRL> __device__ __forceinline__ void attn_unit(int b,int h,int qb,const bf16*Q,const bf16*__restrict__ K,const bf16*__restrict__ V,bf16*O,char*shm,lds_fptr bl,int t0){
  int tid=threadIdx.x; asm volatile("":"+v"(tid)); const int lane=tid&63,r32=lane&31,hi=lane>>5; const int wid=__builtin_amdgcn_readfirstlane(tid>>6);
  const long rowbase=(long)b*SEQ; const int q0=qb*QB;
  const bf16*Qw=Q+(rowbase+q0+wid*QBLK)*DM+h*D;
  const bf16*Kh=K+(rowbase+(long)t0*KVBLK)*DM+h*D,*Vh=V+(rowbase+(long)t0*KVBLK)*DM+h*D;
  const unsigned lds0=(unsigned)(uintptr_t)shm;
  float*wsf=(float*)(shm+LDS_WS)+wid*64;
  const bf16*ksrc=Kh+(long)lane*DM+wid*8;
  const bf16*vsrc=Vh+(long)(16*(wid&3)+(lane>>2))*DM+(wid>>2)*32+(lane&3)*8;
  const unsigned kdst=lds0+LDS_K+wid*1024, vdst=lds0+LDS_V+wid*1024;
  #define DMA_K(t,slot) glds16(ksrc+(long)(t)*KVBLK*DM,(unsigned)__builtin_amdgcn_readfirstlane(kdst+(slot)))
  #define DMA_V(t,slot) glds16(vsrc+(long)(t)*KVBLK*DM,(unsigned)__builtin_amdgcn_readfirstlane(vdst+(slot)))
  const int vb0=(int)(lds0+LDS_V)+((lane>>4)&1)*32+(lane&3)*8+(4*hi+((lane&15)>>2))*64;
  const char*Kbase=shm+LDS_K; bf16x8 kf[8];
  const lds_cptr shm3=(lds_cptr)shm; const lds_cptr kp0=shm3+LDS_K+hi*1024+r32*16; const lds_cptr vp0=shm3+LDS_V+((lane>>4)&1)*32+(lane&3)*8+(4*hi+((lane&15)>>2))*64;
  const int NT=(q0+QB)/KVBLK-t0;
  DMA_K(0,0);DMA_V(0,0);DMA_K(1,SLOTB);
  bf16x8 qr[4];
  #pragma unroll
  for(int d0=0;d0<4;++d0)qr[d0]=*reinterpret_cast<const bf16x8*>(&Qw[(long)r32*DM+d0*16+hi*8]);
  float mhat=0.f,l_reg=0.f;f32x16 o[2];o[0]=f32x16{};o[1]=f32x16{};f32x16 negm=f32x16{};asm volatile("":"+v"(negm));
  const int qrel=wid*QBLK+r32;
  #define CMASK(P0,P1,t) do{int jb_=(t)-(NT-4); if(jb_>=0)cmask(P0,P1,jb_,qrel,hi);}while(0)
  bool resc=false;
  #define START(P0,P1) do{ const float rm=rowmax(P0,P1); resc=false; \
    { const float dl=rm; mhat=fadd_s(mhat,dl); \
      _Pragma("unroll") for(int r=0;r<16;++r){P0[r]=fsub_s(P0[r],dl);P1[r]=fsub_s(P1[r],dl);} \
      } \
    _Pragma("unroll") for(int r=0;r<16;++r)P0[r]=__builtin_amdgcn_exp2f(P0[r]); }while(0)
  #define RESC() do{ if(resc){ asm volatile("s_waitcnt lgkmcnt(0)":::"memory"); \
      _Pragma("unroll") for(int d_=0;d_<2;++d_) _Pragma("unroll") for(int r=0;r<16;++r)o[d_][r]*=wsf[crow(r,hi)]; } }while(0)
  f32x16 pA0,pA1,pB0,pB1;
  int sl_prev=0,sl_cur=0,sl_next=SLOTB;
  #define ROT() do{sl_prev=sl_cur;sl_cur=sl_next;sl_next=(sl_next==(NSLOT-1)*SLOTB)?0:sl_next+SLOTB;}while(0)
  DMA_K(2,2*SLOTB);
  WAIT_BAR(3);
  qkt(pA0,pA1,Kbase,qr,negm,r32,hi);asm volatile("s_nop 15\n\ts_nop 7":"+v"(pA0),"+v"(pA1));BIAS(pA0,pA1,0);CMASK(pA0,pA1,0);
  START(pA0,pA1);
  PREFILL(pB0,pB1,1);
  _Pragma("unroll") for(int r=0;r<16;++r)pA1[r]=__builtin_amdgcn_exp2f(pA1[r]);
  WAIT_BAR(0);
  DMA_K(3,0);DMA_V(1,SLOTB);
  ROT();
  kload8(kf,kp0+sl_cur);
  WAIT_BAR(2);
  s16x4 vlo[8],vhi[8]; u32x4 pw0,pw1,pw2,pw3;
  #define PKW(P,B) cvtpk_s(P[B],P[B+1])
  #define PAF(k) __builtin_bit_cast(bf16x8,pw##k)
  #define VFR(i) (bf16x8){vlo[i][0],vlo[i][1],vlo[i][2],vlo[i][3],vhi[i][0],vhi[i][1],vhi[i][2],vhi[i][3]}
  #define PIN(x) asm volatile("":"+v"(x))
  #define MX3(a,b,c) __builtin_fmaxf(__builtin_fmaxf((a),(b)),(c))
  #define GAPA(MF,A0,A1,A2,A3,W0,W1,PW) do{ MF; sacc+=A0; sacc+=A1; sacc+=A2; sacc+=A3; PIN(sacc); W0; W1; PIN(PW); SBAR(); }while(0)
  #define EX(v) __builtin_amdgcn_exp2f(v)
  #define GAPB(MF,X,B,PRE) do{ MF; PRE; X[B]=EX(X[B]); X[B+1]=EX(X[B+1]); X[B+2]=EX(X[B+2]); X[B+3]=EX(X[B+3]); PIN(X); SBAR(); }while(0)
  #define PREF(P,g,nf4) do{ P[4*(g)]=vq_[0]-mhat; P[4*(g)+1]=vq_[1]-mhat; P[4*(g)+2]=vq_[2]-mhat; P[4*(g)+3]=vq_[3]-mhat; vq_=bpn_[nf4]; }while(0)
  #define VRD(i) do{ vlo[i]=vtr(vp_+(((i)>>2)*4096+((i)&3)*1024)); vhi[i]=vtr(vp_+(((i)>>2)*4096+((i)&3)*1024+512)); }while(0)
  #define KRD(G,j) do{ if(G){ kload2(kf,kp0+sl_next,j); SBAR(); } }while(0)
  #define STEP(C0,C1,P0,P1,t,GK,GV,GL) do{ SBAR(); \
    const lds_cptr vp_=vp0+sl_prev; \
    VRD(0); SBAR(); float sacc=(P0[0]+P0[1]); \
    GAPA(C0=__builtin_amdgcn_mfma_f32_32x32x16_bf16(kf[0],qr[0],C0,0,0,0), P0[2],P0[3],P0[4],P0[5],     pw0[0]=PKW(P0,0), pw0[1]=PKW(P0,2), pw0); \
    VRD(4); SBAR(); GAPA(C1=__builtin_amdgcn_mfma_f32_32x32x16_bf16(kf[1],qr[0],C1,0,0,0), P0[6],P0[7],P0[8],P0[9],     pw0[2]=PKW(P0,4), pw0[3]=PKW(P0,6), pw0); \
    VRD(1); SBAR(); GAPA(C0=__builtin_amdgcn_mfma_f32_32x32x16_bf16(kf[2],qr[1],C0,0,0,0),   P0[10],P0[11],P0[12],P0[13], pw1[0]=PKW(P0,8), pw1[1]=PKW(P0,10), pw1); \
    VRD(5); SBAR(); GAPA(C1=__builtin_amdgcn_mfma_f32_32x32x16_bf16(kf[3],qr[1],C1,0,0,0),   P0[14],P0[15],P1[0],P1[1],   pw1[2]=PKW(P0,12),pw1[3]=PKW(P0,14), pw1); \
    VRD(2); SBAR(); GAPA(C0=__builtin_amdgcn_mfma_f32_32x32x16_bf16(kf[4],qr[2],C0,0,0,0),   P1[2],P1[3],P1[4],P1[5],     pw2[0]=PKW(P1,0), pw2[1]=PKW(P1,2), pw2); \
    VRD(6); SBAR(); GAPA(C1=__builtin_amdgcn_mfma_f32_32x32x16_bf16(kf[5],qr[2],C1,0,0,0),   P1[6],P1[7],P1[8],P1[9],     pw2[2]=PKW(P1,4), pw2[3]=PKW(P1,6), pw2); \
    VRD(3); SBAR(); GAPA(C0=__builtin_amdgcn_mfma_f32_32x32x16_bf16(kf[6],qr[3],C0,0,0,0),   P1[10],P1[11],P1[12],P1[13], pw3[0]=PKW(P1,8), pw3[1]=PKW(P1,10), pw3); \
    VRD(7); SBAR(); GAPA(C1=__builtin_amdgcn_mfma_f32_32x32x16_bf16(kf[7],qr[3],C1,0,0,0),   P1[14],P1[15],0.f,0.f,       pw3[2]=PKW(P1,12),pw3[3]=PKW(P1,14), pw3); \
    l_reg+=sacc; \
    if(GK){DMA_K((t)+3,sl_cur);} if(GV){DMA_V((t)+1,sl_next);} \
    CMASK(C0,C1,t); \
    { float a=MX3(C0[0],C0[1],C1[0]),b=MX3(C0[2],C0[3],C1[1]); a=MX3(a,C1[2],C1[3]); \
      _Pragma("unroll") for(int r=4;r<16;r+=4){a=MX3(a,C0[r],C0[r+1]);b=MX3(b,C0[r+2],C0[r+3]);a=MX3(a,C1[r],C1[r+1]);b=MX3(b,C1[r+2],C1[r+3]);} \
      float rm=__builtin_fmaxf(a,b); { auto rr=__builtin_amdgcn_permlane32_swap(__float_as_uint(rm),__float_as_uint(rm),false,false); rm=__builtin_fmaxf(__uint_as_float(rr[0]),__uint_as_float(rr[1])); } \
      resc=false; \
      if(__builtin_expect(__any(rm>(float)THRL),0)){ const float dl=__builtin_fmaxf(rm,0.f); mhat+=dl; \
        _Pragma("unroll") for(int r=0;r<16;++r){C0[r]-=dl;C1[r]-=dl;} \
        const float f=__builtin_amdgcn_exp2f(-dl); l_reg*=f; if(hi==0)wsf[r32]=f; resc=true; } } \
    const lds_f4ptr bpn_=(lds_f4ptr)(bl+((t)+1)*64+4*hi); f32x4_t vq_=bpn_[0]; \
    SBAR(); \
    GAPB(o[0]=__builtin_amdgcn_mfma_f32_32x32x16_bf16(PAF(0),VFR(0),o[0],0,0,0), C0,0, PREF(P0,0,2)); \
    GAPB(o[1]=__builtin_amdgcn_mfma_f32_32x32x16_bf16(PAF(0),VFR(4),o[1],0,0,0), C0,4, PREF(P0,1,4)); \
    KRD(GL,0); GAPB(o[0]=__builtin_amdgcn_mfma_f32_32x32x16_bf16(PAF(1),VFR(1),o[0],0,0,0), C0,8, PREF(P0,2,6)); \
    KRD(GL,1); GAPB(o[1]=__builtin_amdgcn_mfma_f32_32x32x16_bf16(PAF(1),VFR(5),o[1],0,0,0), C0,12, PREF(P0,3,8)); \
    KRD(GL,2); GAPB(o[0]=__builtin_amdgcn_mfma_f32_32x32x16_bf16(PAF(2),VFR(2),o[0],0,0,0), C1,0, PREF(P1,0,10)); \
    KRD(GL,3); GAPB(o[1]=__builtin_amdgcn_mfma_f32_32x32x16_bf16(PAF(2),VFR(6),o[1],0,0,0), C1,4, PREF(P1,1,12)); \
    GAPB(o[0]=__builtin_amdgcn_mfma_f32_32x32x16_bf16(PAF(3),VFR(3),o[0],0,0,0), C1,8, PREF(P1,2,14)); \
    GAPB(o[1]=__builtin_amdgcn_mfma_f32_32x32x16_bf16(PAF(3),VFR(7),o[1],0,0,0), C1,12, PREF(P1,3,14)); \
    }while(0)
  int t=1;
  #undef CMASK
  #define CMASK(P0,P1,t) do{}while(0)
  for(;t+5<NT;t+=2){
    STEP(pB0,pB1,pA0,pA1,t,true,true,true);     WAIT_BAR(2); RESC(); ROT();
    STEP(pA0,pA1,pB0,pB1,t+1,true,true,true);   WAIT_BAR(2); RESC(); ROT();
  }
  #undef CMASK
  #define CMASK(P0,P1,t) do{int jb_=(t)-(NT-4); if(jb_>=0)cmask(P0,P1,jb_,qrel,hi);}while(0)
  #define ENDW(tt) do{ if((tt)+3<NT){WAIT_BAR(2);} else if((tt)+2<NT){WAIT_BAR(1);} else {WAIT_BAR(0);} }while(0)
  for(;t+1<NT;t+=2){
    STEP(pB0,pB1,pA0,pA1,t,(t+3<NT),(t+1<NT),(t+1<NT));       ENDW(t);   RESC(); ROT();
    STEP(pA0,pA1,pB0,pB1,t+1,(t+4<NT),(t+2<NT),(t+2<NT));     ENDW(t+1); RESC(); ROT();
  }
  STEP(pB0,pB1,pA0,pA1,NT-1,false,false,false); RESC();
  { float sacc=pB0[0]+pB0[1]; _Pragma("unroll") for(int r=2;r<16;++r)sacc+=pB0[r]; _Pragma("unroll") for(int r=0;r<16;++r)sacc+=pB1[r]; l_reg+=sacc;
    pw0=(u32x4){PKW(pB0,0),PKW(pB0,2),PKW(pB0,4),PKW(pB0,6)};pw1=(u32x4){PKW(pB0,8),PKW(pB0,10),PKW(pB0,12),PKW(pB0,14)};pw2=(u32x4){PKW(pB1,0),PKW(pB1,2),PKW(pB1,4),PKW(pB1,6)};pw3=(u32x4){PKW(pB1,8),PKW(pB1,10),PKW(pB1,12),PKW(pB1,14)};
    SBAR(); pv(o,vb0+sl_cur,PAF(0),PAF(1),PAF(2),PAF(3)); }
  #undef PKW
  #undef PAF
  #undef VFR
  #undef PIN
  #undef MX3
  #undef GAPA
  #undef GAPB
  #undef PREF
  #undef EX
  #undef VRD
  #undef KRD
  #undef STEP
  #undef ENDW
  {auto rr=__builtin_amdgcn_permlane32_swap(__float_as_uint(l_reg),__float_as_uint(l_reg),false,false);l_reg=__uint_as_float(rr[0])+__uint_as_float(rr[1]);}
  if(hi==0)wsf[32+r32]=l_reg;asm volatile("s_waitcnt lgkmcnt(0)":::"memory");
  float rli[16];
  #pragma unroll
  for(int r=0;r<16;++r)rli[r]=__builtin_amdgcn_rcpf(wsf[32+crow(r,hi)]);
  bf16*Ow=O+(rowbase+q0+wid*QBLK)*DM+h*D;
  { bf16*stg=(bf16*)(shm+LDS_OST)+wid*2048;
    #pragma unroll
    for(int r=0;r<16;++r){const int orow=crow(r,hi);
      #pragma unroll
      for(int d0=0;d0<2;++d0)stg[orow*64+d0*32+r32]=__float2bfloat16(o[d0][r]*rli[r]);}
    asm volatile("s_waitcnt lgkmcnt(0)":::"memory");
    #pragma unroll
    for(int i=0;i<4;++i){const int row=i*8+(lane>>3),ch=lane&7; const u32x4 v=*(const u32x4*)(stg+row*64+ch*8); ATTN_STORE16(Ow+(long)row*DM+ch*8,v);} }
  asm volatile("s_waitcnt lgkmcnt(0)\n\ts_barrier":::"memory");
  #undef DMA_K
  #undef DMA_V
  #undef CMASK
  #undef START
  #undef RESC
  #undef ROT
}
constexpr int ATTN_LDS_BYTES=LDS_BYTES;
struct AttnTensors { const bf16* Q; const bf16* K; const bf16* V; bf16* O; };
struct AttnUnit { int bh; int qb; };
struct StaticOrder {
  int vcu, G;
  __device__ __forceinline__ explicit StaticOrder(int grid,int block):vcu((grid%8==0)?(block%8)*(grid/8)+block/8:block),G(grid){}
  __device__ __forceinline__ bool next(int i,AttnUnit&u)const{
    if(G==256){ if(i>=8)return false; const int s=vcu&3; u.bh=vcu>>2; const int base=8*(i>>1); u.qb=(i&1)?base+7-s:base+s; return true; }
    const int L=i*G+vcu; if(L>=BATCH*NHEAD*NQB)return false; u.bh=L/NQB; u.qb=NQB-1-(L%NQB); return true; }
  __device__ __forceinline__ void a_ready(const AttnUnit&)const{}
  __device__ __forceinline__ void done(const AttnUnit&)const{}
};
constexpr float PRUNE_LOG2=40.0f;
template<int THRL=8> __device__ __forceinline__ void attn_phase_dyn(char*lds,const AttnTensors&T,const float*CB,const float*qg,const float*kg,unsigned*ctr){
  int tid=threadIdx.x; asm volatile("":"+v"(tid)); const int lane=tid&63;
  __attribute__((address_space(3))) int* sh=(__attribute__((address_space(3))) int*)(lds+LDS_BYTES+32768);
  float gq=fabsf(qg[lane]),gk=fabsf(kg[lane]);
  #pragma unroll
  for(int o=1;o<64;o<<=1){gq=fmaxf(gq,__shfl_xor(gq,o));gk=fmaxf(gk,__shfl_xor(gk,o));}
  const float thresh=2.0f*(8.25f*gq*gk*1.4426950408889634f)+PRUNE_LOG2;
  for(;;){
    __syncthreads();
    if(tid<64){ int ui=0; if(tid==0)ui=(int)atomicAdd(ctr,1u); ui=__shfl(ui,0);
      int t0=0;
      if(ui<BATCH*NHEAD*NQB){ const int qb=NQB-1-ui/(BATCH*NHEAD),bh=ui%(BATCH*NHEAD),q0=qb*QB,NT=(q0+QB)/KVBLK; const float*row=CB+(long)bh*SEQ; const float cq=row[q0];
        int cnt=0;
        #pragma unroll
        for(int j=0;j<2;++j){ const int t=lane+64*j; const bool p=(t<NT)&&(cq-row[t*64+63]>thresh); cnt+=__popcll(__ballot(p)); }
        t0=cnt&~1; if(t0>NT-4)t0=NT-4; }
      if(tid==0){sh[0]=ui;sh[1]=t0;} }
    __syncthreads();
    const int ui=sh[0],t0=sh[1];
    if(ui>=BATCH*NHEAD*NQB)break;
    const int qb=NQB-1-ui/(BATCH*NHEAD),bh=ui%(BATCH*NHEAD);
    { float*bl=(float*)(lds+LDS_BYTES); const f32x4_t*src=(const f32x4_t*)(CB+(long)bh*SEQ); const int lo=t0*16,hi4=(qb+1)*64;
      for(int j=lo+tid;j<hi4;j+=NW*64)((f32x4_t*)bl)[j]=src[j]; }
    __syncthreads();
    attn_unit<THRL>(bh/NHEAD,bh%NHEAD,qb,T.Q,T.K,T.V,T.O,lds,(lds_fptr)(lds+LDS_BYTES)+t0*64,t0);
  }
}
#undef BIAS
#undef PREFILL
#undef SBAR
#undef WAIT_BAR
}
#define LAS __attribute__((address_space(3)))
typedef unsigned short bfu;
typedef unsigned v4u __attribute__((ext_vector_type(4)));
typedef unsigned v2u __attribute__((ext_vector_type(2)));
typedef float f32x4 __attribute__((ext_vector_type(4)));
typedef float f32x2 __attribute__((ext_vector_type(2)));
typedef float f32x16 __attribute__((ext_vector_type(16)));
typedef short bf16x8 __attribute__((ext_vector_type(8)));
typedef __bf16 bf16x2_t __attribute__((ext_vector_type(2)));
constexpr int M = 32768, D = 1024, SEQ = 8192, NWV = 8, NTH = 512;
constexpr int EVEN_IN = 2576, EVEN_PAD = 2816, ODD_PAD = 3328, ODD_IN = 3088;
constexpr size_t MiB = 1u << 20;
constexpr size_t WS_SS = 0, WS_SSP = 1 * MiB, WS_LFT = 3 * MiB, WS_CB = 5 * MiB, WS_DEC = 7 * MiB, WS_USC = 7 * MiB + 512 * 1024, WS_BAR = 7 * MiB + 768 * 1024, WS_KEYS = 8 * MiB, WS_WINE = 9 * MiB, WS_WOUTE = 15 * MiB,
                 WS_WINO = 17 * MiB, WS_WOUTO = 24 * MiB, WS_WQ = 26 * MiB, WS_UV = 34 * MiB, WS_XB = 162 * MiB, WS_R1 = 226 * MiB, WS_R2 = 418 * MiB,
                 WS_EXP = 482 * MiB, WS_GATE = 490 * MiB, WS_END = 506 * MiB;
constexpr int LDS_BYTES = 147456;
constexpr float EPSF = 1e-6f;

__device__ __forceinline__ int tid_fresh() { int t = threadIdx.x; asm volatile("" : "+v"(t)); return t; }
__device__ __forceinline__ int bid_fresh() { int b = __builtin_amdgcn_workgroup_id_x(); asm volatile("" : "+s"(b)); return b; }
#define LDS_WAIT() asm volatile("s_waitcnt lgkmcnt(0)" ::: "memory")
__device__ __forceinline__ void lds_barrier() { asm volatile("s_waitcnt lgkmcnt(0)\n\ts_barrier" ::: "memory"); }
__device__ __forceinline__ float bf2f(unsigned u16) { return __uint_as_float(u16 << 16); }
__device__ __forceinline__ float bflo(unsigned w) { return __uint_as_float(w << 16); }
__device__ __forceinline__ float bfhi(unsigned w) { return __uint_as_float(w & 0xffff0000u); }
__device__ __forceinline__ unsigned pk2(float lo, float hi) { f32x2 v = {lo, hi}; bf16x2_t b = __builtin_convertvector(v, bf16x2_t); return __builtin_bit_cast(unsigned, b); }
__device__ __forceinline__ unsigned short f2bf(float f) { return (unsigned short)(pk2(f, 0.f) & 0xffffu); }
__device__ __forceinline__ float wave_sum(float v) {
#pragma unroll
    for (int o = 1; o < 64; o <<= 1) v += __shfl_xor(v, o);
    return v;
}
__device__ __forceinline__ float sigmoidf_(float x) { return __builtin_amdgcn_rcpf(1.0f + __builtin_amdgcn_exp2f(-1.4426950408889634f * x)); }
__device__ __forceinline__ float logsigf_(float z) { return fminf(z, 0.f) - 0.69314718056f * __builtin_amdgcn_logf(1.0f + __builtin_amdgcn_exp2f(-1.4426950408889634f * fabsf(z))); }
__device__ __forceinline__ int crow(int r, int hi) { return (r & 3) + 8 * (r >> 2) + 4 * hi; }

__device__ __forceinline__ void transpose_item(const float* W, const float* gain, int K, int N, bfu* WT, LAS float* scr, int item, int nblk, int lane) {
    const int kb = item / nblk, nb = item % nblk, k0 = 64 * kb, n0 = 32 * nb; const int n = n0 + (lane & 31); const bool ok = n < N;
#pragma unroll 8
    for (int i = 0; i < 32; ++i) { const int kk = 2 * i + (lane >> 5); float v = 0.f; if (ok) { v = W[(size_t)(k0 + kk) * N + n]; if (gain) v *= gain[k0 + kk]; } scr[kk * 33 + (lane & 31)] = v; }
    LDS_WAIT();
    const int c = lane & 7;
#pragma unroll
    for (int j = 0; j < 4; ++j) { const int nn = (lane >> 3) + 8 * j; const LAS float* s = scr + (8 * c) * 33 + nn;
        v4u o; o.x = pk2(s[0 * 33], s[1 * 33]); o.y = pk2(s[2 * 33], s[3 * 33]); o.z = pk2(s[4 * 33], s[5 * 33]); o.w = pk2(s[6 * 33], s[7 * 33]);
        *(v4u*)(WT + (size_t)(n0 + nn) * K + k0 + 8 * c) = o; }
    LDS_WAIT();
}
__device__ __forceinline__ void cvt8(const float* src, bfu* dst) {
    const f32x4 a = *(const f32x4*)src, b = *(const f32x4*)(src + 4);
    v4u o; o.x = pk2(a[0], a[1]); o.y = pk2(a[2], a[3]); o.z = pk2(b[0], b[1]); o.w = pk2(b[2], b[3]); *(v4u*)dst = o;
}
__device__ __forceinline__ void p0_prologue(const float* const* in, unsigned char* ws, LAS unsigned char* lds, int G) {
    const int tid = tid_fresh(), lane = tid & 63, wave = tid >> 6; const int gw = bid_fresh() * NWV + wave, NGW = G * NWV;
    LAS float* scr = (LAS float*)(lds + wave * 16384);
    for (int st = 0; st < 3; ++st) { const int kind = (wave & 1) ? st : (st + 1) % 3;
    if (kind == 0) {
    const int I0 = 16 * (EVEN_PAD / 32), I1 = 16 * 32, I2 = 16 * (ODD_PAD / 32), I3 = 16 * 32, I4 = 16 * 64, I5 = 16 * 64;
    const int NIT = I0 + I1 + I2 + I3 + I4 + I5;
    for (int it = gw; it < NIT; it += NGW) {
        int r = it;
        if (r < I0) { transpose_item(in[2], in[1], 1024, EVEN_IN, (bfu*)(ws + WS_WINE), scr, r, EVEN_PAD / 32, lane); continue; } r -= I0;
        if (r < I1) { transpose_item(in[10], nullptr, 1024, 1024, (bfu*)(ws + WS_WOUTE), scr, r, 32, lane); continue; } r -= I1;
        if (r < I2) { transpose_item(in[12], in[11], 1024, ODD_IN, (bfu*)(ws + WS_WINO), scr, r, ODD_PAD / 32, lane); continue; } r -= I2;
        if (r < I3) { transpose_item(in[16], nullptr, 1024, 1024, (bfu*)(ws + WS_WOUTO), scr, r, 32, lane); continue; } r -= I3;
        if (r < I4) { transpose_item(in[18], in[17], 1024, 2048, (bfu*)(ws + WS_WQ), scr, r, 64, lane); continue; } r -= I4;
        transpose_item(in[18] + (size_t)1024 * 2048, in[17] + 1024, 1024, 2048, (bfu*)(ws + WS_WQ + 4 * MiB), scr, r, 64, lane);
    }
    } else if (kind == 1) {
    const int gt = bid_fresh() * NTH + tid, NGT = G * NTH;
    for (int r = gw; r < 65536; r += NGW) { const int chunk = r >> 14, row = r & 16383;
        const float* src = ((chunk & 1) ? in[21] : in[20]) + (size_t)(chunk >> 1) * 16777216 + (size_t)row * 1024 + 16 * lane;
        f32x4 a[4]; float mx = 0.f;
#pragma unroll
        for (int q = 0; q < 4; ++q) { a[q] = *(const f32x4*)(src + 4 * q); mx = fmaxf(mx, fmaxf(fmaxf(fabsf(a[q][0]), fabsf(a[q][1])), fmaxf(fabsf(a[q][2]), fabsf(a[q][3])))); }
#pragma unroll
        for (int o = 1; o < 64; o <<= 1) mx = fmaxf(mx, __shfl_xor(mx, o));
        const float scale = (mx > 0.f) ? mx * (1.0f / 127.0f) : 1.0f, inv = 1.0f / scale; const int off = 0;
        v4u o;
#pragma unroll
        for (int q = 0; q < 4; ++q) { unsigned w = 0;
#pragma unroll
            for (int k = 0; k < 4; ++k) { const int qi = (int)__builtin_rintf(a[q][k] * inv) + off; w |= ((unsigned)qi & 0xffu) << (8 * k); }
            o[q] = w; }
        if (chunk & 1) *(v4u*)(ws + WS_UV + (size_t)chunk * 16777216 + ((size_t)(lane >> 3) * 16384 + row) * 128 + 16 * (lane & 7)) = o;
        else *(v4u*)(ws + WS_UV + (size_t)chunk * 16777216 + (size_t)row * 1024 + 16 * lane) = o;
        if (lane == 0) ((float*)(ws + WS_USC))[r] = scale; }
    for (int g = gt; g < 65536; g += NGT) cvt8(in[19] + (size_t)g * 8, (bfu*)(ws + WS_KEYS) + (size_t)g * 8);
    } else {
    for (int m = gw; m < M; m += NGW) { const f32x4* xr = (const f32x4*)(in[0] + (size_t)m * D) + lane; v2u* o8 = (v2u*)((bfu*)(ws + WS_XB) + (size_t)m * D) + lane; float s = 0.f;
#pragma unroll
        for (int j = 0; j < 4; ++j) { const f32x4 v = xr[64 * j]; s += (v[0] * v[0] + v[1] * v[1]) + (v[2] * v[2] + v[3] * v[3]); v2u o; o.x = pk2(v[0], v[1]); o.y = pk2(v[2], v[3]); o8[64 * j] = o; }
        s = wave_sum(s); if (lane == 0) ((float*)(ws + WS_SS))[m] = s;     } }
}
}
__device__ __forceinline__ float row_rstd16(const float* ss, int row) { return pg8::row_rstd<16>(ss, row); }
__device__ __forceinline__ void conv_unit(const bfu* P, const float* cw, const float* cb, const float* lng, const float* lnb, bfu* Y, LAS unsigned char* lds, int unit) {
    const int tid = tid_fresh(), lane = tid & 63, wave = tid >> 6, c = tid; const int row0 = unit * 32, tseq0 = row0 & (SEQ - 1);
    LAS float* U = (LAS float*)lds;
    float u[62];
#pragma unroll
    for (int i = 0; i < 62; ++i) { const int trel = i - 30; float v = 0.f;
        if (tseq0 + trel >= 0) { const bfu* pr = P + (size_t)(row0 + trel) * EVEN_IN; const float val = bf2f(pr[c]), gate = bf2f(pr[512 + c]); v = val * sigmoidf_(gate); }
        u[i] = v; }
    float w[31];
#pragma unroll
    for (int j = 0; j < 31; ++j) w[j] = cw[j * 512 + c];
    const float bias = cb[c];
#pragma unroll
    for (int i = 0; i < 32; ++i) { float a = bias;
#pragma unroll
        for (int j = 0; j < 31; ++j) a += w[j] * u[i + j];
        U[i * 512 + c] = a; }
    lds_barrier();
    const f32x4 g0 = *(const f32x4*)(lng + 8 * lane), g1 = *(const f32x4*)(lng + 8 * lane + 4), b0 = *(const f32x4*)(lnb + 8 * lane), b1 = *(const f32x4*)(lnb + 8 * lane + 4);
#pragma unroll
    for (int q = 0; q < 4; ++q) { const int i = wave * 4 + q; const f32x4 v0 = *(const LAS f32x4*)(U + i * 512 + 8 * lane), v1 = *(const LAS f32x4*)(U + i * 512 + 8 * lane + 4);
        const float mean = wave_sum((v0[0] + v0[1]) + (v0[2] + v0[3]) + (v1[0] + v1[1]) + (v1[2] + v1[3])) * (1.f / 512.f);
        const f32x4 d0 = v0 - mean, d1 = v1 - mean;
        const float var = wave_sum((d0[0] * d0[0] + d0[1] * d0[1]) + (d0[2] * d0[2] + d0[3] * d0[3]) + (d1[0] * d1[0] + d1[1] * d1[1]) + (d1[2] * d1[2] + d1[3] * d1[3])) * (1.f / 512.f);
        const float rstd = __builtin_amdgcn_rsqf(var + EPSF);
        f32x4 o0 = d0 * rstd * g0 + b0, o1 = d1 * rstd * g1 + b1;
#pragma unroll
        for (int k = 0; k < 4; ++k) { o0[k] = o0[k] * sigmoidf_(o0[k]); o1[k] = o1[k] * sigmoidf_(o1[k]); }
        v4u o; o.x = pk2(o0[0], o0[1]); o.y = pk2(o0[2], o0[3]); o.z = pk2(o1[0], o1[1]); o.w = pk2(o1[2], o1[3]);
        *(v4u*)(Y + (size_t)(row0 + i) * D + 8 * lane) = o; }
    lds_barrier();
}

constexpr int GL_GLR = 0, GL_TOT = 4096, GL_B = 6144, GL_KT = 22528, GL_VT = 31744, GL_Q = 50176, GL_K = 59392, GL_ST = 68608, GL_AT = 87040, GL_O = 96256;
constexpr int GLD = 72;
__device__ __forceinline__ void gla_decay(const bfu* P, const float* gw2, const float* gb, LAS unsigned char* lds, int row0, int h, float (&bl)[8], float& blast) {
    const int tid = tid_fresh(), lane = tid & 63, wave = tid >> 6;
    LAS float* GLR = (LAS float*)(lds + GL_GLR); LAS float* TOT = (LAS float*)(lds + GL_TOT);
    { const int idx = tid * 2, t = idx >> 4, j = idx & 15; const unsigned w = *(const unsigned*)(P + (size_t)(row0 + t) * EVEN_IN + 2560 + j); GLR[idx] = bflo(w); GLR[idx + 1] = bfhi(w); }
    float w2[16];
#pragma unroll
    for (int j = 0; j < 16; ++j) w2[j] = gw2[j * 256 + h * 64 + lane];
    const float gbv = gb[h * 64 + lane];
    lds_barrier();
    float run = 0.f;
#pragma unroll
    for (int i = 0; i < 8; ++i) { const int t = wave * 8 + i; float z = gbv;
#pragma unroll
        for (int j4 = 0; j4 < 4; ++j4) { const f32x4 g = *(const LAS f32x4*)(GLR + t * 16 + 4 * j4); z += g[0] * w2[4 * j4] + g[1] * w2[4 * j4 + 1] + g[2] * w2[4 * j4 + 2] + g[3] * w2[4 * j4 + 3]; }
        run += logsigf_(z) * (1.0f / 16.0f); bl[i] = run; }
    TOT[wave * 64 + lane] = run;
    lds_barrier();
    float off = 0.f, tot = 0.f;
#pragma unroll
    for (int s = 0; s < 8; ++s) { const float v = TOT[s * 64 + lane]; if (s < wave) off += v; tot += v; }
#pragma unroll
    for (int i = 0; i < 8; ++i) bl[i] += off;
    blast = tot;
}
struct VtRaw { unsigned short e[2][8]; };
__device__ __forceinline__ void gla_load_vt(VtRaw& r, const bfu* P, int row0, int h, int tid) {
#pragma unroll
    for (int q = 0; q < 2; ++q) { const int p = tid + q * 512, vv = p & 127, sg = p >> 7; const bfu* src = P + (size_t)(row0 + 8 * sg) * EVEN_IN + 1536 + h * 128 + vv;
#pragma unroll
        for (int i = 0; i < 8; ++i) r.e[q][i] = src[(size_t)i * EVEN_IN]; }
}
__device__ __forceinline__ void gla_store_vt(const VtRaw& r, LAS unsigned char* lds, int tid) {
#pragma unroll
    for (int q = 0; q < 2; ++q) { const int p = tid + q * 512, vv = p & 127, sg = p >> 7; const unsigned short* e = r.e[q];
        v4u o; o.x = e[0] | ((unsigned)e[1] << 16); o.y = e[2] | ((unsigned)e[3] << 16); o.z = e[4] | ((unsigned)e[5] << 16); o.w = e[6] | ((unsigned)e[7] << 16);
        *(LAS v4u*)(lds + GL_VT + (vv * GLD + 8 * sg) * 2) = o; }
}
__device__ __forceinline__ bf16x8 lds_frag(LAS unsigned char* lds, int base, int row, int kofs) { return *(const LAS bf16x8*)(lds + base + (row * GLD + kofs) * 2); }

__device__ __forceinline__ void gla_g1_unit(const bfu* P, const float* gw2, const float* gb, float* ST, float* DEC, LAS unsigned char* lds, int ug) {
    const int tid = tid_fresh(), lane = tid & 63, wave = tid >> 6, r32 = lane & 31, hi = lane >> 5;
    const int bh = ug >> 7, n = ug & 127, b = bh >> 2, h = bh & 3, row0 = b * SEQ + 64 * n;
    VtRaw vraw; gla_load_vt(vraw, P, row0, h, tid); unsigned short kraw[8];
#pragma unroll
    for (int i = 0; i < 8; ++i) kraw[i] = P[(size_t)(row0 + wave * 8 + i) * EVEN_IN + 1280 + h * 64 + lane];
    float bl[8], blast; gla_decay(P, gw2, gb, lds, row0, h, bl, blast);
    { unsigned short e[8];
#pragma unroll
      for (int i = 0; i < 8; ++i) { const float kv = bf2f(kraw[i]); e[i] = f2bf(kv * __expf(blast - bl[i])); }
      v4u o; o.x = e[0] | ((unsigned)e[1] << 16); o.y = e[2] | ((unsigned)e[3] << 16); o.z = e[4] | ((unsigned)e[5] << 16); o.w = e[6] | ((unsigned)e[7] << 16);
      *(LAS v4u*)(lds + GL_KT + (lane * GLD + 8 * wave) * 2) = o;
      if (wave == 0) DEC[(size_t)ug * 64 + lane] = __expf(blast); }
    gla_store_vt(vraw, lds, tid);
    lds_barrier();
    const int vb = wave >> 1, kb = wave & 1; f32x16 acc = {};
#pragma unroll
    for (int ks = 0; ks < 4; ++ks) acc = __builtin_amdgcn_mfma_f32_32x32x16_bf16(lds_frag(lds, GL_VT, vb * 32 + r32, 16 * ks + 8 * hi), lds_frag(lds, GL_KT, kb * 32 + r32, 16 * ks + 8 * hi), acc, 0, 0, 0);
    float* dst = ST + (size_t)ug * 8192 + kb * 32 + r32;
#pragma unroll
    for (int r = 0; r < 16; ++r) dst[(vb * 32 + crow(r, hi)) * 64] = acc[r];
    lds_barrier();
}
__device__ __forceinline__ void gla_g2(float* ST, const float* DEC, int G) {
    for (int gid = bid_fresh() * NTH + tid_fresh(); gid < 16 * 8192; gid += G * NTH) { const int bh = gid >> 13, e = gid & 8191, kk = e & 63;
        float* p = ST + (size_t)bh * 128 * 8192 + e; const float* d = DEC + (size_t)bh * 128 * 64 + kk; float s = 0.f;
        for (int n0 = 0; n0 < 128; n0 += 8) { float loc[8], dc[8];
#pragma unroll
            for (int i = 0; i < 8; ++i) { loc[i] = p[(size_t)(n0 + i) * 8192]; dc[i] = d[(n0 + i) * 64]; }
#pragma unroll
            for (int i = 0; i < 8; ++i) { p[(size_t)(n0 + i) * 8192] = s; s = s * dc[i] + loc[i]; } } }
}
__device__ __forceinline__ void gla_g3_unit(const bfu* P, const float* gw2, const float* gb, const float* ng, const float* ST, bfu* Y, LAS unsigned char* lds, int ug) {
    const int tid = tid_fresh(), lane = tid & 63, wave = tid >> 6, r32 = lane & 31, hi = lane >> 5;
    const int bh = ug >> 7, n = ug & 127, b = bh >> 2, h = bh & 3, row0 = b * SEQ + 64 * n;
    VtRaw vraw; gla_load_vt(vraw, P, row0, h, tid); unsigned short qraw[8], kraw[8]; unsigned rraw[8]; f32x4 sraw[2][2];
#pragma unroll
    for (int i = 0; i < 8; ++i) { const int t = wave * 8 + i; const bfu* pr = P + (size_t)(row0 + t) * EVEN_IN + h * 64 + lane; qraw[i] = pr[1024]; kraw[i] = pr[1280];
        rraw[i] = *(const unsigned*)(P + (size_t)(row0 + t) * EVEN_IN + 2048 + h * 128 + 2 * lane); }
#pragma unroll
    for (int q = 0; q < 2; ++q) { const int gq = tid + q * 512, vv = gq >> 3, k8 = (gq & 7) * 8; const float* src = ST + (size_t)ug * 8192 + vv * 64 + k8; sraw[q][0] = *(const f32x4*)src; sraw[q][1] = *(const f32x4*)(src + 4); }
    float bl[8], blast; gla_decay(P, gw2, gb, lds, row0, h, bl, blast);
#pragma unroll
    for (int i = 0; i < 8; ++i) { const int t = wave * 8 + i;
        const float qv = bf2f(qraw[i]) * 0.125f * __expf(bl[i]), kv = bf2f(kraw[i]) * __expf(-bl[i]);
        *(LAS unsigned short*)(lds + GL_Q + (t * GLD + lane) * 2) = f2bf(qv); *(LAS unsigned short*)(lds + GL_K + (t * GLD + lane) * 2) = f2bf(kv); }
    gla_store_vt(vraw, lds, tid);
#pragma unroll
    for (int q = 0; q < 2; ++q) { const int g = tid + q * 512, vv = g >> 3, k8 = (g & 7) * 8;
        const f32x4 a = sraw[q][0], c = sraw[q][1]; v4u o; o.x = pk2(a[0], a[1]); o.y = pk2(a[2], a[3]); o.z = pk2(c[0], c[1]); o.w = pk2(c[2], c[3]);
        *(LAS v4u*)(lds + GL_ST + (vv * GLD + k8) * 2) = o; }
    lds_barrier();
    if (wave < 4) { const int tb = wave >> 1, sb = wave & 1; f32x16 acc = {};
        if (sb <= tb) {
#pragma unroll
            for (int ks = 0; ks < 4; ++ks) acc = __builtin_amdgcn_mfma_f32_32x32x16_bf16(lds_frag(lds, GL_Q, tb * 32 + r32, 16 * ks + 8 * hi), lds_frag(lds, GL_K, sb * 32 + r32, 16 * ks + 8 * hi), acc, 0, 0, 0);
        }
        const int s = sb * 32 + r32;
#pragma unroll
        for (int r = 0; r < 16; ++r) { const int t = tb * 32 + crow(r, hi); const float v = (s <= t) ? acc[r] : 0.f; *(LAS unsigned short*)(lds + GL_AT + (t * GLD + s) * 2) = f2bf(v); } }
    lds_barrier();
    { const int tb = wave >> 2, vb = wave & 3; f32x16 acc = {};
#pragma unroll
      for (int ks = 0; ks < 4; ++ks) acc = __builtin_amdgcn_mfma_f32_32x32x16_bf16(lds_frag(lds, GL_Q, tb * 32 + r32, 16 * ks + 8 * hi), lds_frag(lds, GL_ST, vb * 32 + r32, 16 * ks + 8 * hi), acc, 0, 0, 0);
#pragma unroll
      for (int ks = 0; ks < 4; ++ks) acc = __builtin_amdgcn_mfma_f32_32x32x16_bf16(lds_frag(lds, GL_AT, tb * 32 + r32, 16 * ks + 8 * hi), lds_frag(lds, GL_VT, vb * 32 + r32, 16 * ks + 8 * hi), acc, 0, 0, 0);
      LAS float* O = (LAS float*)(lds + GL_O);
#pragma unroll
      for (int r = 0; r < 16; ++r) O[(tb * 32 + crow(r, hi)) * 132 + vb * 32 + r32] = acc[r]; }
    lds_barrier();
    { const LAS float* O = (const LAS float*)(lds + GL_O); const f32x2 g = *(const f32x2*)(ng + 2 * lane);
#pragma unroll
      for (int i = 0; i < 8; ++i) { const int t = wave * 8 + i; const f32x2 o = *(const LAS f32x2*)(O + t * 132 + 2 * lane);
          const float rstd = __builtin_amdgcn_rsqf(wave_sum(o[0] * o[0] + o[1] * o[1]) * (1.f / 128.f) + EPSF);
          const unsigned rw = rraw[i]; const float r0 = bflo(rw), r1 = bfhi(rw);
          const float y0 = o[0] * rstd * g[0] * (r0 * sigmoidf_(r0)), y1 = o[1] * rstd * g[1] * (r1 * sigmoidf_(r1));
          *(unsigned*)(Y + (size_t)(row0 + t) * D + 512 + h * 128 + 2 * lane) = pk2(y0, y1); } }
    lds_barrier();
}

__device__ __forceinline__ float pair_max(float m) { auto rr = __builtin_amdgcn_permlane32_swap(__float_as_uint(m), __float_as_uint(m), false, false); return fmaxf(__uint_as_float(rr[0]), __uint_as_float(rr[1])); }
constexpr int TK_PITCH = 272;
__device__ __forceinline__ void top16_of_scores(const bfu* qp, const LAS unsigned char* kl, int hi, float (&top)[16]) {
    f32x16 acc[4] = {};
    bf16x8 bq[8];
#pragma unroll
    for (int ks = 0; ks < 8; ++ks) bq[ks] = *(const bf16x8*)(qp + 16 * ks);
#pragma unroll
    for (int ks = 0; ks < 8; ++ks) { bf16x8 ak[4];
#pragma unroll
        for (int kb = 0; kb < 4; ++kb) ak[kb] = *(const LAS bf16x8*)(kl + kb * 32 * TK_PITCH + 32 * ks);
#pragma unroll
        for (int kb = 0; kb < 4; ++kb) acc[kb] = __builtin_amdgcn_mfma_f32_32x32x16_bf16(ak[kb], bq[ks], acc[kb], 0, 0, 0);
        if (ks & 1) asm volatile("" ::: "memory"); }
    float val[64];
#pragma unroll
    for (int kb = 0; kb < 4; ++kb)
#pragma unroll
        for (int r = 0; r < 16; ++r) { const unsigned idx = 32 * kb + crow(r, hi); val[kb * 16 + r] = __uint_as_float((__float_as_uint(acc[kb][r]) & ~127u) | idx); }
#define CE_D(a,b) do{ const float hi_=fmaxf(a,b), lo_=fminf(a,b); a=hi_; b=lo_; }while(0)
    {
        CE_D(val[0],val[1]);
        CE_D(val[3],val[2]);
        CE_D(val[4],val[5]);
        CE_D(val[7],val[6]);
        CE_D(val[8],val[9]);
        CE_D(val[11],val[10]);
        CE_D(val[12],val[13]);
        CE_D(val[15],val[14]);
        CE_D(val[0],val[2]);
        CE_D(val[1],val[3]);
        CE_D(val[6],val[4]);
        CE_D(val[7],val[5]);
        CE_D(val[8],val[10]);
        CE_D(val[9],val[11]);
        CE_D(val[14],val[12]);
        CE_D(val[15],val[13]);
        CE_D(val[0],val[1]);
        CE_D(val[2],val[3]);
        CE_D(val[5],val[4]);
        CE_D(val[7],val[6]);
        CE_D(val[8],val[9]);
        CE_D(val[10],val[11]);
        CE_D(val[13],val[12]);
        CE_D(val[15],val[14]);
        CE_D(val[0],val[4]);
        CE_D(val[1],val[5]);
        CE_D(val[2],val[6]);
        CE_D(val[3],val[7]);
        CE_D(val[12],val[8]);
        CE_D(val[13],val[9]);
        CE_D(val[14],val[10]);
        CE_D(val[15],val[11]);
        CE_D(val[0],val[2]);
        CE_D(val[1],val[3]);
        CE_D(val[4],val[6]);
        CE_D(val[5],val[7]);
        CE_D(val[10],val[8]);
        CE_D(val[11],val[9]);
        CE_D(val[14],val[12]);
        CE_D(val[15],val[13]);
        CE_D(val[0],val[1]);
        CE_D(val[2],val[3]);
        CE_D(val[4],val[5]);
        CE_D(val[6],val[7]);
        CE_D(val[9],val[8]);
        CE_D(val[11],val[10]);
        CE_D(val[13],val[12]);
        CE_D(val[15],val[14]);
        CE_D(val[0],val[8]);
        CE_D(val[1],val[9]);
        CE_D(val[2],val[10]);
        CE_D(val[3],val[11]);
        CE_D(val[4],val[12]);
        CE_D(val[5],val[13]);
        CE_D(val[6],val[14]);
        CE_D(val[7],val[15]);
        CE_D(val[0],val[4]);
        CE_D(val[1],val[5]);
        CE_D(val[2],val[6]);
        CE_D(val[3],val[7]);
        CE_D(val[8],val[12]);
        CE_D(val[9],val[13]);
        CE_D(val[10],val[14]);
        CE_D(val[11],val[15]);
        CE_D(val[0],val[2]);
        CE_D(val[1],val[3]);
        CE_D(val[4],val[6]);
        CE_D(val[5],val[7]);
        CE_D(val[8],val[10]);
        CE_D(val[9],val[11]);
        CE_D(val[12],val[14]);
        CE_D(val[13],val[15]);
        CE_D(val[0],val[1]);
        CE_D(val[2],val[3]);
        CE_D(val[4],val[5]);
        CE_D(val[6],val[7]);
        CE_D(val[8],val[9]);
        CE_D(val[10],val[11]);
        CE_D(val[12],val[13]);
        CE_D(val[14],val[15]);
        CE_D(val[16],val[17]);
        CE_D(val[19],val[18]);
        CE_D(val[20],val[21]);
        CE_D(val[23],val[22]);
        CE_D(val[24],val[25]);
        CE_D(val[27],val[26]);
        CE_D(val[28],val[29]);
        CE_D(val[31],val[30]);
        CE_D(val[16],val[18]);
        CE_D(val[17],val[19]);
        CE_D(val[22],val[20]);
        CE_D(val[23],val[21]);
        CE_D(val[24],val[26]);
        CE_D(val[25],val[27]);
        CE_D(val[30],val[28]);
        CE_D(val[31],val[29]);
        CE_D(val[16],val[17]);
        CE_D(val[18],val[19]);
        CE_D(val[21],val[20]);
        CE_D(val[23],val[22]);
        CE_D(val[24],val[25]);
        CE_D(val[26],val[27]);
        CE_D(val[29],val[28]);
        CE_D(val[31],val[30]);
        CE_D(val[16],val[20]);
        CE_D(val[17],val[21]);
        CE_D(val[18],val[22]);
        CE_D(val[19],val[23]);
        CE_D(val[28],val[24]);
        CE_D(val[29],val[25]);
        CE_D(val[30],val[26]);
        CE_D(val[31],val[27]);
        CE_D(val[16],val[18]);
        CE_D(val[17],val[19]);
        CE_D(val[20],val[22]);
        CE_D(val[21],val[23]);
        CE_D(val[26],val[24]);
        CE_D(val[27],val[25]);
        CE_D(val[30],val[28]);
        CE_D(val[31],val[29]);
        CE_D(val[16],val[17]);
        CE_D(val[18],val[19]);
        CE_D(val[20],val[21]);
        CE_D(val[22],val[23]);
        CE_D(val[25],val[24]);
        CE_D(val[27],val[26]);
        CE_D(val[29],val[28]);
        CE_D(val[31],val[30]);
        CE_D(val[16],val[24]);
        CE_D(val[17],val[25]);
        CE_D(val[18],val[26]);
        CE_D(val[19],val[27]);
        CE_D(val[20],val[28]);
        CE_D(val[21],val[29]);
        CE_D(val[22],val[30]);
        CE_D(val[23],val[31]);
        CE_D(val[16],val[20]);
        CE_D(val[17],val[21]);
        CE_D(val[18],val[22]);
        CE_D(val[19],val[23]);
        CE_D(val[24],val[28]);
        CE_D(val[25],val[29]);
        CE_D(val[26],val[30]);
        CE_D(val[27],val[31]);
        CE_D(val[16],val[18]);
        CE_D(val[17],val[19]);
        CE_D(val[20],val[22]);
        CE_D(val[21],val[23]);
        CE_D(val[24],val[26]);
        CE_D(val[25],val[27]);
        CE_D(val[28],val[30]);
        CE_D(val[29],val[31]);
        CE_D(val[16],val[17]);
        CE_D(val[18],val[19]);
        CE_D(val[20],val[21]);
        CE_D(val[22],val[23]);
        CE_D(val[24],val[25]);
        CE_D(val[26],val[27]);
        CE_D(val[28],val[29]);
        CE_D(val[30],val[31]);
        CE_D(val[32],val[33]);
        CE_D(val[35],val[34]);
        CE_D(val[36],val[37]);
        CE_D(val[39],val[38]);
        CE_D(val[40],val[41]);
        CE_D(val[43],val[42]);
        CE_D(val[44],val[45]);
        CE_D(val[47],val[46]);
        CE_D(val[32],val[34]);
        CE_D(val[33],val[35]);
        CE_D(val[38],val[36]);
        CE_D(val[39],val[37]);
        CE_D(val[40],val[42]);
        CE_D(val[41],val[43]);
        CE_D(val[46],val[44]);
        CE_D(val[47],val[45]);
        CE_D(val[32],val[33]);
        CE_D(val[34],val[35]);
        CE_D(val[37],val[36]);
        CE_D(val[39],val[38]);
        CE_D(val[40],val[41]);
        CE_D(val[42],val[43]);
        CE_D(val[45],val[44]);
        CE_D(val[47],val[46]);
        CE_D(val[32],val[36]);
        CE_D(val[33],val[37]);
        CE_D(val[34],val[38]);
        CE_D(val[35],val[39]);
        CE_D(val[44],val[40]);
        CE_D(val[45],val[41]);
        CE_D(val[46],val[42]);
        CE_D(val[47],val[43]);
        CE_D(val[32],val[34]);
        CE_D(val[33],val[35]);
        CE_D(val[36],val[38]);
        CE_D(val[37],val[39]);
        CE_D(val[42],val[40]);
        CE_D(val[43],val[41]);
        CE_D(val[46],val[44]);
        CE_D(val[47],val[45]);
        CE_D(val[32],val[33]);
        CE_D(val[34],val[35]);
        CE_D(val[36],val[37]);
        CE_D(val[38],val[39]);
        CE_D(val[41],val[40]);
        CE_D(val[43],val[42]);
        CE_D(val[45],val[44]);
        CE_D(val[47],val[46]);
        CE_D(val[32],val[40]);
        CE_D(val[33],val[41]);
        CE_D(val[34],val[42]);
        CE_D(val[35],val[43]);
        CE_D(val[36],val[44]);
        CE_D(val[37],val[45]);
        CE_D(val[38],val[46]);
        CE_D(val[39],val[47]);
        CE_D(val[32],val[36]);
        CE_D(val[33],val[37]);
        CE_D(val[34],val[38]);
        CE_D(val[35],val[39]);
        CE_D(val[40],val[44]);
        CE_D(val[41],val[45]);
        CE_D(val[42],val[46]);
        CE_D(val[43],val[47]);
        CE_D(val[32],val[34]);
        CE_D(val[33],val[35]);
        CE_D(val[36],val[38]);
        CE_D(val[37],val[39]);
        CE_D(val[40],val[42]);
        CE_D(val[41],val[43]);
        CE_D(val[44],val[46]);
        CE_D(val[45],val[47]);
        CE_D(val[32],val[33]);
        CE_D(val[34],val[35]);
        CE_D(val[36],val[37]);
        CE_D(val[38],val[39]);
        CE_D(val[40],val[41]);
        CE_D(val[42],val[43]);
        CE_D(val[44],val[45]);
        CE_D(val[46],val[47]);
        CE_D(val[48],val[49]);
        CE_D(val[51],val[50]);
        CE_D(val[52],val[53]);
        CE_D(val[55],val[54]);
        CE_D(val[56],val[57]);
        CE_D(val[59],val[58]);
        CE_D(val[60],val[61]);
        CE_D(val[63],val[62]);
        CE_D(val[48],val[50]);
        CE_D(val[49],val[51]);
        CE_D(val[54],val[52]);
        CE_D(val[55],val[53]);
        CE_D(val[56],val[58]);
        CE_D(val[57],val[59]);
        CE_D(val[62],val[60]);
        CE_D(val[63],val[61]);
        CE_D(val[48],val[49]);
        CE_D(val[50],val[51]);
        CE_D(val[53],val[52]);
        CE_D(val[55],val[54]);
        CE_D(val[56],val[57]);
        CE_D(val[58],val[59]);
        CE_D(val[61],val[60]);
        CE_D(val[63],val[62]);
        CE_D(val[48],val[52]);
        CE_D(val[49],val[53]);
        CE_D(val[50],val[54]);
        CE_D(val[51],val[55]);
        CE_D(val[60],val[56]);
        CE_D(val[61],val[57]);
        CE_D(val[62],val[58]);
        CE_D(val[63],val[59]);
        CE_D(val[48],val[50]);
        CE_D(val[49],val[51]);
        CE_D(val[52],val[54]);
        CE_D(val[53],val[55]);
        CE_D(val[58],val[56]);
        CE_D(val[59],val[57]);
        CE_D(val[62],val[60]);
        CE_D(val[63],val[61]);
        CE_D(val[48],val[49]);
        CE_D(val[50],val[51]);
        CE_D(val[52],val[53]);
        CE_D(val[54],val[55]);
        CE_D(val[57],val[56]);
        CE_D(val[59],val[58]);
        CE_D(val[61],val[60]);
        CE_D(val[63],val[62]);
        CE_D(val[48],val[56]);
        CE_D(val[49],val[57]);
        CE_D(val[50],val[58]);
        CE_D(val[51],val[59]);
        CE_D(val[52],val[60]);
        CE_D(val[53],val[61]);
        CE_D(val[54],val[62]);
        CE_D(val[55],val[63]);
        CE_D(val[48],val[52]);
        CE_D(val[49],val[53]);
        CE_D(val[50],val[54]);
        CE_D(val[51],val[55]);
        CE_D(val[56],val[60]);
        CE_D(val[57],val[61]);
        CE_D(val[58],val[62]);
        CE_D(val[59],val[63]);
        CE_D(val[48],val[50]);
        CE_D(val[49],val[51]);
        CE_D(val[52],val[54]);
        CE_D(val[53],val[55]);
        CE_D(val[56],val[58]);
        CE_D(val[57],val[59]);
        CE_D(val[60],val[62]);
        CE_D(val[61],val[63]);
        CE_D(val[48],val[49]);
        CE_D(val[50],val[51]);
        CE_D(val[52],val[53]);
        CE_D(val[54],val[55]);
        CE_D(val[56],val[57]);
        CE_D(val[58],val[59]);
        CE_D(val[60],val[61]);
        CE_D(val[62],val[63]);
        val[0]=fmaxf(val[0],val[31]);
        val[1]=fmaxf(val[1],val[30]);
        val[2]=fmaxf(val[2],val[29]);
        val[3]=fmaxf(val[3],val[28]);
        val[4]=fmaxf(val[4],val[27]);
        val[5]=fmaxf(val[5],val[26]);
        val[6]=fmaxf(val[6],val[25]);
        val[7]=fmaxf(val[7],val[24]);
        val[8]=fmaxf(val[8],val[23]);
        val[9]=fmaxf(val[9],val[22]);
        val[10]=fmaxf(val[10],val[21]);
        val[11]=fmaxf(val[11],val[20]);
        val[12]=fmaxf(val[12],val[19]);
        val[13]=fmaxf(val[13],val[18]);
        val[14]=fmaxf(val[14],val[17]);
        val[15]=fmaxf(val[15],val[16]);
        CE_D(val[0],val[8]);
        CE_D(val[1],val[9]);
        CE_D(val[2],val[10]);
        CE_D(val[3],val[11]);
        CE_D(val[4],val[12]);
        CE_D(val[5],val[13]);
        CE_D(val[6],val[14]);
        CE_D(val[7],val[15]);
        CE_D(val[0],val[4]);
        CE_D(val[1],val[5]);
        CE_D(val[2],val[6]);
        CE_D(val[3],val[7]);
        CE_D(val[8],val[12]);
        CE_D(val[9],val[13]);
        CE_D(val[10],val[14]);
        CE_D(val[11],val[15]);
        CE_D(val[0],val[2]);
        CE_D(val[1],val[3]);
        CE_D(val[4],val[6]);
        CE_D(val[5],val[7]);
        CE_D(val[8],val[10]);
        CE_D(val[9],val[11]);
        CE_D(val[12],val[14]);
        CE_D(val[13],val[15]);
        CE_D(val[0],val[1]);
        CE_D(val[2],val[3]);
        CE_D(val[4],val[5]);
        CE_D(val[6],val[7]);
        CE_D(val[8],val[9]);
        CE_D(val[10],val[11]);
        CE_D(val[12],val[13]);
        CE_D(val[14],val[15]);
        val[32]=fmaxf(val[32],val[63]);
        val[33]=fmaxf(val[33],val[62]);
        val[34]=fmaxf(val[34],val[61]);
        val[35]=fmaxf(val[35],val[60]);
        val[36]=fmaxf(val[36],val[59]);
        val[37]=fmaxf(val[37],val[58]);
        val[38]=fmaxf(val[38],val[57]);
        val[39]=fmaxf(val[39],val[56]);
        val[40]=fmaxf(val[40],val[55]);
        val[41]=fmaxf(val[41],val[54]);
        val[42]=fmaxf(val[42],val[53]);
        val[43]=fmaxf(val[43],val[52]);
        val[44]=fmaxf(val[44],val[51]);
        val[45]=fmaxf(val[45],val[50]);
        val[46]=fmaxf(val[46],val[49]);
        val[47]=fmaxf(val[47],val[48]);
        CE_D(val[32],val[40]);
        CE_D(val[33],val[41]);
        CE_D(val[34],val[42]);
        CE_D(val[35],val[43]);
        CE_D(val[36],val[44]);
        CE_D(val[37],val[45]);
        CE_D(val[38],val[46]);
        CE_D(val[39],val[47]);
        CE_D(val[32],val[36]);
        CE_D(val[33],val[37]);
        CE_D(val[34],val[38]);
        CE_D(val[35],val[39]);
        CE_D(val[40],val[44]);
        CE_D(val[41],val[45]);
        CE_D(val[42],val[46]);
        CE_D(val[43],val[47]);
        CE_D(val[32],val[34]);
        CE_D(val[33],val[35]);
        CE_D(val[36],val[38]);
        CE_D(val[37],val[39]);
        CE_D(val[40],val[42]);
        CE_D(val[41],val[43]);
        CE_D(val[44],val[46]);
        CE_D(val[45],val[47]);
        CE_D(val[32],val[33]);
        CE_D(val[34],val[35]);
        CE_D(val[36],val[37]);
        CE_D(val[38],val[39]);
        CE_D(val[40],val[41]);
        CE_D(val[42],val[43]);
        CE_D(val[44],val[45]);
        CE_D(val[46],val[47]);
        val[0]=fmaxf(val[0],val[47]);
        val[1]=fmaxf(val[1],val[46]);
        val[2]=fmaxf(val[2],val[45]);
        val[3]=fmaxf(val[3],val[44]);
        val[4]=fmaxf(val[4],val[43]);
        val[5]=fmaxf(val[5],val[42]);
        val[6]=fmaxf(val[6],val[41]);
        val[7]=fmaxf(val[7],val[40]);
        val[8]=fmaxf(val[8],val[39]);
        val[9]=fmaxf(val[9],val[38]);
        val[10]=fmaxf(val[10],val[37]);
        val[11]=fmaxf(val[11],val[36]);
        val[12]=fmaxf(val[12],val[35]);
        val[13]=fmaxf(val[13],val[34]);
        val[14]=fmaxf(val[14],val[33]);
        val[15]=fmaxf(val[15],val[32]);
        CE_D(val[0],val[8]);
        CE_D(val[1],val[9]);
        CE_D(val[2],val[10]);
        CE_D(val[3],val[11]);
        CE_D(val[4],val[12]);
        CE_D(val[5],val[13]);
        CE_D(val[6],val[14]);
        CE_D(val[7],val[15]);
        CE_D(val[0],val[4]);
        CE_D(val[1],val[5]);
        CE_D(val[2],val[6]);
        CE_D(val[3],val[7]);
        CE_D(val[8],val[12]);
        CE_D(val[9],val[13]);
        CE_D(val[10],val[14]);
        CE_D(val[11],val[15]);
        CE_D(val[0],val[2]);
        CE_D(val[1],val[3]);
        CE_D(val[4],val[6]);
        CE_D(val[5],val[7]);
        CE_D(val[8],val[10]);
        CE_D(val[9],val[11]);
        CE_D(val[12],val[14]);
        CE_D(val[13],val[15]);
        CE_D(val[0],val[1]);
        CE_D(val[2],val[3]);
        CE_D(val[4],val[5]);
        CE_D(val[6],val[7]);
        CE_D(val[8],val[9]);
        CE_D(val[10],val[11]);
        CE_D(val[12],val[13]);
        CE_D(val[14],val[15]);
        { auto r_=__builtin_amdgcn_permlane32_swap(__float_as_uint(val[15]),__float_as_uint(val[15]),false,false); const float p_=__uint_as_float(hi?r_[0]:r_[1]); top[0]=fmaxf(val[0],p_); }
        { auto r_=__builtin_amdgcn_permlane32_swap(__float_as_uint(val[14]),__float_as_uint(val[14]),false,false); const float p_=__uint_as_float(hi?r_[0]:r_[1]); top[1]=fmaxf(val[1],p_); }
        { auto r_=__builtin_amdgcn_permlane32_swap(__float_as_uint(val[13]),__float_as_uint(val[13]),false,false); const float p_=__uint_as_float(hi?r_[0]:r_[1]); top[2]=fmaxf(val[2],p_); }
        { auto r_=__builtin_amdgcn_permlane32_swap(__float_as_uint(val[12]),__float_as_uint(val[12]),false,false); const float p_=__uint_as_float(hi?r_[0]:r_[1]); top[3]=fmaxf(val[3],p_); }
        { auto r_=__builtin_amdgcn_permlane32_swap(__float_as_uint(val[11]),__float_as_uint(val[11]),false,false); const float p_=__uint_as_float(hi?r_[0]:r_[1]); top[4]=fmaxf(val[4],p_); }
        { auto r_=__builtin_amdgcn_permlane32_swap(__float_as_uint(val[10]),__float_as_uint(val[10]),false,false); const float p_=__uint_as_float(hi?r_[0]:r_[1]); top[5]=fmaxf(val[5],p_); }
        { auto r_=__builtin_amdgcn_permlane32_swap(__float_as_uint(val[9]),__float_as_uint(val[9]),false,false); const float p_=__uint_as_float(hi?r_[0]:r_[1]); top[6]=fmaxf(val[6],p_); }
        { auto r_=__builtin_amdgcn_permlane32_swap(__float_as_uint(val[8]),__float_as_uint(val[8]),false,false); const float p_=__uint_as_float(hi?r_[0]:r_[1]); top[7]=fmaxf(val[7],p_); }
        { auto r_=__builtin_amdgcn_permlane32_swap(__float_as_uint(val[7]),__float_as_uint(val[7]),false,false); const float p_=__uint_as_float(hi?r_[0]:r_[1]); top[8]=fmaxf(val[8],p_); }
        { auto r_=__builtin_amdgcn_permlane32_swap(__float_as_uint(val[6]),__float_as_uint(val[6]),false,false); const float p_=__uint_as_float(hi?r_[0]:r_[1]); top[9]=fmaxf(val[9],p_); }
        { auto r_=__builtin_amdgcn_permlane32_swap(__float_as_uint(val[5]),__float_as_uint(val[5]),false,false); const float p_=__uint_as_float(hi?r_[0]:r_[1]); top[10]=fmaxf(val[10],p_); }
        { auto r_=__builtin_amdgcn_permlane32_swap(__float_as_uint(val[4]),__float_as_uint(val[4]),false,false); const float p_=__uint_as_float(hi?r_[0]:r_[1]); top[11]=fmaxf(val[11],p_); }
        { auto r_=__builtin_amdgcn_permlane32_swap(__float_as_uint(val[3]),__float_as_uint(val[3]),false,false); const float p_=__uint_as_float(hi?r_[0]:r_[1]); top[12]=fmaxf(val[12],p_); }
        { auto r_=__builtin_amdgcn_permlane32_swap(__float_as_uint(val[2]),__float_as_uint(val[2]),false,false); const float p_=__uint_as_float(hi?r_[0]:r_[1]); top[13]=fmaxf(val[13],p_); }
        { auto r_=__builtin_amdgcn_permlane32_swap(__float_as_uint(val[1]),__float_as_uint(val[1]),false,false); const float p_=__uint_as_float(hi?r_[0]:r_[1]); top[14]=fmaxf(val[14],p_); }
        { auto r_=__builtin_amdgcn_permlane32_swap(__float_as_uint(val[0]),__float_as_uint(val[0]),false,false); const float p_=__uint_as_float(hi?r_[0]:r_[1]); top[15]=fmaxf(val[15],p_); }
        CE_D(top[0],top[8]);
        CE_D(top[1],top[9]);
        CE_D(top[2],top[10]);
        CE_D(top[3],top[11]);
        CE_D(top[4],top[12]);
        CE_D(top[5],top[13]);
        CE_D(top[6],top[14]);
        CE_D(top[7],top[15]);
        CE_D(top[0],top[4]);
        CE_D(top[1],top[5]);
        CE_D(top[2],top[6]);
        CE_D(top[3],top[7]);
        CE_D(top[8],top[12]);
        CE_D(top[9],top[13]);
        CE_D(top[10],top[14]);
        CE_D(top[11],top[15]);
        CE_D(top[0],top[2]);
        CE_D(top[1],top[3]);
        CE_D(top[4],top[6]);
        CE_D(top[5],top[7]);
        CE_D(top[8],top[10]);
        CE_D(top[9],top[11]);
        CE_D(top[12],top[14]);
        CE_D(top[13],top[15]);
        CE_D(top[0],top[1]);
        CE_D(top[2],top[3]);
        CE_D(top[4],top[5]);
        CE_D(top[6],top[7]);
        CE_D(top[8],top[9]);
        CE_D(top[10],top[11]);
        CE_D(top[12],top[13]);
        CE_D(top[14],top[15]);
    }
#undef CE_D
}
__device__ __forceinline__ void peer_topk(const bfu* PQ, const bfu* KEYS, unsigned short* EXP, float* GATE, LAS unsigned char* lds, int G) {
    const int tid = tid_fresh(), lane = tid & 63, wave = tid >> 6, r32 = lane & 31, hi = lane >> 5; const int bid = bid_fresh(), h = bid & 7, g = bid >> 3, NG = G >> 3;
    { const bfu* src = KEYS + (size_t)h * 32768;
#pragma unroll
      for (int q = 0; q < 8; ++q) { const int c = tid + q * 512, row = c >> 4, piece = c & 15; *(LAS v4u*)(lds + row * TK_PITCH + piece * 16) = *(const v4u*)(src + (size_t)c * 8); } }
    __syncthreads();
    const LAS unsigned char* kl0 = lds + r32 * TK_PITCH + 16 * hi;
    for (int tile = g + NG * wave; tile < M / 32; tile += NG * NWV) { const int tok = tile * 32 + r32;
        float v1[16], v2[16];
        top16_of_scores(PQ + (size_t)tok * 2048 + h * 256 + 8 * hi, kl0, hi, v1);
        top16_of_scores(PQ + (size_t)tok * 2048 + h * 256 + 128 + 8 * hi, kl0 + 128 * TK_PITCH, hi, v2);
        float cand[25]; unsigned pay[25];
#define CAND(c, a0, b0, a1, b1) do { const float s_ = hi ? (v1[a1] + v2[b1]) : (v1[a0] + v2[b0]); const unsigned code_ = hi ? (unsigned)((a1) * 16 + (b1)) : (unsigned)((a0) * 16 + (b0)); \
        cand[c] = __uint_as_float((__float_as_uint(s_) & ~255u) | code_); \
        pay[c] = hi ? (((__float_as_uint(v1[a1]) & 127u) << 7) | (__float_as_uint(v2[b1]) & 127u)) : (((__float_as_uint(v1[a0]) & 127u) << 7) | (__float_as_uint(v2[b0]) & 127u)); } while (0)
    CAND(0, 0, 0, 0, 1);
    CAND(1, 0, 2, 0, 3);
    CAND(2, 0, 4, 0, 5);
    CAND(3, 0, 6, 0, 7);
    CAND(4, 0, 8, 0, 9);
    CAND(5, 0, 10, 0, 11);
    CAND(6, 0, 12, 0, 13);
    CAND(7, 0, 14, 0, 15);
    CAND(8, 1, 0, 1, 1);
    CAND(9, 1, 2, 1, 3);
    CAND(10, 1, 4, 1, 5);
    CAND(11, 1, 6, 1, 7);
    CAND(12, 2, 0, 2, 1);
    CAND(13, 2, 2, 2, 3);
    CAND(14, 2, 4, 3, 0);
    CAND(15, 3, 1, 3, 2);
    CAND(16, 3, 3, 4, 0);
    CAND(17, 4, 1, 4, 2);
    CAND(18, 5, 0, 5, 1);
    CAND(19, 6, 0, 6, 1);
    CAND(20, 7, 0, 7, 1);
    CAND(21, 8, 0, 9, 0);
    CAND(22, 10, 0, 11, 0);
    CAND(23, 12, 0, 13, 0);
    CAND(24, 14, 0, 15, 0);
#undef CAND
        float sc[16]; unsigned ex[16];
#pragma unroll
        for (int i = 0; i < 16; ++i) { float m = cand[0];
#pragma unroll
            for (int j = 1; j < 25; ++j) m = fmaxf(m, cand[j]);
            m = pair_max(m); unsigned pl = 0u;
#pragma unroll
            for (int j = 0; j < 25; ++j) { const bool eq = (cand[j] == m); pl = eq ? pay[j] : pl; cand[j] = eq ? -INFINITY : cand[j]; }
            { auto rr = __builtin_amdgcn_permlane32_swap(pl, pl, false, false); pl = rr[0] | rr[1]; }
            sc[i] = m; ex[i] = pl; }
        float z = 0.f; const float scmax = sc[0];
#pragma unroll
        for (int i = 0; i < 16; ++i) { sc[i] = __expf(sc[i] - scmax); z += sc[i]; }
        const float rz = 1.0f / z;
        if (hi == 0) { v4u o0, o1; o0.x = ex[0] | (ex[1] << 16); o0.y = ex[2] | (ex[3] << 16); o0.z = ex[4] | (ex[5] << 16); o0.w = ex[6] | (ex[7] << 16);
            o1.x = ex[8] | (ex[9] << 16); o1.y = ex[10] | (ex[11] << 16); o1.z = ex[12] | (ex[13] << 16); o1.w = ex[14] | (ex[15] << 16);
            v4u* d = (v4u*)(EXP + (size_t)tok * 128 + h * 16); d[0] = o0; d[1] = o1; }
        else { f32x4* d = (f32x4*)(GATE + (size_t)tok * 128 + h * 16);
#pragma unroll
            for (int q = 0; q < 4; ++q) d[q] = (f32x4){sc[4 * q] * rz, sc[4 * q + 1] * rz, sc[4 * q + 2] * rz, sc[4 * q + 3] * rz}; } }
}
#ifndef DBG_CUMSUM_REP
#define DBG_CUMSUM_REP 1
#endif
#ifndef DBG_GATHER_REP
#define DBG_GATHER_REP 1
#endif
__device__ __forceinline__ float gelu_erf(float x) { return 0.5f * x * (1.0f + erff(x * 0.70710678118654752f)); }
__device__ __forceinline__ float row16_sum(float v) {
    v += __builtin_bit_cast(float, __builtin_amdgcn_update_dpp(0, __builtin_bit_cast(int, v), 0x128, 0xf, 0xf, false));
    v += __builtin_bit_cast(float, __builtin_amdgcn_update_dpp(0, __builtin_bit_cast(int, v), 0x124, 0xf, 0xf, false));
    v += __builtin_bit_cast(float, __builtin_amdgcn_update_dpp(0, __builtin_bit_cast(int, v), 0x122, 0xf, 0xf, false));
    v += __builtin_bit_cast(float, __builtin_amdgcn_update_dpp(0, __builtin_bit_cast(int, v), 0x121, 0xf, 0xf, false));
    return v;
}
__device__ __forceinline__ float ub0(unsigned w) { return (float)(w & 0xffu); }
__device__ __forceinline__ float ub1(unsigned w) { return (float)((w >> 8) & 0xffu); }
__device__ __forceinline__ float ub2(unsigned w) { return (float)((w >> 16) & 0xffu); }
__device__ __forceinline__ float ub3(unsigned w) { return (float)(w >> 24); }
__device__ __forceinline__ float gelu_poly(float v) {
    const float av = fabsf(v), t = __builtin_amdgcn_rcpf(av * 0.2316418882f + 1.0f);
    float q = t * 0.5307027145f + (-0.7265760135f); q = q * t + 0.7107068705f; q = q * t + (-0.142248368f); q = q * t + 0.127414796f; q = q * t;
    const float m = v * (q * __builtin_amdgcn_exp2f(v * v * (-0.72134752044f)));
    return v < 0.f ? m : v - m;
}
__device__ __forceinline__ void peer_hq(const float* XF, const float* SSP, const float* gain, unsigned* HQ, float* SH, int G) {
    const int tid = tid_fresh(), lane = tid & 63, wave = tid >> 6; const int gw = bid_fresh() * NWV + wave, NGW = G * NWV;
    const f32x4 g0 = *(const f32x4*)(gain + 16 * lane), g1 = *(const f32x4*)(gain + 16 * lane + 4), g2 = *(const f32x4*)(gain + 16 * lane + 8), g3 = *(const f32x4*)(gain + 16 * lane + 12);
    for (int tok = gw; tok < M; tok += NGW) {
        const float rstd = row_rstd16(SSP, tok); const float* xr = XF + (size_t)tok * D + 16 * lane;
        const f32x4 a[4] = {*(const f32x4*)xr * rstd * g0, *(const f32x4*)(xr + 4) * rstd * g1, *(const f32x4*)(xr + 8) * rstd * g2, *(const f32x4*)(xr + 12) * rstd * g3};
        float mx = 0.f;
#pragma unroll
        for (int q = 0; q < 4; ++q) mx = fmaxf(mx, fmaxf(fmaxf(fabsf(a[q][0]), fabsf(a[q][1])), fmaxf(fabsf(a[q][2]), fabsf(a[q][3]))));
#pragma unroll
        for (int o = 1; o < 64; o <<= 1) mx = fmaxf(mx, __shfl_xor(mx, o));
        const float sh = (mx > 0.f) ? mx * (1.0f / 127.0f) : 1.0f, inv = 1.0f / sh;
        v4u oh, ol;
#pragma unroll
        for (int k = 0; k < 4; ++k) { unsigned wh = 0, wl = 0;
#pragma unroll
            for (int b = 0; b < 4; ++b) { const float t = a[k][b] * inv; const float qh = __builtin_rintf(t); const int ql = (int)__builtin_rintf((t - qh) * 128.0f);
                wh |= ((unsigned)(int)qh & 0xffu) << (8 * b); wl |= ((unsigned)ql & 0xffu) << (8 * b); }
            oh[k] = wh; ol[k] = wl; }
        unsigned* dst = HQ + (size_t)tok * 512 + lane * 4;
        *(v4u*)dst = oh;
        if (lane == 0) SH[tok] = sh;
    }
}
struct URow { v4u hh[4]; float sh, ga, gb; int ea, eb; };
__device__ __forceinline__ void urow_prefetch(URow& n, const unsigned* HQ, const float* SH, const unsigned short* EXP, const float* GATE, int tok, int j, int lane) {
    const unsigned* hq = HQ + (size_t)tok * 512 + j * 4;
#pragma unroll
    for (int q = 0; q < 4; ++q) n.hh[q] = *(const v4u*)(hq + 64 * q);
    n.sh = SH[tok]; n.ea = EXP[(size_t)tok * 128 + lane]; n.eb = EXP[(size_t)tok * 128 + 64 + lane]; n.ga = GATE[(size_t)tok * 128 + lane]; n.gb = GATE[(size_t)tok * 128 + 64 + lane];
}
__device__ __forceinline__ float urow_dot(const v4u (&w)[4], const v4u (&hh)[4]) {
    int dh = 0;
#pragma unroll
    for (int c = 0; c < 4; ++c)
#pragma unroll
        for (int k = 0; k < 4; ++k) dh = __builtin_amdgcn_sdot4((int)w[c][k], (int)hh[c][k], dh, false);
    return row16_sum((float)dh);
}
__device__ __forceinline__ void peer_u_rows(const unsigned* HQ, const float* SH, const unsigned char* U8, const float* USC, const float* VSC, const unsigned short* EXP, const float* GATE_WGT, float* WOUT,
                                            LAS unsigned char* lds, int G, int x, int sub) {
    const int tid = tid_fresh(), lane = tid & 63, wave = tid >> 6, j = lane & 15, g16 = lane >> 4;
    const int w8 = sub * NWV + wave, NW8 = (G >> 3) * NWV;
    LAS int* lst = (LAS int*)(lds + wave * 2048); LAS float* dbuf = (LAS float*)(lds + wave * 2048 + 512);
    const unsigned uoff0 = 16u * (unsigned)j;
    LAS float* usl = (LAS float*)(lds + 16384); LAS float* vsl = usl + 2048;
    { const int i4 = tid * 4; *(LAS f32x4*)(usl + i4) = *(const f32x4*)(USC + x * 2048 + i4); *(LAS f32x4*)(vsl + i4) = *(const f32x4*)(VSC + x * 2048 + i4); }
    __syncthreads();
    URow cur; if (w8 < M) urow_prefetch(cur, HQ, SH, EXP, GATE_WGT, w8, j, lane);
    for (int tok = w8; tok < M; tok += NW8) {
        v4u hh[4];
#pragma unroll
        for (int q = 0; q < 4; ++q) hh[q] = cur.hh[q];
        const float sh = cur.sh, ga = cur.ga, gb = cur.gb; const int ea = cur.ea, eb = cur.eb;
        const bool ina = (ea >> 11) == x, inb = (eb >> 11) == x;
        const unsigned long long ma = __ballot(ina), mb = __ballot(inb);
        const int na = __popcll(ma), n = na + __popcll(mb);
        const int pa = __builtin_amdgcn_mbcnt_hi((unsigned)(ma >> 32), __builtin_amdgcn_mbcnt_lo((unsigned)ma, 0u)), pb = na + __builtin_amdgcn_mbcnt_hi((unsigned)(mb >> 32), __builtin_amdgcn_mbcnt_lo((unsigned)mb, 0u));
        if (ina) lst[pa] = (ea << 8) | lane;
        if (inb) lst[pb] = (eb << 8) | (64 + lane);
        float usa = 0.f, vsa = 0.f, usb = 0.f, vsb = 0.f;
        if (ina) { usa = usl[ea & 2047]; vsa = vsl[ea & 2047]; }
        if (inb) { usb = usl[eb & 2047]; vsb = vsl[eb & 2047]; }
        LDS_WAIT();
        v4u w[6][4]; int ent[6];
#pragma unroll
        for (int it = 0; it < 6; ++it) { ent[it] = -1;
            if (4 * it < n) { const int idx = 4 * it + g16; if (idx < n) { ent[it] = lst[idx]; const unsigned char* rp = U8 + (uoff0 + (unsigned)(ent[it] >> 8) * 1024u);
#pragma unroll
                for (int c = 0; c < 4; ++c) w[it][c] = *(const v4u*)(rp + 256 * c); } } }
        if (tok + NW8 < M) urow_prefetch(cur, HQ, SH, EXP, GATE_WGT, tok + NW8, j, lane);
#pragma unroll
        for (int it = 0; it < 6; ++it) if (4 * it < n) { const float d = urow_dot(w[it], hh); if (j == 0 && ent[it] >= 0) dbuf[ent[it] & 255] = d; }
        for (int it = 6; 4 * it < n; ++it) { const int idx = 4 * it + g16; int e1 = -1; v4u w1[4] = {};
            if (idx < n) { e1 = lst[idx]; const unsigned char* rp = U8 + (uoff0 + (unsigned)(e1 >> 8) * 1024u);
#pragma unroll
                for (int c = 0; c < 4; ++c) w1[c] = *(const v4u*)(rp + 256 * c); }
            const float d = urow_dot(w1, hh); if (j == 0 && e1 >= 0) dbuf[e1 & 255] = d; }
        LDS_WAIT();
        if (ina) WOUT[(size_t)tok * 128 + lane] = ga * gelu_poly(dbuf[lane] * (sh * usa)) * vsa;
        if (inb) WOUT[(size_t)tok * 128 + 64 + lane] = gb * gelu_poly(dbuf[64 + lane] * (sh * usb)) * vsb;
        LDS_WAIT();
    }
}
__device__ __forceinline__ float sum_groups8(float v) {
    v += __builtin_bit_cast(float, __builtin_amdgcn_update_dpp(0, __builtin_bit_cast(int, v), 0x128, 0xf, 0xf, false));
    { auto r = __builtin_amdgcn_permlane16_swap(__float_as_uint(v), __float_as_uint(v), false, false); v = __uint_as_float(r[0]) + __uint_as_float(r[1]); }
    { auto r = __builtin_amdgcn_permlane32_swap(__float_as_uint(v), __float_as_uint(v), false, false); v = __uint_as_float(r[0]) + __uint_as_float(r[1]); }
    return v;
}
struct VPre { float wa, wb; int ea, eb; };
__device__ __forceinline__ void v_prefetch(VPre& n, const float* WGT, const unsigned short* EXP, int tok, int lane) {
    n.wa = WGT[(size_t)tok * 128 + lane]; n.wb = WGT[(size_t)tok * 128 + 64 + lane]; n.ea = EXP[(size_t)tok * 128 + lane]; n.eb = EXP[(size_t)tok * 128 + 64 + lane];
}
__device__ __forceinline__ void peer_v_slice(const float* XF, float* XO, const float* WGT, const unsigned char* V8T, const unsigned short* EXP,
                                             bfu* XB, float* SSP, LAS unsigned char* lds, int G, int x, int sub, bool last) {
    const int tid = tid_fresh(), lane = tid & 63, wave = tid >> 6, j8 = lane & 7, g8 = lane >> 3;
    const int w8 = sub * NWV + wave, NW8 = (G >> 3) * NWV;
    const unsigned voff0 = (unsigned)x * (16384u * 128u) + 16u * (unsigned)j8;
    const int wqa = (lane >> 5) * 32 + (lane & 7) * 4 + ((lane >> 3) & 3);
    const int coff = 128 * x + 16 * j8 + ((lane >> 5) & 1) * 8 + ((lane >> 4) & 1) * 4;
    VPre cur[2];
#pragma unroll
    for (int h = 0; h < 2; ++h) if (w8 + h * NW8 < M) v_prefetch(cur[h], WGT, EXP, w8 + h * NW8, lane);
    for (int tok0 = w8; tok0 < M; tok0 += 2 * NW8) {
        float sw[2]; v4u rows[2][16]; int wq[2][4]; f32x4 xin[2]; bool live[2];
#pragma unroll
        for (int h = 0; h < 2; ++h) { live[h] = (tok0 + h * NW8 < M);
            LAS int* ebuf = (LAS int*)(lds + wave * 2048 + h * 1024); LAS char* wq8 = (LAS char*)(lds + wave * 2048 + h * 1024 + 512);
            float wmax = fmaxf(fabsf(cur[h].wa), fabsf(cur[h].wb));
#pragma unroll
            for (int o = 1; o < 64; o <<= 1) wmax = fmaxf(wmax, __shfl_xor(wmax, o));
            sw[h] = (wmax > 0.f) ? wmax * (1.0f / 127.0f) : 1.0f; const float inv = 1.0f / sw[h];
            ebuf[lane] = cur[h].ea; ebuf[64 + lane] = cur[h].eb;
            wq8[wqa] = (char)(int)__builtin_rintf(cur[h].wa * inv); wq8[64 + wqa] = (char)(int)__builtin_rintf(cur[h].wb * inv); }
        LDS_WAIT();
#pragma unroll
        for (int h = 0; h < 2; ++h) if (live[h]) { const int tok = tok0 + h * NW8;
            LAS int* ebuf = (LAS int*)(lds + wave * 2048 + h * 1024); LAS char* wq8 = (LAS char*)(lds + wave * 2048 + h * 1024 + 512);
#pragma unroll
            for (int it = 0; it < 16; ++it) rows[h][it] = *(const v4u*)(V8T + (voff0 + (unsigned)ebuf[8 * it + g8] * 128u));
#pragma unroll
            for (int q = 0; q < 4; ++q) wq[h][q] = *(const LAS int*)(wq8 + q * 32 + g8 * 4);
            xin[h] = *(const f32x4*)(XF + (size_t)tok * D + coff); }
#pragma unroll
        for (int h = 0; h < 2; ++h) if (tok0 + (2 + h) * NW8 < M) v_prefetch(cur[h], WGT, EXP, tok0 + (2 + h) * NW8, lane);
#pragma unroll
        for (int h = 0; h < 2; ++h) if (live[h]) { const int tok = tok0 + h * NW8;
            int acc[16];
#pragma unroll
            for (int i = 0; i < 16; ++i) acc[i] = 0;
#pragma unroll
            for (int q = 0; q < 4; ++q)
#pragma unroll
                for (int k = 0; k < 4; ++k) { const unsigned A = rows[h][4 * q][k], B = rows[h][4 * q + 1][k], C = rows[h][4 * q + 2][k], Dd = rows[h][4 * q + 3][k];
                    const unsigned p0 = __builtin_amdgcn_perm(A, B, 0x01050004u), p1 = __builtin_amdgcn_perm(A, B, 0x03070206u), q0 = __builtin_amdgcn_perm(C, Dd, 0x01050004u), q1 = __builtin_amdgcn_perm(C, Dd, 0x03070206u);
                    const unsigned t0 = __builtin_amdgcn_perm(p0, q0, 0x01000504u), t1 = __builtin_amdgcn_perm(p0, q0, 0x03020706u), t2 = __builtin_amdgcn_perm(p1, q1, 0x01000504u), t3 = __builtin_amdgcn_perm(p1, q1, 0x03020706u);
                    acc[4 * k] = __builtin_amdgcn_sdot4((int)t0, wq[h][q], acc[4 * k], false); acc[4 * k + 1] = __builtin_amdgcn_sdot4((int)t1, wq[h][q], acc[4 * k + 1], false);
                    acc[4 * k + 2] = __builtin_amdgcn_sdot4((int)t2, wq[h][q], acc[4 * k + 2], false); acc[4 * k + 3] = __builtin_amdgcn_sdot4((int)t3, wq[h][q], acc[4 * k + 3], false); }
            int r8[8];
#pragma unroll
            for (int i = 0; i < 8; ++i) { auto r = __builtin_amdgcn_permlane32_swap((unsigned)acc[i], (unsigned)acc[i + 8], false, false); r8[i] = (int)r[0] + (int)r[1]; }
            f32x4 c4;
#pragma unroll
            for (int i = 0; i < 4; ++i) { auto r = __builtin_amdgcn_permlane16_swap((unsigned)r8[i], (unsigned)r8[i + 4], false, false); const int v = (int)r[0] + (int)r[1];
                c4[i] = (float)(v + __builtin_amdgcn_update_dpp(0, v, 0x128, 0xf, 0xf, false)) * sw[h]; }
            float ss = 0.f;
            if ((lane & 8) == 0) { const f32x4 o = xin[h] + c4;
                ss = (o[0] * o[0] + o[1] * o[1]) + (o[2] * o[2] + o[3] * o[3]);
                *(f32x4*)(XO + (size_t)tok * D + coff) = o;
                if (!last) { v2u b; b.x = pk2(o[0], o[1]); b.y = pk2(o[2], o[3]); *(v2u*)(XB + (size_t)tok * D + coff) = b; } }
            if (!last) { ss = wave_sum(ss);
                if (lane == 0) { SSP[(size_t)tok * 16 + 2 * x] = ss; SSP[(size_t)tok * 16 + 2 * x + 1] = 0.f; } } }
        LDS_WAIT();
    }
}
__device__ __forceinline__ void fox_prep(bfu* QKV, const float* qg, const float* kg, const float* LFT, float* CB, int G) {
    const int tid = tid_fresh(), lane = tid & 63, wave = tid >> 6; const int gw = bid_fresh() * NWV + wave, NGW = G * NWV;
    for (int crep = 0; crep < DBG_CUMSUM_REP; ++crep)
    if (wave == 0 && (bid_fresh() & 3) == 0 && (bid_fresh() >> 2) < 64 && G >= 256) {
        const int bh = bid_fresh() >> 2, b = bh >> 4, h = bh & 15; const float* src = LFT + (size_t)b * SEQ * 16 + h; float* dst = CB + (size_t)bh * SEQ; float carry = 0.f;
#pragma unroll 4
        for (int r = 0; r < 32; ++r) { const float* sp = src + (size_t)(256 * r + 4 * lane) * 16; const float p0 = logsigf_(sp[0]), p1 = p0 + logsigf_(sp[16]), p2 = p1 + logsigf_(sp[32]), p3 = p2 + logsigf_(sp[48]);
            float inc = p3;
#pragma unroll
            for (int o = 1; o < 64; o <<= 1) { const float t = __shfl_up(inc, o); if (lane >= o) inc += t; }
            const float base = carry + (inc - p3); const float k = -1.4426950408889634f;
            *(f32x4*)(dst + 256 * r + 4 * lane) = (f32x4){k * (base + p0), k * (base + p1), k * (base + p2), k * (base + p3)};
            carry += __shfl(inc, 63); }
    } else if (G < 256 && gw < 64) {
        const int bh = gw, b = bh >> 4, h = bh & 15; const float* src = LFT + (size_t)b * SEQ * 16 + h; float* dst = CB + (size_t)bh * SEQ; float carry = 0.f;
        for (int r = 0; r < 32; ++r) { const float* sp = src + (size_t)(256 * r + 4 * lane) * 16; const float p0 = logsigf_(sp[0]), p1 = p0 + logsigf_(sp[16]), p2 = p1 + logsigf_(sp[32]), p3 = p2 + logsigf_(sp[48]);
            float inc = p3;
#pragma unroll
            for (int o = 1; o < 64; o <<= 1) { const float t = __shfl_up(inc, o); if (lane >= o) inc += t; }
            const float base = carry + (inc - p3); const float k = -1.4426950408889634f;
            *(f32x4*)(dst + 256 * r + 4 * lane) = (f32x4){k * (base + p0), k * (base + p1), k * (base + p2), k * (base + p3)};
            carry += __shfl(inc, 63); }
    }
    const float C2 = 0.125f * 1.4426950408889634f;
    int wi = gw, nwk = NGW;
    if (G == 256) { if ((gw & 31) == 0) return; wi = gw - ((gw >> 5) + 1); nwk = NGW - 64; }
    for (int it0 = wi; it0 < 2 * M; it0 += 4 * nwk) { v4u wv[4][2];
#pragma unroll
        for (int u = 0; u < 4; ++u) { const int it = it0 + u * nwk; if (it < 2 * M) { const bfu* p = QKV + (size_t)(it & 1) * ((size_t)M * D) + (size_t)(it >> 1) * D + 8 * lane;
            wv[u][0] = *(const v4u*)p; wv[u][1] = *(const v4u*)(p + 512); } }
#pragma unroll
        for (int u = 0; u < 4; ++u) { const int it = it0 + u * nwk; if (it < 2 * M) { const int which = it & 1; bfu* p = QKV + (size_t)which * ((size_t)M * D) + (size_t)(it >> 1) * D + 8 * lane;
            const float* gn = which ? kg : qg; const float sc = which ? 1.0f : C2;
            const f32x4 g0 = *(const f32x4*)(gn + 8 * (lane & 7)), g1 = *(const f32x4*)(gn + 8 * (lane & 7) + 4);
#pragma unroll
            for (int q = 0; q < 2; ++q) { const v4u w = wv[u][q];
                float v[8] = {bflo(w.x), bfhi(w.x), bflo(w.y), bfhi(w.y), bflo(w.z), bfhi(w.z), bflo(w.w), bfhi(w.w)};
                float s = 0.f;
#pragma unroll
                for (int i = 0; i < 8; ++i) s += v[i] * v[i];
                s += __shfl_xor(s, 1); s += __shfl_xor(s, 2); s += __shfl_xor(s, 4);
                const float rs = sc * __builtin_amdgcn_rsqf(s * (1.f / 64.f) + EPSF);
                v4u o; o.x = pk2(v[0] * rs * g0[0], v[1] * rs * g0[1]); o.y = pk2(v[2] * rs * g0[2], v[3] * rs * g0[3]); o.z = pk2(v[4] * rs * g1[0], v[5] * rs * g1[1]); o.w = pk2(v[6] * rs * g1[2], v[7] * rs * g1[3]);
                *(v4u*)(p + 512 * q) = o; } } } }
}
#define RLX_AGENT __ATOMIC_RELAXED, __HIP_MEMORY_SCOPE_AGENT
#define XB_TMO      128
#define XB_XCNT(j)  (256  + 64 * (j))
#define XB_XSUB(j)  (1280 + 64 * (j))
#define XB_XGEN(j)  (2304 + 64 * (j))
#define XB_TOP      3328
#define XB_TOPGEN   3392
#define XCD_BAR_WORDS 3456
#define XB_SPIN_CAP (1u << 18)

__device__ __forceinline__ unsigned xb_ld(unsigned* p)              { return __hip_atomic_load(p, __ATOMIC_RELAXED, __HIP_MEMORY_SCOPE_AGENT); }
__device__ __forceinline__ unsigned xb_add(unsigned* p, unsigned v) { return __hip_atomic_fetch_add(p, v, __ATOMIC_RELAXED, __HIP_MEMORY_SCOPE_AGENT); }
__device__ __forceinline__ unsigned xb_xcc_id() { return (unsigned)__builtin_amdgcn_s_getreg((3 << 11) | 20) & 0xFu; }
#define XB_SPIN(cond, bar) do { unsigned _sp = 0; while (cond) { __builtin_amdgcn_s_sleep(1); \
    if ((++_sp & 255u) == 0u) { if (xb_ld(&(bar)[XB_TMO])) break; if (_sp > XB_SPIN_CAP) { atomicAdd(&(bar)[XB_TMO], 1u); break; } } } } while (0)

struct XcdBarrier {
    unsigned* bar; unsigned x;
    volatile LAS unsigned* st;
};

__device__ __forceinline__ XcdBarrier xcd_barrier_post(unsigned* bar, volatile LAS unsigned* st) {
    XcdBarrier b; b.bar = bar; b.x = xb_xcc_id(); b.st = st;
    if (threadIdx.x == 0) (void)xb_add(&bar[XB_XCNT(b.x)], 1u);
    return b;
}
__device__ __forceinline__ void xcd_barrier_complete(unsigned* bar, unsigned x, unsigned& nloc, unsigned& nx) {
    const unsigned G = gridDim.x * gridDim.y * gridDim.z;
    unsigned sum, cnt, mine, sp = 0u;
    for (;;) {
        sum = 0u; cnt = 0u; mine = 0u;
#pragma unroll
        for (unsigned j = 0; j < 16; ++j) { const unsigned c = xb_ld(&bar[XB_XCNT(j)]); sum += c; cnt += (c > 0u) ? 1u : 0u; mine = (j == x) ? c : mine; }
        if (sum == G) break;
        __builtin_amdgcn_s_sleep(1);
        if ((++sp & 255u) == 0u) { if (xb_ld(&bar[XB_TMO])) break; if (sp > XB_SPIN_CAP) { atomicAdd(&bar[XB_TMO], 1u); break; } }
    }
    nloc = mine > 0u ? mine : 1u; nx = cnt > 0u ? cnt : 1u;
}

__device__ __forceinline__ void xcd_barrier(const XcdBarrier& b) {
    asm volatile("s_waitcnt vmcnt(0)" ::: "memory");
    __syncthreads();
    if (threadIdx.x == 0) {
        unsigned* bar = b.bar;
        __builtin_amdgcn_s_waitcnt(0);
        unsigned nloc = b.st[0], nx = b.st[1];
        if (nloc == 0u) { xcd_barrier_complete(bar, b.x, nloc, nx); b.st[0] = nloc; b.st[1] = nx; }
        const unsigned old = xb_add(&bar[XB_XSUB(b.x)], 1u);
        const unsigned gen = old / nloc;
        if (old + 1u == (gen + 1u) * nloc) {
            __builtin_amdgcn_fence(__ATOMIC_RELEASE, "agent");
            asm volatile("s_waitcnt vmcnt(0)" ::: "memory");
            const unsigned og = xb_add(&bar[XB_TOP], 1u);
            const unsigned tg = og / nx;
            if (og + 1u == (tg + 1u) * nx) xb_add(&bar[XB_TOPGEN], 1u);
            else XB_SPIN(xb_ld(&bar[XB_TOPGEN]) == tg, bar);
            __builtin_amdgcn_fence(__ATOMIC_ACQUIRE, "agent");
            xb_add(&bar[XB_XGEN(b.x)], 1u);
            asm volatile("s_waitcnt vmcnt(0)" ::: "memory");
        } else {
            XB_SPIN(xb_ld(&bar[XB_XGEN(b.x)]) == gen, bar);
            __builtin_amdgcn_fence(__ATOMIC_ACQUIRE, "agent");
            asm volatile("s_waitcnt vmcnt(0)" ::: "memory");
        }
    }
    __syncthreads();
}

struct Params { const float* in[22]; float* out; unsigned char* ws; int ph_lo, ph_hi; };
constexpr int N_PHASES = 16;
#ifndef DBG_PROBE_U
#define DBG_PROBE_U 0
#endif
#ifndef DBG_PROBE_V
#define DBG_PROBE_V 0
#endif
#ifndef DBG_PROBE_ATT
#define DBG_PROBE_ATT 0
#endif
#ifndef DBG_DUP
#define DBG_DUP 0
#endif
#ifndef SKIPMASK
#define SKIPMASK 0
#endif
#define PH_ON(n) (!((SKIPMASK >> (n)) & 1))
typedef const __attribute__((address_space(4))) Params* KP;
__device__ __forceinline__ KP kparams() { KP k = (KP)__builtin_amdgcn_kernarg_segment_ptr(); asm volatile("" : "+s"(k)); return k; }
#define WSP(T, off) ((T*)(ws + (off)))
__global__ void __launch_bounds__(NTH, 2) trunk_fwd(Params p_unused) {
    extern __shared__ __attribute__((aligned(16))) unsigned char lds_raw[];
    LAS unsigned char* lds = (LAS unsigned char*)lds_raw;
    cg::grid_group grid = cg::this_grid();
    volatile LAS unsigned* xst = (volatile LAS unsigned*)(lds + LDS_BYTES - 64);
    if (threadIdx.x < 2) xst[threadIdx.x] = 0u;
    __syncthreads();
    XcdBarrier xbar = xcd_barrier_post((unsigned*)(kparams()->ws + WS_BAR), xst);
    int ph_hi; { KP k0 = kparams(); ph_hi = k0->ph_hi; }
    for (int ph = kparams()->ph_lo; ph < ph_hi; ++ph) {
        for (int rep = 0; rep < (((DBG_DUP >> ph) & 1) ? 2 : 1); ++rep) {
        if (rep) xcd_barrier(xbar);
        KP kp = kparams(); unsigned char* ws = kp->ws; int G = gridDim.x; asm volatile("" : "+s"(G));
        switch (ph) {
        case 0: if (PH_ON(0)) { const float* inl[22];
#pragma unroll
                  for (int i = 0; i < 22; ++i) inl[i] = kp->in[i];
                  p0_prologue(inl, ws, lds, G); } break;
        case 1: if (PH_ON(1)) { pg8::Gemm g{WSP(bfu, WS_XB), WSP(const bfu, WS_WINE), M, EVEN_PAD, D}; pg8::StaticOrder S; S.init(M, EVEN_PAD, G, (int)bid_fresh());
                  pg8::EpiScale<1> E{WSP(bfu, WS_R1), EVEN_IN, EVEN_IN, WSP(float, WS_SS)}; pg8::gemm_phase<pg8::EpiScale<1>, pg8::StaticOrder, true, true>(lds, g, S, E); } break;
        case 2: if (PH_ON(2)) { for (int u = bid_fresh(); u < M / 32; u += G) conv_unit(WSP(bfu, WS_R1), kp->in[3], kp->in[4], kp->in[5], kp->in[6], WSP(bfu, WS_R2), lds, u);
                  for (int u = bid_fresh(); u < 2048; u += G) gla_g1_unit(WSP(bfu, WS_R1), kp->in[7], kp->in[8], kp->out, WSP(float, WS_DEC), lds, u); } break;
        case 3: if (PH_ON(3)) gla_g2(kp->out, WSP(float, WS_DEC), G); break;
        case 4: if (PH_ON(4)) { for (int u = bid_fresh(); u < 2048; u += G) gla_g3_unit(WSP(bfu, WS_R1), kp->in[7], kp->in[8], kp->in[9], kp->out, WSP(bfu, WS_R2), lds, u); } break;
        case 5: case 12: if (PH_ON(5)) { const bool odd = (ph == 12); pg8::Gemm g{odd ? WSP(bfu, WS_R1) : WSP(bfu, WS_R2), (const bfu*)(ws + (odd ? WS_WOUTO : WS_WOUTE)), M, D, D}; pg8::StaticOrder S; S.init(M, D, G, (int)bid_fresh());
                  pg8::EpiResid E{odd ? (const float*)kp->out : kp->in[0], kp->out, WSP(bfu, WS_XB), WSP(float, WS_SSP)}; pg8::gemm_phase<pg8::EpiResid, pg8::StaticOrder, true, true>(lds, g, S, E); } break;
        case 6: case 13: if (PH_ON(6)) { const int l = (ph == 13); pg8::Gemm g{WSP(bfu, WS_XB), (const bfu*)(ws + WS_WQ + (size_t)l * 4 * MiB), M, 2048, D}; pg8::StaticOrder S; S.init(M, 2048, G, (int)bid_fresh());
                  pg8::EpiScale<16> E{WSP(bfu, WS_R1), 2048, 2048, WSP(float, WS_SSP)}; pg8::gemm_phase<pg8::EpiScale<16>, pg8::StaticOrder, true, true>(lds, g, S, E); } break;
        case 7: case 14: if (PH_ON(7)) { const int l = (ph == 14);
                  peer_hq(kp->out, WSP(float, WS_SSP), kp->in[17] + l * 1024, WSP(unsigned, WS_R2), WSP(float, WS_SS), G);
                  peer_topk(WSP(bfu, WS_R1), WSP(const bfu, WS_KEYS) + (size_t)l * 262144, WSP(unsigned short, WS_EXP), WSP(float, WS_GATE), lds, G); } break;
        case 8: case 15: if (PH_ON(8)) { const int l = (ph == 15); const unsigned char* U8 = ws + WS_UV + (size_t)l * 2 * 16777216; const float* USC = WSP(const float, WS_USC) + l * 2 * 16384;
#if DBG_PROBE_U
                  peer_u_rows(WSP(unsigned, WS_R2), WSP(float, WS_SS), U8, USC, USC + 16384, WSP(unsigned short, WS_EXP), WSP(float, WS_GATE), WSP(float, WS_R1), lds, G, bid_fresh() & 7, bid_fresh() >> 3);
                  xcd_barrier(xbar);
#endif
                  peer_u_rows(WSP(unsigned, WS_R2), WSP(float, WS_SS), U8, USC, USC + 16384, WSP(unsigned short, WS_EXP), WSP(float, WS_GATE), WSP(float, WS_GATE), lds, G, bid_fresh() & 7, bid_fresh() >> 3);
                  xcd_barrier(xbar);
#if DBG_PROBE_V
                  peer_v_slice(kparams()->out, WSP(float, WS_R1), WSP(float, WS_GATE), ws + WS_UV + (size_t)l * 2 * 16777216 + 16777216, WSP(unsigned short, WS_EXP), WSP(bfu, WS_R1 + 128 * MiB), WSP(float, WS_LFT), lds, G, bid_fresh() & 7, bid_fresh() >> 3, false);
                  xcd_barrier(xbar);
#endif
                  peer_v_slice(kparams()->out, kparams()->out, WSP(float, WS_GATE), ws + WS_UV + (size_t)l * 2 * 16777216 + 16777216, WSP(unsigned short, WS_EXP), WSP(bfu, WS_XB), WSP(float, WS_SSP), lds, G, bid_fresh() & 7, bid_fresh() >> 3, l == 1); } break;
        case 9: if (PH_ON(9)) { pg8::Gemm g{WSP(bfu, WS_XB), WSP(const bfu, WS_WINO), M, ODD_PAD, D}; pg8::StaticOrder S; S.init(M, ODD_PAD, G, (int)bid_fresh());
                  pg8::EpiQkv E{WSP(bfu, WS_R1), WSP(float, WS_SSP), WSP(float, WS_LFT), kp->in[13]}; pg8::gemm_phase<pg8::EpiQkv, pg8::StaticOrder, true, true>(lds, g, S, E); } break;
        case 10: if (PH_ON(10)) fox_prep(WSP(bfu, WS_R1), kp->in[14], kp->in[15], WSP(float, WS_LFT), WSP(float, WS_CB), G); break;
        case 11: if (PH_ON(11)) { bfu* R1 = WSP(bfu, WS_R1); const attn_body::AttnTensors AT{(const attn_body::bf16*)R1, (const attn_body::bf16*)(R1 + (size_t)M * D), (const attn_body::bf16*)(R1 + (size_t)2 * M * D), (attn_body::bf16*)R1};
#if DBG_PROBE_ATT
                  { const attn_body::AttnTensors AT2{(const attn_body::bf16*)R1, (const attn_body::bf16*)(R1 + (size_t)M * D), (const attn_body::bf16*)(R1 + (size_t)2 * M * D), (attn_body::bf16*)WSP(bfu, WS_R2)};
                    attn_body::attn_phase_dyn<8>((char*)lds_raw, AT2, WSP(float, WS_CB), kp->in[14], kp->in[15], (unsigned*)(ws + WS_BAR + 15360 + 32)); xcd_barrier(xbar); }
#endif
                  attn_body::attn_phase_dyn<14>((char*)lds_raw, AT, WSP(float, WS_CB), kp->in[14], kp->in[15], (unsigned*)(ws + WS_BAR + 15360)); } break;
        default: break;
        }
        }
        if (ph + 1 < ph_hi) { if (ph == kparams()->ph_lo) grid.sync(); else xcd_barrier(xbar); }
    }
}

extern "C" void kernel_launch(void* const* d_in, const int* in_sizes, int n_in, void* d_out, int out_size, void* d_ws, size_t ws_size, hipStream_t stream) {
    static int grid = 0;
    if (grid == 0) {
        if (n_in != 22 || out_size != M * D || ws_size < WS_END) { fprintf(stderr, "kernel_launch: unexpected problem (n_in %d, out %d, ws %zu)\n", n_in, out_size, ws_size); grid = -1; return; }
        int dev = 0, cus = 0, per_cu = 0;
        (void)hipGetDevice(&dev); (void)hipDeviceGetAttribute(&cus, hipDeviceAttributeMultiprocessorCount, dev);
        if (hipFuncSetAttribute((const void*)trunk_fwd, hipFuncAttributeMaxDynamicSharedMemorySize, LDS_BYTES) != hipSuccess) { fprintf(stderr, "kernel_launch: hipFuncSetAttribute failed\n"); grid = -1; return; }
        if (hipOccupancyMaxActiveBlocksPerMultiprocessor(&per_cu, (const void*)trunk_fwd, NTH, LDS_BYTES) != hipSuccess || per_cu < 1) { fprintf(stderr, "kernel_launch: occupancy query says %d\n", per_cu); per_cu = 1; }
        (void)hipGetLastError();
        grid = (cus / 8) * 8;
        fprintf(stderr, "kernel_launch: grid %d (cus %d, per_cu %d)\n", grid, cus, per_cu);
    }
    if (grid < 0) return;
    Params p{};
    for (int i = 0; i < 22; ++i) p.in[i] = (const float*)d_in[i];
    p.out = (float*)d_out; p.ws = (unsigned char*)d_ws; p.ph_lo = 0; p.ph_hi = N_PHASES;
    (void)hipMemsetAsync((char*)d_ws + WS_BAR, 0, 16384, stream);
    void* args[] = {&p};
    hipError_t e = hipLaunchCooperativeKernel((const void*)trunk_fwd, dim3(grid), dim3(NTH), args, LDS_BYTES, stream);
    if (e != hipSuccess) fprintf(stderr, "cooperative launch failed: %s (grid %d)\n", hipGetErrorString(e), grid);
}
```
